# Optimizing an MI355X kernel written in HIP

```python
import jax, jax.numpy as jnp
from jax import lax
import numpy as np

D_MODEL = 1024
BATCH = 8
SEQ = 8192
DEPTH = 1

MIX_WIDTH = D_MODEL
CONV_WIDTH = MIX_WIDTH // 2
CONV_K = 3
RWKV_WIDTH = MIX_WIDTH - CONV_WIDTH
RWKV_HEAD = 64
RWKV_HEADS = RWKV_WIDTH // RWKV_HEAD
DECAY_LORA = 64
AAA_LORA = 64
GATE_LORA = 128
P_CONV = 3 * CONV_WIDTH
P_RWKV = 3 * RWKV_WIDTH + DECAY_LORA + AAA_LORA + GATE_LORA
P_TOTAL = P_CONV + P_RWKV
D_FF = 4 * D_MODEL
N_MOD = 6
EPS = 1e-6
LNX_EPS = 1e-5 * RWKV_HEAD

kernel_name = "hymba_conv_rwkv7_adaln_block"


def rms_norm(x, eps=EPS):
    xf = x.astype(jnp.float32)
    return (xf * lax.rsqrt(jnp.mean(xf * xf, axis=-1, keepdims=True) + eps)).astype(x.dtype)


def modulate(h, shift, scale):
    return h * (1.0 + scale[:, None, :]) + shift[:, None, :]


def token_shift(u):
    return jnp.pad(u, ((0, 0), (1, 0), (0, 0)))[:, :-1]


def short_conv_mixer(p, conv_w):
    b_gate, c_gate, u = jnp.split(p, 3, axis=-1)
    z = c_gate * u
    z = lax.conv_general_dilated(
        z, conv_w, window_strides=(1,), padding=((CONV_K - 1, 0),),
        dimension_numbers=('NWC', 'WIO', 'NWC'), feature_group_count=CONV_WIDTH)
    return b_gate * z


def rwkv7_step(S, inp):
    r_t, w_t, k_t, v_t, a_t, b_t = inp
    sa = jnp.einsum('bhvk,bhk->bhv', S, a_t)
    S = S * w_t[:, :, None, :] + sa[..., None] * b_t[:, :, None, :] + v_t[..., None] * k_t[:, :, None, :]
    y_t = jnp.einsum('bhvk,bhk->bhv', S, r_t)
    return S, y_t


def rwkv7_mixer(p, mu, w0, w2, a0, a2, g2, k_k, k_a, r_k, lnx_g, lnx_b):
    b, t, _ = p.shape
    H, N = RWKV_HEADS, RWKV_HEAD
    p = p + (token_shift(p) - p) * mu
    R = RWKV_WIDTH
    r, k, v, w_lo, a_lo, g_lo = jnp.split(
        p, [R, 2 * R, 3 * R, 3 * R + DECAY_LORA, 3 * R + DECAY_LORA + AAA_LORA], axis=-1)
    w = -jax.nn.softplus(-(w0 + jnp.tanh(w_lo) @ w2)) - 0.5
    a = jax.nn.sigmoid(a0 + a_lo @ a2)
    g = jax.nn.sigmoid(g_lo) @ g2
    heads = lambda z: z.reshape(b, t, H, N).astype(jnp.float32)
    kk = heads(k * k_k)
    kk = kk / jnp.maximum(jnp.sqrt(jnp.sum(kk * kk, axis=-1, keepdims=True)), 1e-12)
    k = k * (1.0 + (a - 1.0) * k_a)
    rh, kh, vh, ah = heads(r), heads(k), heads(v), heads(a)
    decay = jnp.exp(-jnp.exp(heads(w)))
    a_vec = -kk
    b_vec = kk * ah
    seq_first = lambda z: jnp.moveaxis(z, 1, 0)
    S0 = jnp.zeros((b, H, N, N), jnp.float32)
    _, y = lax.scan(rwkv7_step, S0,
                    (seq_first(rh), seq_first(decay), seq_first(kh), seq_first(vh),
                     seq_first(a_vec), seq_first(b_vec)))
    y = jnp.moveaxis(y, 0, 1)
    mean = jnp.mean(y, axis=-1, keepdims=True)
    var = jnp.mean(jnp.square(y - mean), axis=-1, keepdims=True)
    y = ((y - mean) * lax.rsqrt(var + LNX_EPS)).reshape(b, t, R)
    y = y * lnx_g.astype(jnp.float32) + lnx_b.astype(jnp.float32)
    bonus = jnp.sum(rh * kh * r_k.astype(jnp.float32), axis=-1, keepdims=True) * vh
    y = y + bonus.reshape(b, t, R)
    return (y.astype(p.dtype)) * g


def setup_inputs(seed: int = 0) -> dict:
    key = jax.random.key(seed)
    ks = jax.random.split(key, 24)
    nrm = lambda k, shape, s: jax.random.normal(k, shape, jnp.float32) * s
    L = DEPTH
    x = jax.random.normal(ks[0], (BATCH, SEQ, D_MODEL), jnp.float32)
    c = jax.random.normal(ks[1], (BATCH, D_MODEL), jnp.float32)
    w_ada = nrm(ks[2], (L, D_MODEL, N_MOD * D_MODEL), 0.5 * D_MODEL ** -0.5)
    b_ada = nrm(ks[3], (L, N_MOD * D_MODEL), 0.01)
    w_in = nrm(ks[4], (L, D_MODEL, P_TOTAL), D_MODEL ** -0.5)
    conv_w = nrm(ks[5], (L, CONV_K, 1, CONV_WIDTH), CONV_K ** -0.5)
    rwkv_mu = jax.random.uniform(ks[6], (L, P_RWKV), jnp.float32)
    w0 = jax.random.uniform(ks[7], (L, RWKV_WIDTH), jnp.float32, -6.0, 0.0)
    w2 = nrm(ks[8], (L, DECAY_LORA, RWKV_WIDTH), 0.5 * DECAY_LORA ** -0.5)
    a0 = nrm(ks[9], (L, RWKV_WIDTH), 0.1)
    a2 = nrm(ks[10], (L, AAA_LORA, RWKV_WIDTH), AAA_LORA ** -0.5)
    g2 = nrm(ks[11], (L, GATE_LORA, RWKV_WIDTH), GATE_LORA ** -0.5)
    k_k = 0.85 + nrm(ks[12], (L, RWKV_WIDTH), 0.02)
    k_a = 1.0 + nrm(ks[13], (L, RWKV_WIDTH), 0.02)
    r_k = nrm(ks[14], (L, RWKV_HEADS, RWKV_HEAD), 0.1)
    lnx_g = 1.0 + nrm(ks[15], (L, RWKV_WIDTH), 0.02)
    lnx_b = nrm(ks[16], (L, RWKV_WIDTH), 0.01)
    w_out = nrm(ks[17], (L, MIX_WIDTH, D_MODEL), MIX_WIDTH ** -0.5)
    w_up = nrm(ks[18], (L, D_MODEL, D_FF), D_MODEL ** -0.5)
    w_down = nrm(ks[19], (L, D_FF, D_MODEL), D_FF ** -0.5)
    final_g = 1.0 + nrm(ks[20], (D_MODEL,), 0.02)
    return {"x": x, "c": c, "w_ada": w_ada, "b_ada": b_ada, "w_in": w_in,
            "conv_w": conv_w, "rwkv_mu": rwkv_mu, "w0": w0, "w2": w2, "a0": a0,
            "a2": a2, "g2": g2, "k_k": k_k, "k_a": k_a, "r_k": r_k,
            "lnx_g": lnx_g, "lnx_b": lnx_b, "w_out": w_out, "w_up": w_up,
            "w_down": w_down, "final_g": final_g}


def reference(x, c, w_ada, b_ada, w_in, conv_w, rwkv_mu, w0, w2, a0, a2, g2,
              k_k, k_a, r_k, lnx_g, lnx_b, w_out, w_up, w_down, final_g):
    cond = jax.nn.silu(c)
    for l in range(DEPTH):
        mod = cond @ w_ada[l] + b_ada[l]
        sh1, sc1, gt1, sh2, sc2, gt2 = jnp.split(mod, N_MOD, axis=-1)
        h = modulate(rms_norm(x), sh1, sc1)
        p = h @ w_in[l]
        y_conv = short_conv_mixer(p[..., :P_CONV], conv_w[l])
        y_rwkv = rwkv7_mixer(p[..., P_CONV:], rwkv_mu[l], w0[l], w2[l], a0[l], a2[l],
                             g2[l], k_k[l], k_a[l], r_k[l], lnx_g[l], lnx_b[l])
        y = jnp.concatenate([y_conv, y_rwkv], axis=-1) @ w_out[l]
        x = x + gt1[:, None, :] * y
        h = modulate(rms_norm(x), sh2, sc2)
        f = jnp.square(jax.nn.relu(h @ w_up[l])) @ w_down[l]
        x = x + gt2[:, None, :] * f
    return rms_norm(x) * final_g
```

```cpp
#include <hip/hip_runtime.h>
#include <hip/hip_cooperative_groups.h>
#include <cstdio>
#include <cstdint>
namespace cg = cooperative_groups;
namespace pg8 {
#define PG8_LAS __attribute__((address_space(3)))
typedef unsigned short bf16_t;
typedef short bf16x8 __attribute__((ext_vector_type(8)));
typedef float f32x4 __attribute__((ext_vector_type(4)));
typedef unsigned u32x4 __attribute__((ext_vector_type(4)));
constexpr int BM = 256, BK = 64, HALF = 128, HTB = HALF * BK * 2  , STAGE_BYTES = 8 * HTB, NXCD = 8, WGM = 8;

__host__ __device__ __forceinline__ int lds_byte(int r, int c) { const int st = (r >> 4) * 2 + (c >> 5), rr = r & 15, cc = c & 31, ob = rr * 64 + cc * 2; return st * 1024 + (ob ^ (((ob >> 9) & 1) << 5)); }
__host__ __device__ __forceinline__ void stage_rc(int b, int& R, int& C) { const int st = b / 1024, sb = b % 1024, swz = sb ^ (((sb >> 9) & 1) << 5); R = (st >> 1) * 16 + swz / 64; C = (st & 1) * 32 + (swz % 64) / 2; }
__host__ __device__ __forceinline__ int perm32(int rho) { const int n = rho >> 4, i = rho & 15; return 8 * (i >> 2) + 4 * n + (i & 3); }

struct Unit { int pm, pn; };
struct Gemm { const bf16_t* A; const bf16_t* Bt; int M, N, K; };

struct StaticOrder {
    int nM, nN, nwg, G, c;
    __host__ __device__ void init(int M, int N, int G_, int c_) { nM = M / BM; nN = N / BM; nwg = nM * nN; G = G_; c = c_; }
    __host__ __device__ bool next(int i, Unit& u) const {
        const long L = (long)i * G + c; if (L >= nwg) return false;
        int wgid = (int)L; { const int q = nwg / NXCD, r = nwg % NXCD, xcd = wgid % NXCD, off = wgid / NXCD; wgid = (xcd < r ? xcd * (q + 1) : r * (q + 1) + (xcd - r) * q) + off; }
        const int nig = WGM * nN, gid = wgid / nig, fm = gid * WGM, gsz = (nM - fm) < WGM ? (nM - fm) : WGM;
        u.pm = fm + ((wgid % nig) % gsz); u.pn = (wgid % nig) / gsz; return true;
    }
    __device__ __forceinline__ void a_ready(const Unit&) const {}
    __device__ __forceinline__ void done(const Unit&) const {}
};
__device__ __forceinline__ unsigned cvt_pk_bf16(float lo, float hi) { unsigned r; asm volatile("v_cvt_pk_bf16_f32 %0, %1, %2" : "=v"(r) : "v"(lo), "v"(hi)); return r; }
template <class Epi, class Sched, bool ALIGN_EPI = false, bool SP2 = false>
__device__ __forceinline__ void gemm_phase(PG8_LAS unsigned char* lds, const Gemm g, const Sched& S, const Epi& E) {
    const int tid = threadIdx.x, wid = __builtin_amdgcn_readfirstlane(tid >> 6), lane = tid & 63, wr = wid >> 2, wc = wid & 3, fr = lane & 15, fq = lane >> 4;
    const int K = g.K, nt = K / BK;
    unsigned voffA[2], voffB[2];
#pragma unroll
    for (int i = 0; i < 2; ++i) { int R, C; stage_rc(tid * 16 + i * 8192, R, C); const int Rb = Epi::PERM ? ((R & ~31) + perm32(R & 31)) : R;
        voffA[i] = (unsigned)(R * K + C) * 2u; voffB[i] = (unsigned)(Rb * K + C) * 2u; }
    const size_t kstep = (size_t)(BK * 2);
    const size_t hstep = (size_t)HALF * K * 2;
    const size_t tstep = 2 * hstep;
    const unsigned ldsw = (unsigned)wid * 1024u;
    const int aoff = lds_byte(wr * 64 + fr, fq * 8), boff = lds_byte(wc * 32 + fr, fq * 8);
#define PG8_SA(b, h) (((b) * 2 + (h)) * HTB)
#define PG8_SB(b, h) ((4 + (b) * 2 + (h)) * HTB)
#define PG8_STAGE(bufoff, gbase, voff) do { _Pragma("unroll") for (int _i = 0; _i < 2; ++_i) \
        __builtin_amdgcn_global_load_lds((const unsigned*)((const char*)(gbase) + (voff)[_i]), (PG8_LAS unsigned*)(lds + (bufoff) + ldsw + _i * 8192), 16, 0, 0); } while (0)
#define PG8_LDA(dst, b, h) do { _Pragma("unroll") for (int m = 0; m < 4; ++m) _Pragma("unroll") for (int k = 0; k < 2; ++k) dst[m][k] = *(const PG8_LAS bf16x8*)(lds + PG8_SA(b, h) + aoff + m * 2048 + k * 1024); } while (0)
#define PG8_LDB(dst, b, h) do { _Pragma("unroll") for (int n = 0; n < 2; ++n) _Pragma("unroll") for (int k = 0; k < 2; ++k) dst[n][k] = *(const PG8_LAS bf16x8*)(lds + PG8_SB(b, h) + boff + n * 2048 + k * 1024); } while (0)
#define PG8_MMA(ai, bj, At, Bt) do { __builtin_amdgcn_s_setprio(1); _Pragma("unroll") for (int m = 0; m < 4; ++m) _Pragma("unroll") for (int n = 0; n < 2; ++n) _Pragma("unroll") for (int k = 0; k < 2; ++k) \
        acc[ai][bj][m][n] = __builtin_amdgcn_mfma_f32_16x16x32_bf16(Bt[n][k], At[m][k], acc[ai][bj][m][n], 0, 0, 0); __builtin_amdgcn_s_setprio(0); } while (0)
#define PG8_WAIT_V(n) asm volatile("s_waitcnt vmcnt(" #n ")" ::: "memory")
#define PG8_WAIT_L(n) asm volatile("s_waitcnt lgkmcnt(" #n ")" ::: "memory")
#define PG8_BAR __builtin_amdgcn_s_barrier()
#define PG8_SCHED __builtin_amdgcn_sched_barrier(0)
    Unit cur, nxt; int ui = 0;
    if (!S.next(0, cur)) return;
    f32x4 acc[2][2][4][2];
#pragma unroll
    for (int a = 0; a < 2; ++a)
#pragma unroll
        for (int b = 0; b < 2; ++b)
#pragma unroll
            for (int m = 0; m < 4; ++m)
#pragma unroll
                for (int n = 0; n < 2; ++n) acc[a][b][m][n] = (f32x4){0.f, 0.f, 0.f, 0.f};
    bf16x8 At[4][2], B0[2][2], B1[2][2];
    const char* cA = (const char*)g.A + (size_t)cur.pm * tstep; const char* cB = (const char*)g.Bt + (size_t)cur.pn * tstep;
    S.a_ready(cur);
    if constexpr (SP2) {
        PG8_STAGE(PG8_SB(0, 0), cB, voffB); PG8_STAGE(PG8_SB(0, 1), cB + hstep, voffB); PG8_STAGE(PG8_SA(0, 0), cA, voffA); PG8_STAGE(PG8_SA(0, 1), cA + hstep, voffA);
        if (wr == 1) PG8_BAR;
        PG8_WAIT_V(2); PG8_BAR;
        PG8_STAGE(PG8_SB(1, 0), cB + kstep, voffB); PG8_STAGE(PG8_SA(1, 0), cA + kstep, voffA); PG8_STAGE(PG8_SB(1, 1), cB + hstep + kstep, voffB);
        PG8_WAIT_V(6); PG8_BAR;
    } else {
        PG8_STAGE(PG8_SB(0, 0), cB, voffB); PG8_STAGE(PG8_SA(0, 0), cA, voffA); PG8_STAGE(PG8_SB(0, 1), cB + hstep, voffB); PG8_STAGE(PG8_SA(0, 1), cA + hstep, voffA);
        if (wr == 1) PG8_BAR;
        PG8_WAIT_V(4); PG8_BAR;
        PG8_STAGE(PG8_SB(1, 0), cB + kstep, voffB); PG8_STAGE(PG8_SA(1, 0), cA + kstep, voffA); PG8_STAGE(PG8_SB(1, 1), cB + hstep + kstep, voffB);
        PG8_WAIT_V(6); PG8_BAR;
    }
    for (;;) {
        const bool has_next = S.next(ui + 1, nxt);
        const char* nA = has_next ? (const char*)g.A + (size_t)nxt.pm * tstep : cA; const char* nB = has_next ? (const char*)g.Bt + (size_t)nxt.pn * tstep : cB;
#pragma unroll 1
        for (int t = 0; t < nt; t += 2) {
            const bool last = (t == nt - 2);
            const char* a1 = cA + (size_t)(t + 1) * kstep;
            const char* a2 = last ? nA : cA + (size_t)(t + 2) * kstep; const char* b2 = last ? nB : cB + (size_t)(t + 2) * kstep;
            const char* a3 = a2 + kstep; const char* b3 = b2 + kstep;
            if (last && has_next) S.a_ready(nxt);
            if constexpr (SP2) {
            PG8_LDB(B0, 0, 0); PG8_LDB(B1, 0, 1); PG8_SCHED; PG8_LDA(At, 0, 0); PG8_STAGE(PG8_SA(1, 1), a1 + hstep, voffA);
            PG8_WAIT_V(8); PG8_WAIT_L(0); PG8_BAR; PG8_MMA(0, 0, At, B0); PG8_MMA(0, 1, At, B1); PG8_BAR; PG8_SCHED;
            PG8_LDA(At, 0, 1); PG8_STAGE(PG8_SB(0, 0), b2, voffB); PG8_STAGE(PG8_SB(0, 1), b2 + hstep, voffB); PG8_STAGE(PG8_SA(0, 0), a2, voffA);
            PG8_WAIT_V(8); PG8_WAIT_L(0); PG8_BAR; PG8_MMA(1, 0, At, B0); PG8_MMA(1, 1, At, B1); PG8_BAR; PG8_SCHED;
            PG8_LDB(B0, 1, 0); PG8_LDB(B1, 1, 1); PG8_SCHED; PG8_LDA(At, 1, 0); PG8_STAGE(PG8_SA(0, 1), a2 + hstep, voffA);
            PG8_WAIT_V(8); PG8_WAIT_L(0); PG8_BAR; PG8_MMA(0, 0, At, B0); PG8_MMA(0, 1, At, B1); PG8_BAR; PG8_SCHED;
            PG8_LDA(At, 1, 1); PG8_STAGE(PG8_SB(1, 0), b3, voffB); PG8_STAGE(PG8_SB(1, 1), b3 + hstep, voffB); PG8_STAGE(PG8_SA(1, 0), a3, voffA);
            PG8_WAIT_V(8); PG8_WAIT_L(0); PG8_BAR; PG8_MMA(1, 0, At, B0); PG8_MMA(1, 1, At, B1); PG8_BAR; PG8_SCHED;
            } else {
            PG8_LDB(B0, 0, 0); PG8_SCHED; PG8_LDA(At, 0, 0); PG8_STAGE(PG8_SA(1, 1), a1 + hstep, voffA);
            PG8_WAIT_L(8); PG8_BAR; PG8_WAIT_L(0); PG8_MMA(0, 0, At, B0); PG8_BAR; PG8_SCHED;
            PG8_LDB(B1, 0, 1); PG8_STAGE(PG8_SB(0, 0), b2, voffB);
            PG8_BAR; PG8_WAIT_L(0); PG8_MMA(0, 1, At, B1); PG8_BAR;
            PG8_LDA(At, 0, 1); PG8_STAGE(PG8_SA(0, 0), a2, voffA);
            PG8_BAR; PG8_WAIT_L(0); PG8_MMA(1, 0, At, B0); PG8_BAR; PG8_SCHED;
            PG8_STAGE(PG8_SB(0, 1), b2 + hstep, voffB);
            PG8_WAIT_V(6); PG8_BAR; PG8_MMA(1, 1, At, B1); PG8_BAR;
            PG8_LDB(B0, 1, 0); PG8_SCHED; PG8_LDA(At, 1, 0); PG8_STAGE(PG8_SA(0, 1), a2 + hstep, voffA);
            PG8_WAIT_L(8); PG8_BAR; PG8_WAIT_L(0); PG8_MMA(0, 0, At, B0); PG8_BAR; PG8_SCHED;
            PG8_LDB(B1, 1, 1); PG8_STAGE(PG8_SB(1, 0), b3, voffB);
            PG8_BAR; PG8_WAIT_L(0); PG8_MMA(0, 1, At, B1); PG8_BAR;
            PG8_LDA(At, 1, 1); PG8_STAGE(PG8_SA(1, 0), a3, voffA);
            PG8_BAR; PG8_WAIT_L(0); PG8_MMA(1, 0, At, B0); PG8_BAR; PG8_SCHED;
            PG8_STAGE(PG8_SB(1, 1), b3 + hstep, voffB);
            PG8_WAIT_V(6); PG8_BAR; PG8_MMA(1, 1, At, B1); PG8_BAR;
            }
        }
        if constexpr (ALIGN_EPI) { if (wr == 0) PG8_BAR; }
        if constexpr (!Epi::AFTER_DRAIN) { E(acc, cur, wr, wc, fr, fq); S.done(cur); }
        if (!has_next) break;
#pragma unroll
        for (int a = 0; a < 2; ++a)
#pragma unroll
            for (int b = 0; b < 2; ++b)
#pragma unroll
                for (int m = 0; m < 4; ++m)
#pragma unroll
                    for (int n = 0; n < 2; ++n) acc[a][b][m][n] = (f32x4){0.f, 0.f, 0.f, 0.f};
        cur = nxt; cA = nA; cB = nB; ++ui;
        if constexpr (ALIGN_EPI) { if (wr == 1) PG8_BAR; }
    }
    PG8_WAIT_V(0);
    if constexpr (!ALIGN_EPI) { if (wr == 0) PG8_BAR; }
    PG8_BAR;
    if constexpr (Epi::AFTER_DRAIN) { E.fused(acc, cur, wr, wc, fr, fq, lds, wid, lane); S.done(cur); }
#undef PG8_SA
#undef PG8_SB
#undef PG8_STAGE
#undef PG8_LDA
#undef PG8_LDB
#undef PG8_MMA
#undef PG8_WAIT_V
#undef PG8_WAIT_L
#undef PG8_BAR
#undef PG8_SCHED
}
}

#ifndef MK_SPLIT
#define MK_SPLIT 0
#endif
constexpr int NWAVES = 8, NTHR = 512;
constexpr int BATCH = 8, SEQ = 8192, D = 1024, M = BATCH * SEQ;
constexpr int PCONV = 1536, PT = 3328, FF = 4096, RW = 512;
constexpr int LK = 256, LN = 1536;
constexpr int NMOD = 6 * D;
constexpr int NPHASE = 12;
constexpr size_t MiB = 1u << 20;
constexpr size_t WS_MOD = 0, CTL_ZERO_BYTES = 256 * 1024;
constexpr size_t WS_WIN = 1 * MiB, WS_WOUT = 8 * MiB, WS_WUP = 10 * MiB, WS_WDN = 18 * MiB, WS_LT = 26 * MiB;
constexpr size_t WS_XN = 32 * MiB;
constexpr size_t WS_Y = 32 * MiB;
constexpr size_t WS_P = 160 * MiB;
constexpr size_t WS_DEC = 160 * MiB, WS_KP = 288 * MiB, WS_BV = 352 * MiB, WS_G = 416 * MiB;
constexpr size_t WS_H = 160 * MiB;
constexpr size_t WS_RL = 576 * MiB, WS_KL = 640 * MiB, WS_VL = 704 * MiB, WS_KK = 768 * MiB;
constexpr size_t WS_LA = 832 * MiB;
constexpr size_t WS_MIX = 864 * MiB;
constexpr size_t WS_END = 992 * MiB;
constexpr int LDS_MISC = 131072, LDS_BYTES = 131072 + 2048;

typedef unsigned short bf16;
typedef float f32x4 __attribute__((ext_vector_type(4)));
typedef float f32x2 __attribute__((ext_vector_type(2)));
typedef unsigned u32x4 __attribute__((ext_vector_type(4)));
typedef unsigned u32x2 __attribute__((ext_vector_type(2)));
#define LAS __attribute__((address_space(3)))

__device__ __forceinline__ unsigned pk2(float lo, float hi) { return pg8::cvt_pk_bf16(lo, hi); }
__device__ __forceinline__ float bflo(unsigned w) { return __uint_as_float(w << 16); }
__device__ __forceinline__ float bfhi(unsigned w) { return __uint_as_float(w & 0xffff0000u); }
__device__ __forceinline__ void unpack8(const u32x4 w, float (&f)[8]) {
    f[0] = bflo(w.x); f[1] = bfhi(w.x); f[2] = bflo(w.y); f[3] = bfhi(w.y); f[4] = bflo(w.z); f[5] = bfhi(w.z); f[6] = bflo(w.w); f[7] = bfhi(w.w);
}
__device__ __forceinline__ u32x4 pack8(const float (&f)[8]) { u32x4 w; w.x = pk2(f[0], f[1]); w.y = pk2(f[2], f[3]); w.z = pk2(f[4], f[5]); w.w = pk2(f[6], f[7]); return w; }
__device__ __forceinline__ void ld8f(const float* p, float (&f)[8]) { const f32x4 a = *(const f32x4*)p, b = *(const f32x4*)(p + 4); f[0] = a.x; f[1] = a.y; f[2] = a.z; f[3] = a.w; f[4] = b.x; f[5] = b.y; f[6] = b.z; f[7] = b.w; }
__device__ __forceinline__ float wave_sum(float v) {
#pragma unroll
    for (int o = 1; o < 64; o <<= 1) v += __shfl_xor(v, o);
    return v;
}
__device__ __forceinline__ float sum8(float v) { v += __shfl_xor(v, 1); v += __shfl_xor(v, 2); v += __shfl_xor(v, 4); return v; }
__device__ __forceinline__ float sigmoidf_(float x) { return 1.0f / (1.0f + __expf(-x)); }

struct Args { const float* in[21]; float* out; unsigned char* ws; int ph_lo, ph_hi; };

template <int ACT  > struct EpiBf {
    static constexpr bool PERM = true, AFTER_DRAIN = false;
    bf16* O; int ldc;
    __device__ __forceinline__ void operator()(const pg8::f32x4 (&acc)[2][2][4][2], const pg8::Unit& u, int wr, int wc, int fr, int fq) const {
        const int row0 = u.pm * 256 + wr * 64 + fr, col0 = u.pn * 256 + wc * 32 + 8 * fq;
#pragma unroll
        for (int ai = 0; ai < 2; ++ai)
#pragma unroll
            for (int m = 0; m < 4; ++m) { bf16* rowp = O + (size_t)(row0 + ai * 128 + m * 16) * ldc + col0;
#pragma unroll
                for (int bj = 0; bj < 2; ++bj) { pg8::f32x4 v0 = acc[ai][bj][m][0], v1 = acc[ai][bj][m][1];
                    if (ACT == 1) {
#pragma unroll
                        for (int j = 0; j < 4; ++j) { const float a = fmaxf(v0[j], 0.f), b = fmaxf(v1[j], 0.f); v0[j] = a * a; v1[j] = b * b; } }
                    u32x4 w; w.x = pk2(v0[0], v0[1]); w.y = pk2(v0[2], v0[3]); w.z = pk2(v1[0], v1[1]); w.w = pk2(v1[2], v1[3]);
                    *(u32x4*)(rowp + bj * 128) = w; } }
    }
};
struct EpiRes {
    static constexpr bool PERM = false, AFTER_DRAIN = false;
    const float* X; float* O; const float* gate;
    __device__ __forceinline__ void operator()(const pg8::f32x4 (&acc)[2][2][4][2], const pg8::Unit& u, int wr, int wc, int fr, int fq) const {
        const int row0 = u.pm * 256 + wr * 64 + fr, col0 = u.pn * 256 + wc * 32 + 4 * fq, b = u.pm >> 5;
        f32x4 gv[2][2];
#pragma unroll
        for (int bj = 0; bj < 2; ++bj)
#pragma unroll
            for (int n = 0; n < 2; ++n) gv[bj][n] = *(const f32x4*)(gate + (size_t)b * NMOD + col0 + bj * 128 + n * 16);
#pragma unroll
        for (int ai = 0; ai < 2; ++ai)
#pragma unroll
            for (int m = 0; m < 4; ++m) { const size_t off = (size_t)(row0 + ai * 128 + m * 16) * D + col0;
#pragma unroll
                for (int bj = 0; bj < 2; ++bj)
#pragma unroll
                    for (int n = 0; n < 2; ++n) { const f32x4 xv = *(const f32x4*)(X + off + bj * 128 + n * 16);
                        *(f32x4*)(O + off + bj * 128 + n * 16) = xv + gv[bj][n] * acc[ai][bj][m][n]; }
                asm volatile("" ::: "memory"); }
    }
};
#ifndef LK0
#define LK0 1
#endif
#ifndef LK1
#define LK1 1
#endif
#ifndef LK2
#define LK2 1
#endif
struct EpiLora {
    static constexpr bool PERM = true, AFTER_DRAIN = false;
    const float *w0, *a0, *k_a; const bf16 *KL, *KK; float* DEC; bf16 *KP, *BV, *G;
    __device__ __forceinline__ void operator()(const pg8::f32x4 (&acc)[2][2][4][2], const pg8::Unit& u, int wr, int wc, int fr, int fq) const {
        const int kind = u.pn >> 1, row0 = u.pm * 256 + wr * 64 + fr, cb = (u.pn & 1) * 256 + wc * 32 + 8 * fq;
#pragma unroll
        for (int bj = 0; bj < 2; ++bj) {
            const int c = cb + bj * 128;
            if (LK0 && kind == 0) {
                float wv[8]; ld8f(w0 + c, wv);
#pragma unroll
                for (int ai = 0; ai < 2; ++ai)
#pragma unroll
                    for (int m = 0; m < 4; ++m) { const size_t off = (size_t)(row0 + ai * 128 + m * 16) * RW + c; f32x4 o[2];
#pragma unroll
                        for (int n = 0; n < 2; ++n)
#pragma unroll
                            for (int j = 0; j < 4; ++j) { const float pre = acc[ai][bj][m][n][j] + wv[4 * n + j];
                                o[n][j] = __expf(-0.6065306597f * sigmoidf_(pre)); }
                        *(f32x4*)(DEC + off) = o[0]; *(f32x4*)(DEC + off + 4) = o[1]; asm volatile("" ::: "memory"); }
            } else if (LK1 && kind == 1) {
                float av[8], kav[8]; ld8f(a0 + c, av); ld8f(k_a + c, kav);
#pragma unroll
                for (int ai = 0; ai < 2; ++ai)
#pragma unroll
                    for (int m = 0; m < 4; ++m) { const size_t off = (size_t)(row0 + ai * 128 + m * 16) * RW + c;
                        float kf[8], kkf[8], kp[8], bv[8]; unpack8(*(const u32x4*)(KL + off), kf); unpack8(*(const u32x4*)(KK + off), kkf);
#pragma unroll
                        for (int n = 0; n < 2; ++n)
#pragma unroll
                            for (int j = 0; j < 4; ++j) { const int i = 4 * n + j; const float a = sigmoidf_(acc[ai][bj][m][n][j] + av[i]);
                                kp[i] = kf[i] * (1.0f + (a - 1.0f) * kav[i]); bv[i] = kkf[i] * a; }
                        *(u32x4*)(KP + off) = pack8(kp); *(u32x4*)(BV + off) = pack8(bv); asm volatile("" ::: "memory"); }
            } else if (LK2) {
#pragma unroll
                for (int ai = 0; ai < 2; ++ai)
#pragma unroll
                    for (int m = 0; m < 4; ++m) { const size_t off = (size_t)(row0 + ai * 128 + m * 16) * RW + c;
                        const pg8::f32x4 v0 = acc[ai][bj][m][0], v1 = acc[ai][bj][m][1];
                        u32x4 w; w.x = pk2(v0[0], v0[1]); w.y = pk2(v0[2], v0[3]); w.z = pk2(v1[0], v1[1]); w.w = pk2(v1[2], v1[3]);
                        *(u32x4*)(G + off) = w; }
            }
        }
    }
};

__device__ __forceinline__ void transpose_item(const float* W, int K, int N, bf16* WT, LAS float* scr, int item, int lane) {
    const int nblk = N / 32, kb = item / nblk, nb = item % nblk, k0 = 64 * kb, n0 = 32 * nb;
#pragma unroll 8
    for (int i = 0; i < 32; ++i) { const int kk = 2 * i + (lane >> 5); scr[kk * 33 + (lane & 31)] = W[(size_t)(k0 + kk) * N + n0 + (lane & 31)]; }
    asm volatile("s_waitcnt lgkmcnt(0)" ::: "memory");
    const int c = lane & 7;
#pragma unroll
    for (int j = 0; j < 4; ++j) { const int n = (lane >> 3) + 8 * j; const LAS float* s = scr + (8 * c) * 33 + n;
        u32x4 o; o.x = pk2(s[0 * 33], s[1 * 33]); o.y = pk2(s[2 * 33], s[3 * 33]); o.z = pk2(s[4 * 33], s[5 * 33]); o.w = pk2(s[6 * 33], s[7 * 33]);
        *(u32x4*)(WT + (size_t)(n0 + n) * K + k0 + 8 * c) = o; }
    asm volatile("s_waitcnt lgkmcnt(0)" ::: "memory");
}
__device__ __forceinline__ void p0_prologue(const Args& A, LAS unsigned char* lds, int tid, int lane, int wave) {
    unsigned char* ws = A.ws;
    {
        const float* c = A.in[1]; const float* w_ada = A.in[2]; const float* b_ada = A.in[3]; float* MOD = (float*)(ws + WS_MOD);
        LAS float* cs = (LAS float*)(lds + LDS_MISC);
        for (int item = blockIdx.x; item < 384; item += gridDim.x) {
            const int kc = item / 12, cb = item % 12;
            __syncthreads();
            if (tid < 256) { const float cv = c[(tid >> 5) * D + kc * 32 + (tid & 31)]; cs[tid] = cv * sigmoidf_(cv); }
            __syncthreads();
            const int col = cb * 512 + tid;
            float acc[8];
#pragma unroll
            for (int b = 0; b < 8; ++b) acc[b] = 0.f;
#pragma unroll 4
            for (int kk = 0; kk < 32; ++kk) { const float w = w_ada[(size_t)(kc * 32 + kk) * NMOD + col];
#pragma unroll
                for (int b = 0; b < 8; ++b) acc[b] += cs[b * 32 + kk] * w; }
            const float bias = (kc == 0) ? b_ada[col] : 0.f;
#pragma unroll
            for (int b = 0; b < 8; ++b) unsafeAtomicAdd(MOD + b * NMOD + col, acc[b] + bias);
        }
        __syncthreads();
    }
    {
        LAS float* scr = (LAS float*)(lds + wave * 16384);
        const int gw = blockIdx.x * NWAVES + wave, NGW = gridDim.x * NWAVES;
        constexpr int I_IN = (D / 64) * (PT / 32), I_OUT = (D / 64) * (D / 32), I_UP = (D / 64) * (FF / 32), I_DN = (FF / 64) * (D / 32);
        for (int it = gw; it < I_IN + I_OUT + I_UP + I_DN; it += NGW) {
            int r = it;
            if (r < I_IN) { transpose_item(A.in[4], D, PT, (bf16*)(ws + WS_WIN), scr, r, lane); continue; } r -= I_IN;
            if (r < I_OUT) { transpose_item(A.in[17], D, D, (bf16*)(ws + WS_WOUT), scr, r, lane); continue; } r -= I_OUT;
            if (r < I_UP) { transpose_item(A.in[18], D, FF, (bf16*)(ws + WS_WUP), scr, r, lane); continue; } r -= I_UP;
            transpose_item(A.in[19], FF, D, (bf16*)(ws + WS_WDN), scr, r, lane);
        }
    }
    {
        const float* w2 = A.in[8]; const float* a2 = A.in[10]; const float* g2 = A.in[11]; bf16* LT = (bf16*)(ws + WS_LT);
        for (int idx = blockIdx.x * NTHR + tid; idx < LN * LK; idx += gridDim.x * NTHR) {
            const int n = idx >> 8, k = idx & 255; float v = 0.f;
            if (n < 512) { if (k < 64) v = w2[k * 512 + n]; }
            else if (n < 1024) { if (k >= 64 && k < 128) v = a2[(k - 64) * 512 + (n - 512)]; }
            else { if (k >= 128) v = g2[(k - 128) * 512 + (n - 1024)]; }
            LT[idx] = (bf16)(pk2(v, 0.f) & 0xffffu);
        }
    }
}

__device__ __forceinline__ void norm_mod_row(const float* xrow, bf16* orow, const float* sh, const float* sc, int lane) {
    const f32x4* xr = (const f32x4*)xrow + lane;
    f32x4 v[4]; float s = 0.f;
#pragma unroll
    for (int j = 0; j < 4; ++j) { v[j] = xr[64 * j]; s += (v[j].x * v[j].x + v[j].y * v[j].y) + (v[j].z * v[j].z + v[j].w * v[j].w); }
    const float rstd = rsqrtf(wave_sum(s) * (1.f / D) + 1e-6f);
#pragma unroll
    for (int j = 0; j < 4; ++j) { const f32x4 a = ((const f32x4*)sc)[lane + 64 * j], b = ((const f32x4*)sh)[lane + 64 * j];
        const f32x4 h = v[j] * rstd * (1.f + a) + b;
        ((u32x2*)orow)[lane + 64 * j] = (u32x2){pk2(h.x, h.y), pk2(h.z, h.w)}; }
}
__device__ __forceinline__ void final_row(float* xrow, const float* g, int lane) {
    f32x4* xr = (f32x4*)xrow + lane;
    f32x4 v[4]; float s = 0.f;
#pragma unroll
    for (int j = 0; j < 4; ++j) { v[j] = xr[64 * j]; s += (v[j].x * v[j].x + v[j].y * v[j].y) + (v[j].z * v[j].z + v[j].w * v[j].w); }
    const float rstd = rsqrtf(wave_sum(s) * (1.f / D) + 1e-6f);
#pragma unroll
    for (int j = 0; j < 4; ++j) xr[64 * j] = v[j] * rstd * ((const f32x4*)g)[lane + 64 * j];
}
__device__ __forceinline__ void mix_row(const Args& A, int m, int lane) {
    unsigned char* ws = A.ws;
    const bf16* P = (const bf16*)(ws + WS_P);
    const bf16* prow = P + (size_t)m * PT;
    const int tt = m & (SEQ - 1);
    const bool has1 = tt >= 1, has2 = tt >= 2;
    const u32x4 zero4 = (u32x4){0u, 0u, 0u, 0u};
    const int ch = 8 * lane;
    {
        const float* cw = A.in[5];
        float bg[8], c0[8], u0[8], c1[8], u1[8], c2[8], u2[8], w0[8], w1[8], w2[8], y[8];
        unpack8(*(const u32x4*)(prow + ch), bg);
        unpack8(*(const u32x4*)(prow + 512 + ch), c0); unpack8(*(const u32x4*)(prow + 1024 + ch), u0);
        unpack8(has1 ? *(const u32x4*)(prow - PT + 512 + ch) : zero4, c1); unpack8(has1 ? *(const u32x4*)(prow - PT + 1024 + ch) : zero4, u1);
        unpack8(has2 ? *(const u32x4*)(prow - 2 * PT + 512 + ch) : zero4, c2); unpack8(has2 ? *(const u32x4*)(prow - 2 * PT + 1024 + ch) : zero4, u2);
        ld8f(cw + ch, w0); ld8f(cw + 512 + ch, w1); ld8f(cw + 1024 + ch, w2);
#pragma unroll
        for (int i = 0; i < 8; ++i) y[i] = bg[i] * (w0[i] * (c2[i] * u2[i]) + w1[i] * (c1[i] * u1[i]) + w2[i] * (c0[i] * u0[i]));
        *(u32x4*)((bf16*)(ws + WS_MIX) + (size_t)m * D + ch) = pack8(y);
    }
    const bf16* q = prow + PCONV;
    const float* mu = A.in[6];
    {
        float cur[8], prv[8], mv[8], o[8];
        const size_t off = (size_t)m * RW + ch;
        unpack8(*(const u32x4*)(q + ch), cur); unpack8(has1 ? *(const u32x4*)(q - PT + ch) : zero4, prv); ld8f(mu + ch, mv);
#pragma unroll
        for (int i = 0; i < 8; ++i) o[i] = cur[i] + (prv[i] - cur[i]) * mv[i];
        *(u32x4*)((bf16*)(ws + WS_RL) + off) = pack8(o);
        unpack8(*(const u32x4*)(q + 1024 + ch), cur); unpack8(has1 ? *(const u32x4*)(q - PT + 1024 + ch) : zero4, prv); ld8f(mu + 1024 + ch, mv);
#pragma unroll
        for (int i = 0; i < 8; ++i) o[i] = cur[i] + (prv[i] - cur[i]) * mv[i];
        *(u32x4*)((bf16*)(ws + WS_VL) + off) = pack8(o);
        unpack8(*(const u32x4*)(q + 512 + ch), cur); unpack8(has1 ? *(const u32x4*)(q - PT + 512 + ch) : zero4, prv); ld8f(mu + 512 + ch, mv);
#pragma unroll
        for (int i = 0; i < 8; ++i) o[i] = cur[i] + (prv[i] - cur[i]) * mv[i];
        *(u32x4*)((bf16*)(ws + WS_KL) + off) = pack8(o);
        float kkv[8], kk8[8]; ld8f(A.in[12] + ch, kk8); float ss = 0.f;
#pragma unroll
        for (int i = 0; i < 8; ++i) { kkv[i] = o[i] * kk8[i]; ss += kkv[i] * kkv[i]; }
        ss = sum8(ss);
        const float inv = 1.0f / fmaxf(sqrtf(ss), 1e-12f);
#pragma unroll
        for (int i = 0; i < 8; ++i) kkv[i] *= inv;
        *(u32x4*)((bf16*)(ws + WS_KK) + off) = pack8(kkv);
    }
    {
        const int c4 = 4 * lane;
        const u32x2 cw = *(const u32x2*)(q + 1536 + c4); const u32x2 pw = has1 ? *(const u32x2*)(q - PT + 1536 + c4) : (u32x2){0u, 0u};
        const f32x4 mv = *(const f32x4*)(mu + 1536 + c4);
        float cur[4] = {bflo(cw.x), bfhi(cw.x), bflo(cw.y), bfhi(cw.y)}, prv[4] = {bflo(pw.x), bfhi(pw.x), bflo(pw.y), bfhi(pw.y)}, o[4];
#pragma unroll
        for (int i = 0; i < 4; ++i) { const float xl = cur[i] + (prv[i] - cur[i]) * mv[i];
            const float sg = sigmoidf_(lane < 16 ? 2.0f * xl : xl);
            o[i] = lane < 16 ? (2.0f * sg - 1.0f) : (lane < 32 ? xl : sg); }
        *(u32x2*)((bf16*)(ws + WS_LA) + (size_t)m * LK + c4) = (u32x2){pk2(o[0], o[1]), pk2(o[2], o[3])};
    }
}
__device__ __forceinline__ void post_row(const Args& A, int m, int lane) {
    unsigned char* ws = A.ws;
    const int ch = 8 * lane; const size_t off = (size_t)m * RW + ch;
    float y[8], r[8], kp[8], v[8], g[8], rk[8], lg[8], lb[8], o[8];
    ld8f((const float*)(ws + WS_Y) + off, y);
    unpack8(*(const u32x4*)((const bf16*)(ws + WS_RL) + off), r); unpack8(*(const u32x4*)((const bf16*)(ws + WS_KP) + off), kp);
    unpack8(*(const u32x4*)((const bf16*)(ws + WS_VL) + off), v); unpack8(*(const u32x4*)((const bf16*)(ws + WS_G) + off), g);
    ld8f(A.in[14] + ch, rk); ld8f(A.in[15] + ch, lg); ld8f(A.in[16] + ch, lb);
    float s = 0.f, bs = 0.f;
#pragma unroll
    for (int i = 0; i < 8; ++i) { s += y[i]; bs += r[i] * kp[i] * rk[i]; }
    s = sum8(s); bs = sum8(bs);
    const float mean = s * (1.f / 64.f); float q = 0.f;
#pragma unroll
    for (int i = 0; i < 8; ++i) { y[i] -= mean; q += y[i] * y[i]; }
    q = sum8(q);
    const float rstd = rsqrtf(q * (1.f / 64.f) + 64e-5f);
#pragma unroll
    for (int i = 0; i < 8; ++i) o[i] = (y[i] * rstd * lg[i] + lb[i] + bs * v[i]) * g[i];
    *(u32x4*)((bf16*)(ws + WS_MIX) + (size_t)m * D + 512 + ch) = pack8(o);
}

constexpr int TC = 32, NCH = SEQ / TC;
constexpr int OPB = 5 * TC * 256 + TC * 64;
constexpr int YB_OFF = 2 * OPB, DUMP_OFF = YB_OFF + 4096;
static_assert(DUMP_OFF + 4608 <= 131072, "scan LDS");
#define SCAN_BAR() do { asm volatile("s_waitcnt lgkmcnt(0)" ::: "memory"); __builtin_amdgcn_s_barrier(); asm volatile("" ::: "memory"); } while (0)
template <int CTRL> __device__ __forceinline__ float dpp_add(float x) {
    return x + __builtin_bit_cast(float, __builtin_amdgcn_update_dpp(0, __builtin_bit_cast(int, x), CTRL, 0xf, 0xf, false));
}
__device__ __forceinline__ float rsum16(float x) { x = dpp_add<0x128>(x); x = dpp_add<0x124>(x); x = dpp_add<0x122>(x); x = dpp_add<0x121>(x); return x; }
struct ScanRegs { u32x4 rl, kp, kk, bv, vv; f32x4 d0, d1; };
__device__ __forceinline__ void st8(LAS unsigned char* p, const u32x4 w) {
    *(LAS f32x4*)p = (f32x4){bflo(w.x), bfhi(w.x), bflo(w.y), bfhi(w.y)}; *(LAS f32x4*)(p + 16) = (f32x4){bflo(w.z), bfhi(w.z), bflo(w.w), bfhi(w.w)};
}
__device__ __forceinline__ void scan_phase(unsigned char* ws, LAS unsigned char* lds, int tid, int lane, int wid) {
    const bf16* RL = (const bf16*)(ws + WS_RL); const bf16* KP = (const bf16*)(ws + WS_KP); const bf16* KK = (const bf16*)(ws + WS_KK);
    const bf16* BV = (const bf16*)(ws + WS_BV); const bf16* VL = (const bf16*)(ws + WS_VL); const float* DEC = (const float*)(ws + WS_DEC);
    float* Y = (float*)(ws + WS_Y);
    for (int item = blockIdx.x; item < 256; item += gridDim.x) {
        const int xcd = item & 7, slot = item >> 3, bh = xcd * 8 + (slot >> 2), q = slot & 3, b = bh >> 3, h = bh & 7;
        const size_t rowbase = (size_t)b * SEQ;
        const bool loader = wid >= 4;
        const int L = tid - 256;
        const int lt = L >> 3, lc = (L & 7) * 8;
        ScanRegs R;
#define SCAN_ISSUE(cc) do { const size_t o_ = (rowbase + (size_t)(cc) * TC + lt) * RW + h * 64 + lc; \
            R.rl = *(const u32x4*)(RL + o_); R.kp = *(const u32x4*)(KP + o_); R.kk = *(const u32x4*)(KK + o_); R.bv = *(const u32x4*)(BV + o_); \
            R.d0 = *(const f32x4*)(DEC + o_); R.d1 = *(const f32x4*)(DEC + o_ + 4); \
            if (wid == 4) R.vv = *(const u32x4*)(VL + (rowbase + (size_t)(cc) * TC + (lane >> 1)) * RW + h * 64 + q * 16 + (lane & 1) * 8); } while (0)
#define SCAN_WRITE(buf) do { LAS unsigned char* ob_ = lds + (buf) * OPB + lt * 256 + lc * 4; \
            st8(ob_ + 0 * TC * 256, R.rl); *(LAS f32x4*)(ob_ + 1 * TC * 256) = R.d0; *(LAS f32x4*)(ob_ + 1 * TC * 256 + 16) = R.d1; \
            st8(ob_ + 2 * TC * 256, R.kp); st8(ob_ + 3 * TC * 256, R.kk); st8(ob_ + 4 * TC * 256, R.bv); \
            if (wid == 4) st8(lds + (buf) * OPB + 5 * TC * 256 + (lane >> 1) * 64 + (lane & 1) * 32, R.vv); } while (0)
#define SCAN_FLUSH(cc) do { if (L < 128) { const f32x4 yv_ = *(LAS const f32x4*)(lds + YB_OFF + ((cc) & 1) * 2048 + (L >> 2) * 64 + (L & 3) * 16); \
            *(f32x4*)(Y + (rowbase + (size_t)(cc) * TC + (L >> 2)) * RW + h * 64 + q * 16 + (L & 3) * 4) = yv_; } } while (0)
        const int rg = lane >> 4, cl = lane & 15, rb = (wid & 3) * 4 + rg;
        f32x2 S01 = (f32x2){0.f, 0.f}, S23 = (f32x2){0.f, 0.f};
        const unsigned opoff = cl * 16, voff = 5 * TC * 256 + rb * 4;
        const unsigned ybase = (cl == 0) ? (unsigned)(YB_OFF + rb * 4) : (unsigned)(DUMP_OFF + lane * 4);
        if (loader) { SCAN_ISSUE(0); SCAN_WRITE(0); SCAN_ISSUE(1); }
        SCAN_BAR();
        for (int c = 0; c < NCH; ++c) {
            if (!loader) {
                LAS const unsigned char* ob = lds + (c & 1) * OPB;
                LAS unsigned char* yb = lds + ybase + (c & 1) * 2048;
#pragma unroll 8
                for (int t = 0; t < TC; ++t) {
                    const f32x4 r = *(LAS const f32x4*)(ob + opoff + (0 * TC + t) * 256);
                    const f32x4 w = *(LAS const f32x4*)(ob + opoff + (1 * TC + t) * 256);
                    const f32x4 k = *(LAS const f32x4*)(ob + opoff + (2 * TC + t) * 256);
                    const f32x4 a = *(LAS const f32x4*)(ob + opoff + (3 * TC + t) * 256);
                    const f32x4 bb = *(LAS const f32x4*)(ob + opoff + (4 * TC + t) * 256);
                    const float v = *(LAS const float*)(ob + voff + t * 64);
                    const f32x2 sp2 = S01 * (f32x2){a.x, a.y} + S23 * (f32x2){a.z, a.w};
                    const float sa = rsum16(sp2.x + sp2.y);
                    const f32x2 vv = (f32x2){v, v}, nsa = (f32x2){-sa, -sa};
                    const f32x2 t01 = vv * (f32x2){k.x, k.y} + nsa * (f32x2){bb.x, bb.y};
                    const f32x2 t23 = vv * (f32x2){k.z, k.w} + nsa * (f32x2){bb.z, bb.w};
                    S01 = S01 * (f32x2){w.x, w.y} + t01;
                    S23 = S23 * (f32x2){w.z, w.w} + t23;
                    const f32x2 yp2 = S01 * (f32x2){r.x, r.y} + S23 * (f32x2){r.z, r.w};
                    const float yv = rsum16(yp2.x + yp2.y);
                    *(LAS float*)(yb + t * 64) = yv;
                }
            } else {
                if (c + 1 < NCH) SCAN_WRITE((c + 1) & 1);
                if (c + 2 < NCH) SCAN_ISSUE(c + 2);
                if (c >= 1) SCAN_FLUSH(c - 1);
            }
            SCAN_BAR();
        }
        if (loader) SCAN_FLUSH(NCH - 1);
        SCAN_BAR();
#undef SCAN_ISSUE
#undef SCAN_WRITE
#undef SCAN_FLUSH
    }
}

__global__ void __launch_bounds__(NTHR, 2) fwd_megakernel(Args A) {
    extern __shared__ __attribute__((aligned(16))) unsigned char lds_raw[];
    LAS unsigned char* lds = (LAS unsigned char*)lds_raw;
    cg::grid_group grid = cg::this_grid();
    const int tid = threadIdx.x, lane = tid & 63, wave = __builtin_amdgcn_readfirstlane(tid >> 6);
    unsigned char* ws = A.ws;
    const int lo = A.ph_lo, hi = A.ph_hi;
    const int gw = blockIdx.x * NWAVES + wave, NGW = gridDim.x * NWAVES;
    float* MOD = (float*)(ws + WS_MOD);
#ifndef PHASE_MASK
#define PHASE_MASK 0xfff
#endif
#define IN(k) (((PHASE_MASK >> (k)) & 1) && lo <= (k) && (k) < hi)
#define SEAM(k) do { if (IN(k) && IN((k) + 1)) grid.sync(); } while (0)

    if (IN(0)) { p0_prologue(A, lds, tid, lane, wave); } SEAM(0);
    if (IN(1)) {
        for (int m = gw; m < M; m += NGW) { const int b = m >> 13;
            norm_mod_row(A.in[0] + (size_t)m * D, (bf16*)(ws + WS_XN) + (size_t)m * D, MOD + b * NMOD + 0 * D, MOD + b * NMOD + 1 * D, lane); }
    } SEAM(1);
    if (IN(2)) {
        pg8::Gemm g{(const bf16*)(ws + WS_XN), (const bf16*)(ws + WS_WIN), M, PT, D}; pg8::StaticOrder S; S.init(M, PT, gridDim.x, blockIdx.x);
        EpiBf<0> E{(bf16*)(ws + WS_P), PT};
        pg8::gemm_phase<EpiBf<0>, pg8::StaticOrder, true, true>(lds, g, S, E);
    } SEAM(2);
    if (IN(3)) { for (int m = gw; m < M; m += NGW) mix_row(A, m, lane); } SEAM(3);
    if (IN(4)) {
        pg8::Gemm g{(const bf16*)(ws + WS_LA), (const bf16*)(ws + WS_LT), M, LN, LK}; pg8::StaticOrder S; S.init(M, LN, gridDim.x, blockIdx.x);
        EpiLora E{A.in[7], A.in[9], A.in[13], (const bf16*)(ws + WS_KL), (const bf16*)(ws + WS_KK), (float*)(ws + WS_DEC), (bf16*)(ws + WS_KP), (bf16*)(ws + WS_BV), (bf16*)(ws + WS_G)};
        pg8::gemm_phase<EpiLora, pg8::StaticOrder, true, true>(lds, g, S, E);
    } SEAM(4);
    if (IN(5)) { scan_phase(ws, lds, tid, lane, wave); } SEAM(5);
    if (IN(6)) { for (int m = gw; m < M; m += NGW) post_row(A, m, lane); } SEAM(6);
    if (IN(7)) {
        pg8::Gemm g{(const bf16*)(ws + WS_MIX), (const bf16*)(ws + WS_WOUT), M, D, D}; pg8::StaticOrder S; S.init(M, D, gridDim.x, blockIdx.x);
        EpiRes E{A.in[0], A.out, MOD + 2 * D};
        pg8::gemm_phase<EpiRes, pg8::StaticOrder, true, true>(lds, g, S, E);
    } SEAM(7);
    if (IN(8)) {
        for (int m = gw; m < M; m += NGW) { const int b = m >> 13;
            norm_mod_row(A.out + (size_t)m * D, (bf16*)(ws + WS_XN) + (size_t)m * D, MOD + b * NMOD + 3 * D, MOD + b * NMOD + 4 * D, lane); }
    } SEAM(8);
    if (IN(9)) {
        pg8::Gemm g{(const bf16*)(ws + WS_XN), (const bf16*)(ws + WS_WUP), M, FF, D}; pg8::StaticOrder S; S.init(M, FF, gridDim.x, blockIdx.x);
        EpiBf<1> E{(bf16*)(ws + WS_H), FF};
        pg8::gemm_phase<EpiBf<1>, pg8::StaticOrder, true, true>(lds, g, S, E);
    } SEAM(9);
    if (IN(10)) {
        pg8::Gemm g{(const bf16*)(ws + WS_H), (const bf16*)(ws + WS_WDN), M, D, FF}; pg8::StaticOrder S; S.init(M, D, gridDim.x, blockIdx.x);
        EpiRes E{A.out, A.out, MOD + 5 * D};
        pg8::gemm_phase<EpiRes, pg8::StaticOrder, true, true>(lds, g, S, E);
    } SEAM(10);
    if (IN(11)) { for (int m = gw; m < M; m += NGW) final_row(A.out + (size_t)m * D, A.in[20], lane); }
#undef IN
#undef SEAM
}

extern "C" void kernel_launch(void* const* d_in, const int* in_sizes, int n_in, void* d_out, int out_size, void* d_ws, size_t ws_size, hipStream_t stream) {
    static int grid_blocks = 0;
    if (grid_blocks == 0) {
        if (n_in != 21 || out_size != M * D || ws_size < WS_END) { fprintf(stderr, "kernel_launch: unexpected shapes (n_in %d out %d ws %zu)\n", n_in, out_size, ws_size); grid_blocks = -1; return; }
        int dev = 0, cus = 0, per_cu = 0;
        hipGetDevice(&dev);
        hipDeviceGetAttribute(&cus, hipDeviceAttributeMultiprocessorCount, dev);
        if (hipFuncSetAttribute((const void*)fwd_megakernel, hipFuncAttributeMaxDynamicSharedMemorySize, LDS_BYTES) != hipSuccess) { fprintf(stderr, "kernel_launch: hipFuncSetAttribute failed\n"); grid_blocks = -1; return; }
        if (hipOccupancyMaxActiveBlocksPerMultiprocessor(&per_cu, (const void*)fwd_megakernel, NTHR, LDS_BYTES) != hipSuccess || per_cu < 1) { fprintf(stderr, "kernel_launch: occupancy query failed (%d)\n", per_cu); grid_blocks = -1; return; }
        grid_blocks = cus * per_cu;
    }
    if (grid_blocks < 0) return;
    hipMemsetAsync((char*)d_ws + WS_MOD, 0, CTL_ZERO_BYTES, stream);
    Args a{};
    for (int i = 0; i < 21; ++i) a.in[i] = (const float*)d_in[i];
    a.out = (float*)d_out; a.ws = (unsigned char*)d_ws;
#if MK_SPLIT
    for (int ph = 0; ph < NPHASE; ++ph) {
        a.ph_lo = ph; a.ph_hi = ph + 1;
#else
    {
        a.ph_lo = 0; a.ph_hi = NPHASE;
#endif
        void* args[] = {&a};
        hipError_t e = hipLaunchCooperativeKernel((const void*)fwd_megakernel, dim3(grid_blocks), dim3(NTHR), args, LDS_BYTES, stream);
        if (e != hipSuccess) fprintf(stderr, "kernel_launch: cooperative launch failed: %s (grid %d)\n", hipGetErrorString(e), grid_blocks);
    }
}
```

```cpp
#include <hip/hip_runtime.h>
#include <hip/hip_cooperative_groups.h>
#include <cstdio>
#include <cstdint>
namespace cg = cooperative_groups;
namespace pg8 {
#define PG8_LAS __attribute__((address_space(3)))
typedef unsigned short bf16_t;
typedef short bf16x8 __attribute__((ext_vector_type(8)));
typedef float f32x4 __attribute__((ext_vector_type(4)));
typedef unsigned u32x4 __attribute__((ext_vector_type(4)));
constexpr int BM = 256, BK = 64, HALF = 128, HTB = HALF * BK * 2  , STAGE_BYTES = 8 * HTB, NXCD = 8, WGM = 8;

__host__ __device__ __forceinline__ int lds_byte(int r, int c) { const int st = (r >> 4) * 2 + (c >> 5), rr = r & 15, cc = c & 31, ob = rr * 64 + cc * 2; return st * 1024 + (ob ^ (((ob >> 9) & 1) << 5)); }
__host__ __device__ __forceinline__ void stage_rc(int b, int& R, int& C) { const int st = b / 1024, sb = b % 1024, swz = sb ^ (((sb >> 9) & 1) << 5); R = (st >> 1) * 16 + swz / 64; C = (st & 1) * 32 + (swz % 64) / 2; }
__host__ __device__ __forceinline__ int perm32(int rho) { const int n = rho >> 4, i = rho & 15; return 8 * (i >> 2) + 4 * n + (i & 3); }

struct Unit { int pm, pn; };
struct Gemm { const bf16_t* A; const bf16_t* Bt; int M, N, K; };

struct StaticOrder {
    int nM, nN, nwg, G, c;
    __host__ __device__ void init(int M, int N, int G_, int c_) { nM = M / BM; nN = N / BM; nwg = nM * nN; G = G_; c = c_; }
    __host__ __device__ bool next(int i, Unit& u) const {
        const long L = (long)i * G + c; if (L >= nwg) return false;
        int wgid = (int)L; { const int q = nwg / NXCD, r = nwg % NXCD, xcd = wgid % NXCD, off = wgid / NXCD; wgid = (xcd < r ? xcd * (q + 1) : r * (q + 1) + (xcd - r) * q) + off; }
        const int nig = WGM * nN, gid = wgid / nig, fm = gid * WGM, gsz = (nM - fm) < WGM ? (nM - fm) : WGM;
        u.pm = fm + ((wgid % nig) % gsz); u.pn = (wgid % nig) / gsz; return true;
    }
    __device__ __forceinline__ void a_ready(const Unit&) const {}
    __device__ __forceinline__ void done(const Unit&) const {}
};
__device__ __forceinline__ unsigned cvt_pk_bf16(float lo, float hi) { unsigned r; asm volatile("v_cvt_pk_bf16_f32 %0, %1, %2" : "=v"(r) : "v"(lo), "v"(hi)); return r; }
template <class Epi, class Sched, bool ALIGN_EPI = false, bool SP2 = false>
__device__ __forceinline__ void gemm_phase(PG8_LAS unsigned char* lds, const Gemm g, const Sched& S, const Epi& E) {
    const int tid = threadIdx.x, wid = __builtin_amdgcn_readfirstlane(tid >> 6), lane = tid & 63, wr = wid >> 2, wc = wid & 3, fr = lane & 15, fq = lane >> 4;
    const int K = g.K, nt = K / BK;
    unsigned voffA[2], voffB[2];
#pragma unroll
    for (int i = 0; i < 2; ++i) { int R, C; stage_rc(tid * 16 + i * 8192, R, C); const int Rb = Epi::PERM ? ((R & ~31) + perm32(R & 31)) : R;
        voffA[i] = (unsigned)(R * K + C) * 2u; voffB[i] = (unsigned)(Rb * K + C) * 2u; }
    const size_t kstep = (size_t)(BK * 2);
    const size_t hstep = (size_t)HALF * K * 2;
    const size_t tstep = 2 * hstep;
    const unsigned ldsw = (unsigned)wid * 1024u;
    const int aoff = lds_byte(wr * 64 + fr, fq * 8), boff = lds_byte(wc * 32 + fr, fq * 8);
#define PG8_SA(b, h) (((b) * 2 + (h)) * HTB)
#define PG8_SB(b, h) ((4 + (b) * 2 + (h)) * HTB)
#define PG8_STAGE(bufoff, gbase, voff) do { _Pragma("unroll") for (int _i = 0; _i < 2; ++_i) \
        __builtin_amdgcn_global_load_lds((const unsigned*)((const char*)(gbase) + (voff)[_i]), (PG8_LAS unsigned*)(lds + (bufoff) + ldsw + _i * 8192), 16, 0, 0); } while (0)
#define PG8_LDA(dst, b, h) do { _Pragma("unroll") for (int m = 0; m < 4; ++m) _Pragma("unroll") for (int k = 0; k < 2; ++k) dst[m][k] = *(const PG8_LAS bf16x8*)(lds + PG8_SA(b, h) + aoff + m * 2048 + k * 1024); } while (0)
#define PG8_LDB(dst, b, h) do { _Pragma("unroll") for (int n = 0; n < 2; ++n) _Pragma("unroll") for (int k = 0; k < 2; ++k) dst[n][k] = *(const PG8_LAS bf16x8*)(lds + PG8_SB(b, h) + boff + n * 2048 + k * 1024); } while (0)
#define PG8_MMA(ai, bj, At, Bt) do { __builtin_amdgcn_s_setprio(1); _Pragma("unroll") for (int m = 0; m < 4; ++m) _Pragma("unroll") for (int n = 0; n < 2; ++n) _Pragma("unroll") for (int k = 0; k < 2; ++k) \
        acc[ai][bj][m][n] = __builtin_amdgcn_mfma_f32_16x16x32_bf16(Bt[n][k], At[m][k], acc[ai][bj][m][n], 0, 0, 0); __builtin_amdgcn_s_setprio(0); } while (0)
#define PG8_WAIT_V(n) asm volatile("s_waitcnt vmcnt(" #n ")" ::: "memory")
#define PG8_WAIT_L(n) asm volatile("s_waitcnt lgkmcnt(" #n ")" ::: "memory")
#define PG8_BAR __builtin_amdgcn_s_barrier()
#define PG8_SCHED __builtin_amdgcn_sched_barrier(0)
    Unit cur, nxt; int ui = 0;
    if (!S.next(0, cur)) return;
    f32x4 acc[2][2][4][2];
#pragma unroll
    for (int a = 0; a < 2; ++a)
#pragma unroll
        for (int b = 0; b < 2; ++b)
#pragma unroll
            for (int m = 0; m < 4; ++m)
#pragma unroll
                for (int n = 0; n < 2; ++n) acc[a][b][m][n] = (f32x4){0.f, 0.f, 0.f, 0.f};
    bf16x8 At[4][2], B0[2][2], B1[2][2];
    const char* cA = (const char*)g.A + (size_t)cur.pm * tstep; const char* cB = (const char*)g.Bt + (size_t)cur.pn * tstep;
    S.a_ready(cur);
    if constexpr (SP2) {
        PG8_STAGE(PG8_SB(0, 0), cB, voffB); PG8_STAGE(PG8_SB(0, 1), cB + hstep, voffB); PG8_STAGE(PG8_SA(0, 0), cA, voffA); PG8_STAGE(PG8_SA(0, 1), cA + hstep, voffA);
        if (wr == 1) PG8_BAR;
        PG8_WAIT_V(2); PG8_BAR;
        PG8_STAGE(PG8_SB(1, 0), cB + kstep, voffB); PG8_STAGE(PG8_SA(1, 0), cA + kstep, voffA); PG8_STAGE(PG8_SB(1, 1), cB + hstep + kstep, voffB);
        PG8_WAIT_V(6); PG8_BAR;
    } else {
        PG8_STAGE(PG8_SB(0, 0), cB, voffB); PG8_STAGE(PG8_SA(0, 0), cA, voffA); PG8_STAGE(PG8_SB(0, 1), cB + hstep, voffB); PG8_STAGE(PG8_SA(0, 1), cA + hstep, voffA);
        if (wr == 1) PG8_BAR;
        PG8_WAIT_V(4); PG8_BAR;
        PG8_STAGE(PG8_SB(1, 0), cB + kstep, voffB); PG8_STAGE(PG8_SA(1, 0), cA + kstep, voffA); PG8_STAGE(PG8_SB(1, 1), cB + hstep + kstep, voffB);
        PG8_WAIT_V(6); PG8_BAR;
    }
    for (;;) {
        const bool has_next = S.next(ui + 1, nxt);
        const char* nA = has_next ? (const char*)g.A + (size_t)nxt.pm * tstep : cA; const char* nB = has_next ? (const char*)g.Bt + (size_t)nxt.pn * tstep : cB;
#pragma unroll 1
        for (int t = 0; t < nt; t += 2) {
            const bool last = (t == nt - 2);
            const char* a1 = cA + (size_t)(t + 1) * kstep;
            const char* a2 = last ? nA : cA + (size_t)(t + 2) * kstep; const char* b2 = last ? nB : cB + (size_t)(t + 2) * kstep;
            const char* a3 = a2 + kstep; const char* b3 = b2 + kstep;
            if (last && has_next) S.a_ready(nxt);
            if constexpr (SP2) {
            PG8_LDB(B0, 0, 0); PG8_LDB(B1, 0, 1); PG8_SCHED; PG8_LDA(At, 0, 0); PG8_STAGE(PG8_SA(1, 1), a1 + hstep, voffA);
            PG8_WAIT_V(8); PG8_WAIT_L(0); PG8_BAR; PG8_MMA(0, 0, At, B0); PG8_MMA(0, 1, At, B1); PG8_BAR; PG8_SCHED;
            PG8_LDA(At, 0, 1); PG8_STAGE(PG8_SB(0, 0), b2, voffB); PG8_STAGE(PG8_SB(0, 1), b2 + hstep, voffB); PG8_STAGE(PG8_SA(0, 0), a2, voffA);
            PG8_WAIT_V(8); PG8_WAIT_L(0); PG8_BAR; PG8_MMA(1, 0, At, B0); PG8_MMA(1, 1, At, B1); PG8_BAR; PG8_SCHED;
            PG8_LDB(B0, 1, 0); PG8_LDB(B1, 1, 1); PG8_SCHED; PG8_LDA(At, 1, 0); PG8_STAGE(PG8_SA(0, 1), a2 + hstep, voffA);
            PG8_WAIT_V(8); PG8_WAIT_L(0); PG8_BAR; PG8_MMA(0, 0, At, B0); PG8_MMA(0, 1, At, B1); PG8_BAR; PG8_SCHED;
            PG8_LDA(At, 1, 1); PG8_STAGE(PG8_SB(1, 0), b3, voffB); PG8_STAGE(PG8_SB(1, 1), b3 + hstep, voffB); PG8_STAGE(PG8_SA(1, 0), a3, voffA);
            PG8_WAIT_V(8); PG8_WAIT_L(0); PG8_BAR; PG8_MMA(1, 0, At, B0); PG8_MMA(1, 1, At, B1); PG8_BAR; PG8_SCHED;
            } else {
            PG8_LDB(B0, 0, 0); PG8_SCHED; PG8_LDA(At, 0, 0); PG8_STAGE(PG8_SA(1, 1), a1 + hstep, voffA);
            PG8_WAIT_L(8); PG8_BAR; PG8_WAIT_L(0); PG8_MMA(0, 0, At, B0); PG8_BAR; PG8_SCHED;
            PG8_LDB(B1, 0, 1); PG8_STAGE(PG8_SB(0, 0), b2, voffB);
            PG8_BAR; PG8_WAIT_L(0); PG8_MMA(0, 1, At, B1); PG8_BAR;
            PG8_LDA(At, 0, 1); PG8_STAGE(PG8_SA(0, 0), a2, voffA);
            PG8_BAR; PG8_WAIT_L(0); PG8_MMA(1, 0, At, B0); PG8_BAR; PG8_SCHED;
            PG8_STAGE(PG8_SB(0, 1), b2 + hstep, voffB);
            PG8_WAIT_V(6); PG8_BAR; PG8_MMA(1, 1, At, B1); PG8_BAR;
            PG8_LDB(B0, 1, 0); PG8_SCHED; PG8_LDA(At, 1, 0); PG8_STAGE(PG8_SA(0, 1), a2 + hstep, voffA);
            PG8_WAIT_L(8); PG8_BAR; PG8_WAIT_L(0); PG8_MMA(0, 0, At, B0); PG8_BAR; PG8_SCHED;
            PG8_LDB(B1, 1, 1); PG8_STAGE(PG8_SB(1, 0), b3, voffB);
            PG8_BAR; PG8_WAIT_L(0); PG8_MMA(0, 1, At, B1); PG8_BAR;
            PG8_LDA(At, 1, 1); PG8_STAGE(PG8_SA(1, 0), a3, voffA);
            PG8_BAR; PG8_WAIT_L(0); PG8_MMA(1, 0, At, B0); PG8_BAR; PG8_SCHED;
            PG8_STAGE(PG8_SB(1, 1), b3 + hstep, voffB);
            PG8_WAIT_V(6); PG8_BAR; PG8_MMA(1, 1, At, B1); PG8_BAR;
            }
        }
        if constexpr (ALIGN_EPI) { if (wr == 0) PG8_BAR; }
        if constexpr (!Epi::AFTER_DRAIN) { E(acc, cur, wr, wc, fr, fq); S.done(cur); }
        if (!has_next) break;
#pragma unroll
        for (int a = 0; a < 2; ++a)
#pragma unroll
            for (int b = 0; b < 2; ++b)
#pragma unroll
                for (int m = 0; m < 4; ++m)
#pragma unroll
                    for (int n = 0; n < 2; ++n) acc[a][b][m][n] = (f32x4){0.f, 0.f, 0.f, 0.f};
        cur = nxt; cA = nA; cB = nB; ++ui;
        if constexpr (ALIGN_EPI) { if (wr == 1) PG8_BAR; }
    }
    PG8_WAIT_V(0);
    if constexpr (!ALIGN_EPI) { if (wr == 0) PG8_BAR; }
    PG8_BAR;
    if constexpr (Epi::AFTER_DRAIN) { E.fused(acc, cur, wr, wc, fr, fq, lds, wid, lane); S.done(cur); }
#undef PG8_SA
#undef PG8_SB
#undef PG8_STAGE
#undef PG8_LDA
#undef PG8_LDB
#undef PG8_MMA
#undef PG8_WAIT_V
#undef PG8_WAIT_L
#undef PG8_BAR
#undef PG8_SCHED
}
}

#ifndef MK_SPLIT
#define MK_SPLIT 0
#endif
constexpr int NWAVES = 8, NTHR = 512;
constexpr int BATCH = 8, SEQ = 8192, D = 1024, M = BATCH * SEQ;
constexpr int PCONV = 1536, PT = 3328, FF = 4096, RW = 512;
constexpr int LK = 256, LN = 1536;
constexpr int NMOD = 6 * D;
constexpr int NPHASE = 12;
constexpr size_t MiB = 1u << 20;
constexpr size_t WS_MOD = 0, CTL_ZERO_BYTES = 256 * 1024;
constexpr size_t WS_WIN = 1 * MiB, WS_WOUT = 8 * MiB, WS_WUP = 10 * MiB, WS_WDN = 18 * MiB, WS_LT = 26 * MiB;
constexpr size_t WS_XN = 32 * MiB;
constexpr size_t WS_Y = 32 * MiB;
constexpr size_t WS_P = 160 * MiB;
constexpr size_t WS_DEC = 160 * MiB, WS_KP = 288 * MiB, WS_BV = 352 * MiB, WS_G = 416 * MiB;
constexpr size_t WS_H = 160 * MiB;
constexpr size_t WS_RL = 576 * MiB, WS_KL = 640 * MiB, WS_VL = 704 * MiB, WS_KK = 768 * MiB;
constexpr size_t WS_LA = 832 * MiB;
constexpr size_t WS_MIX = 864 * MiB;
constexpr size_t WS_END = 992 * MiB;
constexpr int LDS_MISC = 131072, LDS_BYTES = 131072 + 2048;

typedef unsigned short bf16;
typedef float f32x4 __attribute__((ext_vector_type(4)));
typedef float f32x2 __attribute__((ext_vector_type(2)));
typedef unsigned u32x4 __attribute__((ext_vector_type(4)));
typedef unsigned u32x2 __attribute__((ext_vector_type(2)));
#define LAS __attribute__((address_space(3)))

typedef __bf16 bf16v2_t __attribute__((ext_vector_type(2)));
__device__ __forceinline__ unsigned pk2(float lo, float hi) { return __builtin_bit_cast(unsigned, __builtin_convertvector((f32x2){lo, hi}, bf16v2_t)); }
__device__ __forceinline__ float bflo(unsigned w) { return __uint_as_float(w << 16); }
__device__ __forceinline__ float bfhi(unsigned w) { return __uint_as_float(w & 0xffff0000u); }
__device__ __forceinline__ void unpack8(const u32x4 w, float (&f)[8]) {
    f[0] = bflo(w.x); f[1] = bfhi(w.x); f[2] = bflo(w.y); f[3] = bfhi(w.y); f[4] = bflo(w.z); f[5] = bfhi(w.z); f[6] = bflo(w.w); f[7] = bfhi(w.w);
}
__device__ __forceinline__ u32x4 pack8(const float (&f)[8]) { u32x4 w; w.x = pk2(f[0], f[1]); w.y = pk2(f[2], f[3]); w.z = pk2(f[4], f[5]); w.w = pk2(f[6], f[7]); return w; }
__device__ __forceinline__ void ld8f(const float* p, float (&f)[8]) { const f32x4 a = *(const f32x4*)p, b = *(const f32x4*)(p + 4); f[0] = a.x; f[1] = a.y; f[2] = a.z; f[3] = a.w; f[4] = b.x; f[5] = b.y; f[6] = b.z; f[7] = b.w; }
__device__ __forceinline__ float wave_sum(float v) {
#pragma unroll
    for (int o = 1; o < 64; o <<= 1) v += __shfl_xor(v, o);
    return v;
}
__device__ __forceinline__ float sum8(float v) { v += __shfl_xor(v, 1); v += __shfl_xor(v, 2); v += __shfl_xor(v, 4); return v; }
__device__ __forceinline__ float sigmoidf_(float x) { return 1.0f / (1.0f + __expf(-x)); }

struct Args { const float* in[21]; float* out; unsigned char* ws; int ph_lo, ph_hi; };

template <int ACT  > struct EpiBf {
    static constexpr bool PERM = true, AFTER_DRAIN = false;
    bf16* O; int ldc;
    __device__ __forceinline__ void operator()(const pg8::f32x4 (&acc)[2][2][4][2], const pg8::Unit& u, int wr, int wc, int fr, int fq) const {
        const int row0 = u.pm * 256 + wr * 64 + fr, col0 = u.pn * 256 + wc * 32 + 8 * fq;
#pragma unroll
        for (int ai = 0; ai < 2; ++ai)
#pragma unroll
            for (int m = 0; m < 4; ++m) { bf16* rowp = O + (size_t)(row0 + ai * 128 + m * 16) * ldc + col0;
#pragma unroll
                for (int bj = 0; bj < 2; ++bj) { pg8::f32x4 v0 = acc[ai][bj][m][0], v1 = acc[ai][bj][m][1];
                    if (ACT == 1) {
#pragma unroll
                        for (int j = 0; j < 4; ++j) { const float a = fmaxf(v0[j], 0.f), b = fmaxf(v1[j], 0.f); v0[j] = a * a; v1[j] = b * b; } }
                    u32x4 w; w.x = pk2(v0[0], v0[1]); w.y = pk2(v0[2], v0[3]); w.z = pk2(v1[0], v1[1]); w.w = pk2(v1[2], v1[3]);
                    *(u32x4*)(rowp + bj * 128) = w; } }
    }
};
struct EpiRes {
    static constexpr bool PERM = false, AFTER_DRAIN = false;
    const float* X; float* O; const float* gate;
    __device__ __forceinline__ void operator()(const pg8::f32x4 (&acc)[2][2][4][2], const pg8::Unit& u, int wr, int wc, int fr, int fq) const {
        const int row0 = u.pm * 256 + wr * 64 + fr, col0 = u.pn * 256 + wc * 32 + 4 * fq, b = u.pm >> 5;
        f32x4 gv[2][2];
#pragma unroll
        for (int bj = 0; bj < 2; ++bj)
#pragma unroll
            for (int n = 0; n < 2; ++n) gv[bj][n] = *(const f32x4*)(gate + (size_t)b * NMOD + col0 + bj * 128 + n * 16);
#pragma unroll
        for (int ai = 0; ai < 2; ++ai)
#pragma unroll
            for (int m = 0; m < 4; ++m) { const size_t off = (size_t)(row0 + ai * 128 + m * 16) * D + col0;
#pragma unroll
                for (int bj = 0; bj < 2; ++bj)
#pragma unroll
                    for (int n = 0; n < 2; ++n) { const f32x4 xv = *(const f32x4*)(X + off + bj * 128 + n * 16);
                        *(f32x4*)(O + off + bj * 128 + n * 16) = xv + gv[bj][n] * acc[ai][bj][m][n]; }
                asm volatile("" ::: "memory"); }
    }
};
#ifndef LK0
#define LK0 1
#endif
#ifndef LK1
#define LK1 1
#endif
#ifndef LK2
#define LK2 1
#endif
#ifndef SCAN_CHUNKED
#define SCAN_CHUNKED 1
#endif
#define LORA_LOGW SCAN_CHUNKED
struct EpiLora {
    static constexpr bool PERM = true, AFTER_DRAIN = false;
    const float *w0, *a0, *k_a; const bf16 *KL, *KK; float* DEC; bf16 *KP, *BV, *G;
    __device__ __forceinline__ void operator()(const pg8::f32x4 (&acc)[2][2][4][2], const pg8::Unit& u, int wr, int wc, int fr, int fq) const {
        const int kind = u.pn >> 1, row0 = u.pm * 256 + wr * 64 + fr, cb = (u.pn & 1) * 256 + wc * 32 + 8 * fq;
#pragma unroll
        for (int bj = 0; bj < 2; ++bj) {
            const int c = cb + bj * 128;
            if (LK0 && kind == 0) {
                float wv[8]; ld8f(w0 + c, wv);
#pragma unroll
                for (int ai = 0; ai < 2; ++ai)
#pragma unroll
                    for (int m = 0; m < 4; ++m) { const size_t off = (size_t)(row0 + ai * 128 + m * 16) * RW + c; f32x4 o[2];
#pragma unroll
                        for (int n = 0; n < 2; ++n)
#pragma unroll
                            for (int j = 0; j < 4; ++j) { const float pre = acc[ai][bj][m][n][j] + wv[4 * n + j];
                                const float lw_ = -0.6065306597f * sigmoidf_(pre); o[n][j] = LORA_LOGW ? lw_ : __expf(lw_); }
                        *(f32x4*)(DEC + off) = o[0]; *(f32x4*)(DEC + off + 4) = o[1]; asm volatile("" ::: "memory"); }
            } else if (LK1 && kind == 1) {
                float av[8], kav[8]; ld8f(a0 + c, av); ld8f(k_a + c, kav);
#pragma unroll
                for (int ai = 0; ai < 2; ++ai)
#pragma unroll
                    for (int m = 0; m < 4; ++m) { const size_t off = (size_t)(row0 + ai * 128 + m * 16) * RW + c;
                        float kf[8], kkf[8], kp[8], bv[8]; unpack8(*(const u32x4*)(KL + off), kf); unpack8(*(const u32x4*)(KK + off), kkf);
#pragma unroll
                        for (int n = 0; n < 2; ++n)
#pragma unroll
                            for (int j = 0; j < 4; ++j) { const int i = 4 * n + j; const float a = sigmoidf_(acc[ai][bj][m][n][j] + av[i]);
                                kp[i] = kf[i] * (1.0f + (a - 1.0f) * kav[i]); bv[i] = kkf[i] * a; }
                        *(u32x4*)(KP + off) = pack8(kp); *(u32x4*)(BV + off) = pack8(bv); asm volatile("" ::: "memory"); }
            } else if (LK2) {
#pragma unroll
                for (int ai = 0; ai < 2; ++ai)
#pragma unroll
                    for (int m = 0; m < 4; ++m) { const size_t off = (size_t)(row0 + ai * 128 + m * 16) * RW + c;
                        const pg8::f32x4 v0 = acc[ai][bj][m][0], v1 = acc[ai][bj][m][1];
                        u32x4 w; w.x = pk2(v0[0], v0[1]); w.y = pk2(v0[2], v0[3]); w.z = pk2(v1[0], v1[1]); w.w = pk2(v1[2], v1[3]);
                        *(u32x4*)(G + off) = w; }
            }
        }
    }
};

__device__ __forceinline__ void transpose_item(const float* W, int K, int N, bf16* WT, LAS float* scr, int item, int lane) {
    const int nblk = N / 32, kb = item / nblk, nb = item % nblk, k0 = 64 * kb, n0 = 32 * nb;
#pragma unroll 8
    for (int i = 0; i < 32; ++i) { const int kk = 2 * i + (lane >> 5); scr[kk * 33 + (lane & 31)] = W[(size_t)(k0 + kk) * N + n0 + (lane & 31)]; }
    asm volatile("s_waitcnt lgkmcnt(0)" ::: "memory");
    const int c = lane & 7;
#pragma unroll
    for (int j = 0; j < 4; ++j) { const int n = (lane >> 3) + 8 * j; const LAS float* s = scr + (8 * c) * 33 + n;
        u32x4 o; o.x = pk2(s[0 * 33], s[1 * 33]); o.y = pk2(s[2 * 33], s[3 * 33]); o.z = pk2(s[4 * 33], s[5 * 33]); o.w = pk2(s[6 * 33], s[7 * 33]);
        *(u32x4*)(WT + (size_t)(n0 + n) * K + k0 + 8 * c) = o; }
    asm volatile("s_waitcnt lgkmcnt(0)" ::: "memory");
}
__device__ __forceinline__ void p0_prologue(const Args& A, LAS unsigned char* lds, int tid, int lane, int wave) {
    unsigned char* ws = A.ws;
    {
        const float* c = A.in[1]; const float* w_ada = A.in[2]; const float* b_ada = A.in[3]; float* MOD = (float*)(ws + WS_MOD);
        LAS float* cs = (LAS float*)(lds + LDS_MISC);
        for (int item = blockIdx.x; item < 384; item += gridDim.x) {
            const int kc = item / 12, cb = item % 12;
            __syncthreads();
            if (tid < 256) { const float cv = c[(tid >> 5) * D + kc * 32 + (tid & 31)]; cs[tid] = cv * sigmoidf_(cv); }
            __syncthreads();
            const int col = cb * 512 + tid;
            float acc[8];
#pragma unroll
            for (int b = 0; b < 8; ++b) acc[b] = 0.f;
#pragma unroll 4
            for (int kk = 0; kk < 32; ++kk) { const float w = w_ada[(size_t)(kc * 32 + kk) * NMOD + col];
#pragma unroll
                for (int b = 0; b < 8; ++b) acc[b] += cs[b * 32 + kk] * w; }
            const float bias = (kc == 0) ? b_ada[col] : 0.f;
#pragma unroll
            for (int b = 0; b < 8; ++b) unsafeAtomicAdd(MOD + b * NMOD + col, acc[b] + bias);
        }
        __syncthreads();
    }
    {
        LAS float* scr = (LAS float*)(lds + wave * 16384);
        const int gw = blockIdx.x * NWAVES + wave, NGW = gridDim.x * NWAVES;
        constexpr int I_IN = (D / 64) * (PT / 32), I_OUT = (D / 64) * (D / 32), I_UP = (D / 64) * (FF / 32), I_DN = (FF / 64) * (D / 32);
        for (int it = gw; it < I_IN + I_OUT + I_UP + I_DN; it += NGW) {
            int r = it;
            if (r < I_IN) { transpose_item(A.in[4], D, PT, (bf16*)(ws + WS_WIN), scr, r, lane); continue; } r -= I_IN;
            if (r < I_OUT) { transpose_item(A.in[17], D, D, (bf16*)(ws + WS_WOUT), scr, r, lane); continue; } r -= I_OUT;
            if (r < I_UP) { transpose_item(A.in[18], D, FF, (bf16*)(ws + WS_WUP), scr, r, lane); continue; } r -= I_UP;
            transpose_item(A.in[19], FF, D, (bf16*)(ws + WS_WDN), scr, r, lane);
        }
    }
    {
        const float* w2 = A.in[8]; const float* a2 = A.in[10]; const float* g2 = A.in[11]; bf16* LT = (bf16*)(ws + WS_LT);
        for (int idx = blockIdx.x * NTHR + tid; idx < LN * LK; idx += gridDim.x * NTHR) {
            const int n = idx >> 8, k = idx & 255; float v = 0.f;
            if (n < 512) { if (k < 64) v = w2[k * 512 + n]; }
            else if (n < 1024) { if (k >= 64 && k < 128) v = a2[(k - 64) * 512 + (n - 512)]; }
            else { if (k >= 128) v = g2[(k - 128) * 512 + (n - 1024)]; }
            LT[idx] = (bf16)(pk2(v, 0.f) & 0xffffu);
        }
    }
}

template <int R> __device__ __forceinline__ void norm_mod_rows(const float* X, bf16* O, const float* MOD, int sh_chunk, int m0, int stride, int lane) {
    f32x4 v[R][4];
#pragma unroll
    for (int r = 0; r < R; ++r) { const f32x4* xr = (const f32x4*)(X + (size_t)(m0 + r * stride) * D) + lane;
#pragma unroll
        for (int j = 0; j < 4; ++j) v[r][j] = xr[64 * j]; }
#pragma unroll
    for (int r = 0; r < R; ++r) { const int m = m0 + r * stride; const float* sh = MOD + (m >> 13) * NMOD + sh_chunk * D; const float* sc = sh + D;
        float s = 0.f;
#pragma unroll
        for (int j = 0; j < 4; ++j) s += (v[r][j].x * v[r][j].x + v[r][j].y * v[r][j].y) + (v[r][j].z * v[r][j].z + v[r][j].w * v[r][j].w);
        const float rstd = rsqrtf(wave_sum(s) * (1.f / D) + 1e-6f);
        bf16* orow = O + (size_t)m * D;
#pragma unroll
        for (int j = 0; j < 4; ++j) { const f32x4 a = ((const f32x4*)sc)[lane + 64 * j], b = ((const f32x4*)sh)[lane + 64 * j];
            const f32x4 h = v[r][j] * rstd * (1.f + a) + b;
            ((u32x2*)orow)[lane + 64 * j] = (u32x2){pk2(h.x, h.y), pk2(h.z, h.w)}; } }
}
template <int R> __device__ __forceinline__ void final_rows(float* X, const float* g, int m0, int stride, int lane) {
    f32x4 v[R][4];
#pragma unroll
    for (int r = 0; r < R; ++r) { const f32x4* xr = (const f32x4*)(X + (size_t)(m0 + r * stride) * D) + lane;
#pragma unroll
        for (int j = 0; j < 4; ++j) v[r][j] = xr[64 * j]; }
    f32x4 gv[4];
#pragma unroll
    for (int j = 0; j < 4; ++j) gv[j] = ((const f32x4*)g)[lane + 64 * j];
#pragma unroll
    for (int r = 0; r < R; ++r) { f32x4* xr = (f32x4*)(X + (size_t)(m0 + r * stride) * D) + lane; float s = 0.f;
#pragma unroll
        for (int j = 0; j < 4; ++j) s += (v[r][j].x * v[r][j].x + v[r][j].y * v[r][j].y) + (v[r][j].z * v[r][j].z + v[r][j].w * v[r][j].w);
        const float rstd = rsqrtf(wave_sum(s) * (1.f / D) + 1e-6f);
#pragma unroll
        for (int j = 0; j < 4; ++j) xr[64 * j] = v[r][j] * rstd * gv[j]; }
}
__device__ __forceinline__ void mix_row(const Args& A, int m, int lane) {
    unsigned char* ws = A.ws;
    const bf16* P = (const bf16*)(ws + WS_P);
    const bf16* prow = P + (size_t)m * PT;
    const int tt = m & (SEQ - 1);
    const bool has1 = tt >= 1, has2 = tt >= 2;
    const u32x4 zero4 = (u32x4){0u, 0u, 0u, 0u};
    const int ch = 8 * lane;
    {
        const float* cw = A.in[5];
        float bg[8], c0[8], u0[8], c1[8], u1[8], c2[8], u2[8], w0[8], w1[8], w2[8], y[8];
        unpack8(*(const u32x4*)(prow + ch), bg);
        unpack8(*(const u32x4*)(prow + 512 + ch), c0); unpack8(*(const u32x4*)(prow + 1024 + ch), u0);
        unpack8(has1 ? *(const u32x4*)(prow - PT + 512 + ch) : zero4, c1); unpack8(has1 ? *(const u32x4*)(prow - PT + 1024 + ch) : zero4, u1);
        unpack8(has2 ? *(const u32x4*)(prow - 2 * PT + 512 + ch) : zero4, c2); unpack8(has2 ? *(const u32x4*)(prow - 2 * PT + 1024 + ch) : zero4, u2);
        ld8f(cw + ch, w0); ld8f(cw + 512 + ch, w1); ld8f(cw + 1024 + ch, w2);
#pragma unroll
        for (int i = 0; i < 8; ++i) y[i] = bg[i] * (w0[i] * (c2[i] * u2[i]) + w1[i] * (c1[i] * u1[i]) + w2[i] * (c0[i] * u0[i]));
        *(u32x4*)((bf16*)(ws + WS_MIX) + (size_t)m * D + ch) = pack8(y);
    }
    const bf16* q = prow + PCONV;
    const float* mu = A.in[6];
    {
        float cur[8], prv[8], mv[8], o[8];
        const size_t off = (size_t)m * RW + ch;
        unpack8(*(const u32x4*)(q + ch), cur); unpack8(has1 ? *(const u32x4*)(q - PT + ch) : zero4, prv); ld8f(mu + ch, mv);
#pragma unroll
        for (int i = 0; i < 8; ++i) o[i] = cur[i] + (prv[i] - cur[i]) * mv[i];
        *(u32x4*)((bf16*)(ws + WS_RL) + off) = pack8(o);
        unpack8(*(const u32x4*)(q + 1024 + ch), cur); unpack8(has1 ? *(const u32x4*)(q - PT + 1024 + ch) : zero4, prv); ld8f(mu + 1024 + ch, mv);
#pragma unroll
        for (int i = 0; i < 8; ++i) o[i] = cur[i] + (prv[i] - cur[i]) * mv[i];
        *(u32x4*)((bf16*)(ws + WS_VL) + off) = pack8(o);
        unpack8(*(const u32x4*)(q + 512 + ch), cur); unpack8(has1 ? *(const u32x4*)(q - PT + 512 + ch) : zero4, prv); ld8f(mu + 512 + ch, mv);
#pragma unroll
        for (int i = 0; i < 8; ++i) o[i] = cur[i] + (prv[i] - cur[i]) * mv[i];
        *(u32x4*)((bf16*)(ws + WS_KL) + off) = pack8(o);
        float kkv[8], kk8[8]; ld8f(A.in[12] + ch, kk8); float ss = 0.f;
#pragma unroll
        for (int i = 0; i < 8; ++i) { kkv[i] = o[i] * kk8[i]; ss += kkv[i] * kkv[i]; }
        ss = sum8(ss);
        const float inv = 1.0f / fmaxf(sqrtf(ss), 1e-12f);
#pragma unroll
        for (int i = 0; i < 8; ++i) kkv[i] *= inv;
        *(u32x4*)((bf16*)(ws + WS_KK) + off) = pack8(kkv);
    }
    {
        const int c4 = 4 * lane;
        const u32x2 cw = *(const u32x2*)(q + 1536 + c4); const u32x2 pw = has1 ? *(const u32x2*)(q - PT + 1536 + c4) : (u32x2){0u, 0u};
        const f32x4 mv = *(const f32x4*)(mu + 1536 + c4);
        float cur[4] = {bflo(cw.x), bfhi(cw.x), bflo(cw.y), bfhi(cw.y)}, prv[4] = {bflo(pw.x), bfhi(pw.x), bflo(pw.y), bfhi(pw.y)}, o[4];
#pragma unroll
        for (int i = 0; i < 4; ++i) { const float xl = cur[i] + (prv[i] - cur[i]) * mv[i];
            const float sg = sigmoidf_(lane < 16 ? 2.0f * xl : xl);
            o[i] = lane < 16 ? (2.0f * sg - 1.0f) : (lane < 32 ? xl : sg); }
        *(u32x2*)((bf16*)(ws + WS_LA) + (size_t)m * LK + c4) = (u32x2){pk2(o[0], o[1]), pk2(o[2], o[3])};
    }
}
template <int R> __device__ __forceinline__ void post_rows(const Args& A, int m0, int stride, int lane) {
    unsigned char* ws = A.ws;
    const int ch = 8 * lane;
    f32x4 y0[R], y1[R]; u32x4 rw[R], kw[R], vw[R], gw_[R];
#pragma unroll
    for (int r = 0; r < R; ++r) { const size_t off = (size_t)(m0 + r * stride) * RW + ch;
        y0[r] = *(const f32x4*)((const float*)(ws + WS_Y) + off); y1[r] = *(const f32x4*)((const float*)(ws + WS_Y) + off + 4);
        rw[r] = *(const u32x4*)((const bf16*)(ws + WS_RL) + off); kw[r] = *(const u32x4*)((const bf16*)(ws + WS_KP) + off);
        vw[r] = *(const u32x4*)((const bf16*)(ws + WS_VL) + off); gw_[r] = *(const u32x4*)((const bf16*)(ws + WS_G) + off); }
    float rk[8], lg[8], lb[8];
    ld8f(A.in[14] + ch, rk); ld8f(A.in[15] + ch, lg); ld8f(A.in[16] + ch, lb);
#pragma unroll
    for (int r = 0; r < R; ++r) {
        float y[8] = {y0[r].x, y0[r].y, y0[r].z, y0[r].w, y1[r].x, y1[r].y, y1[r].z, y1[r].w}, rr[8], kp[8], v[8], g[8], o[8];
        unpack8(rw[r], rr); unpack8(kw[r], kp); unpack8(vw[r], v); unpack8(gw_[r], g);
        float s = 0.f, bs = 0.f;
#pragma unroll
        for (int i = 0; i < 8; ++i) { s += y[i]; bs += rr[i] * kp[i] * rk[i]; }
        s = sum8(s); bs = sum8(bs);
        const float mean = s * (1.f / 64.f); float q = 0.f;
#pragma unroll
        for (int i = 0; i < 8; ++i) { y[i] -= mean; q += y[i] * y[i]; }
        q = sum8(q);
        const float rstd = rsqrtf(q * (1.f / 64.f) + 64e-5f);
#pragma unroll
        for (int i = 0; i < 8; ++i) o[i] = (y[i] * rstd * lg[i] + lb[i] + bs * v[i]) * g[i];
        *(u32x4*)((bf16*)(ws + WS_MIX) + (size_t)(m0 + r * stride) * D + 512 + ch) = pack8(o); }
}

constexpr int TC = 32, NCH = SEQ / TC;
constexpr int OPB = 5 * TC * 256 + TC * 64;
constexpr int YB_OFF = 2 * OPB, DUMP_OFF = YB_OFF + 4096;
static_assert(DUMP_OFF + 4608 <= 131072, "scan LDS");
#define SCAN_BAR() do { asm volatile("s_waitcnt lgkmcnt(0)" ::: "memory"); __builtin_amdgcn_s_barrier(); asm volatile("" ::: "memory"); } while (0)
template <int CTRL> __device__ __forceinline__ float dpp_add(float x) {
    return x + __builtin_bit_cast(float, __builtin_amdgcn_update_dpp(0, __builtin_bit_cast(int, x), CTRL, 0xf, 0xf, false));
}
__device__ __forceinline__ float rsum16(float x) { x = dpp_add<0x128>(x); x = dpp_add<0x124>(x); x = dpp_add<0x122>(x); x = dpp_add<0x121>(x); return x; }
struct ScanRegs { u32x4 rl, kp, kk, bv, vv; f32x4 d0, d1; };
__device__ __forceinline__ void st8(LAS unsigned char* p, const u32x4 w) {
    *(LAS f32x4*)p = (f32x4){bflo(w.x), bfhi(w.x), bflo(w.y), bfhi(w.y)}; *(LAS f32x4*)(p + 16) = (f32x4){bflo(w.z), bfhi(w.z), bflo(w.w), bfhi(w.w)};
}
__device__ __forceinline__ void scan_phase(unsigned char* ws, LAS unsigned char* lds, int tid, int lane, int wid) {
    const bf16* RL = (const bf16*)(ws + WS_RL); const bf16* KP = (const bf16*)(ws + WS_KP); const bf16* KK = (const bf16*)(ws + WS_KK);
    const bf16* BV = (const bf16*)(ws + WS_BV); const bf16* VL = (const bf16*)(ws + WS_VL); const float* DEC = (const float*)(ws + WS_DEC);
    float* Y = (float*)(ws + WS_Y);
    for (int item = blockIdx.x; item < 256; item += gridDim.x) {
        const int xcd = item & 7, slot = item >> 3, bh = xcd * 8 + (slot >> 2), q = slot & 3, b = bh >> 3, h = bh & 7;
        const size_t rowbase = (size_t)b * SEQ;
        const bool loader = wid >= 4;
        const int L = tid - 256;
        const int lt = L >> 3, lc = (L & 7) * 8;
        ScanRegs R;
#define SCAN_ISSUE(cc) do { const size_t o_ = (rowbase + (size_t)(cc) * TC + lt) * RW + h * 64 + lc; \
            R.rl = *(const u32x4*)(RL + o_); R.kp = *(const u32x4*)(KP + o_); R.kk = *(const u32x4*)(KK + o_); R.bv = *(const u32x4*)(BV + o_); \
            R.d0 = *(const f32x4*)(DEC + o_); R.d1 = *(const f32x4*)(DEC + o_ + 4); \
            if (wid == 4) R.vv = *(const u32x4*)(VL + (rowbase + (size_t)(cc) * TC + (lane >> 1)) * RW + h * 64 + q * 16 + (lane & 1) * 8); } while (0)
#define SCAN_WRITE(buf) do { LAS unsigned char* ob_ = lds + (buf) * OPB + lt * 256 + lc * 4; \
            st8(ob_ + 0 * TC * 256, R.rl); *(LAS f32x4*)(ob_ + 1 * TC * 256) = R.d0; *(LAS f32x4*)(ob_ + 1 * TC * 256 + 16) = R.d1; \
            st8(ob_ + 2 * TC * 256, R.kp); st8(ob_ + 3 * TC * 256, R.kk); st8(ob_ + 4 * TC * 256, R.bv); \
            if (wid == 4) st8(lds + (buf) * OPB + 5 * TC * 256 + (lane >> 1) * 64 + (lane & 1) * 32, R.vv); } while (0)
#define SCAN_FLUSH(cc) do { if (L < 128) { const f32x4 yv_ = *(LAS const f32x4*)(lds + YB_OFF + ((cc) & 1) * 2048 + (L >> 2) * 64 + (L & 3) * 16); \
            *(f32x4*)(Y + (rowbase + (size_t)(cc) * TC + (L >> 2)) * RW + h * 64 + q * 16 + (L & 3) * 4) = yv_; } } while (0)
        const int rg = lane >> 4, cl = lane & 15, rb = (wid & 3) * 4 + rg;
        f32x2 S01 = (f32x2){0.f, 0.f}, S23 = (f32x2){0.f, 0.f};
        const unsigned opoff = cl * 16, voff = 5 * TC * 256 + rb * 4;
        const unsigned ybase = (cl == 0) ? (unsigned)(YB_OFF + rb * 4) : (unsigned)(DUMP_OFF + lane * 4);
        if (loader) { SCAN_ISSUE(0); SCAN_WRITE(0); SCAN_ISSUE(1); }
        SCAN_BAR();
        for (int c = 0; c < NCH; ++c) {
            if (!loader) {
                LAS const unsigned char* ob = lds + (c & 1) * OPB;
                LAS unsigned char* yb = lds + ybase + (c & 1) * 2048;
                f32x4 r_[3], w_[3], k_[3], a_[3], b_[3]; float v_[3];
#define SCAN_LD(st, tt) do { r_[st] = *(LAS const f32x4*)(ob + opoff + (0 * TC + (tt)) * 256); w_[st] = *(LAS const f32x4*)(ob + opoff + (1 * TC + (tt)) * 256); \
                    k_[st] = *(LAS const f32x4*)(ob + opoff + (2 * TC + (tt)) * 256); a_[st] = *(LAS const f32x4*)(ob + opoff + (3 * TC + (tt)) * 256); \
                    b_[st] = *(LAS const f32x4*)(ob + opoff + (4 * TC + (tt)) * 256); v_[st] = *(LAS const float*)(ob + voff + (tt) * 64); } while (0)
                SCAN_LD(0, 0); SCAN_LD(1, 1);
#pragma unroll
                for (int t = 0; t < TC; ++t) {
                    const int st = t % 3;
                    if (t + 2 < TC) SCAN_LD((t + 2) % 3, t + 2);
                    const f32x4 r = r_[st], w = w_[st], k = k_[st], a = a_[st], bb = b_[st]; const float v = v_[st];
                    const f32x2 sp2 = S01 * (f32x2){a.x, a.y} + S23 * (f32x2){a.z, a.w};
                    const float sa = rsum16(sp2.x + sp2.y);
                    const f32x2 vv = (f32x2){v, v}, nsa = (f32x2){-sa, -sa};
                    const f32x2 t01 = vv * (f32x2){k.x, k.y} + nsa * (f32x2){bb.x, bb.y};
                    const f32x2 t23 = vv * (f32x2){k.z, k.w} + nsa * (f32x2){bb.z, bb.w};
                    S01 = S01 * (f32x2){w.x, w.y} + t01;
                    S23 = S23 * (f32x2){w.z, w.w} + t23;
                    const f32x2 yp2 = S01 * (f32x2){r.x, r.y} + S23 * (f32x2){r.z, r.w};
                    const float yv = rsum16(yp2.x + yp2.y);
                    *(LAS float*)(yb + t * 64) = yv;
                }
#undef SCAN_LD
            } else {
                if (c + 1 < NCH) SCAN_WRITE((c + 1) & 1);
                if (c + 2 < NCH) SCAN_ISSUE(c + 2);
                if (c >= 1) SCAN_FLUSH(c - 1);
            }
            SCAN_BAR();
        }
        if (loader) SCAN_FLUSH(NCH - 1);
        SCAN_BAR();
#undef SCAN_ISSUE
#undef SCAN_WRITE
#undef SCAN_FLUSH
    }
}

#ifndef SCAN_CHUNKED
#define SCAN_CHUNKED 1
#endif
constexpr size_t WS_AH = 640 * MiB, WS_RT = 480 * MiB, WS_NN = 544 * MiB, WS_MA = 832 * MiB;
constexpr size_t OUT_BK = 0, OUT_PC = 128 * MiB;
constexpr int S1_XA = 0, S1_XB = 2304, S1_XK = 4608, S1_XR = 6912, S1_AHL = 9216, S1_NABT = 11520, S1_TT = 12544, S1_NAK = 13824, S1_WAVE = 15360;
typedef short bf16x8 __attribute__((ext_vector_type(8)));
__device__ __forceinline__ float bf2f(unsigned short v) { return __uint_as_float(((unsigned)v) << 16); }
__device__ __forceinline__ unsigned short f2bf1(float f) { return (unsigned short)(pk2(f, 0.f) & 0xffffu); }
__device__ __forceinline__ bf16x8 mk8(unsigned a, unsigned b, unsigned c, unsigned d) { return __builtin_bit_cast(bf16x8, (u32x4){a, b, c, d}); }
#define MFMA16(a, b, c) __builtin_amdgcn_mfma_f32_16x16x32_bf16((a), (b), (c), 0, 0, 0)

__device__ __forceinline__ void s1_item(unsigned char* ws, unsigned char* outb, LAS unsigned char* wl, int ci, int lane) {
    const int bh = ci >> 9, c = ci & 511, b = bh >> 3, h = bh & 7;
    const size_t goff = ((size_t)b * SEQ + (size_t)c * 16) * RW + h * 64 + lane;
    const float* LW = (const float*)(ws + WS_DEC); const bf16* KKg = (const bf16*)(ws + WS_KK); const bf16* BVg = (const bf16*)(ws + WS_BV);
    const bf16* KPg = (const bf16*)(ws + WS_KP); const bf16* RLg = (const bf16*)(ws + WS_RL);
    float lw[16]; unsigned short kk_[16], bv_[16], kp_[16], rr_[16];
#pragma unroll
    for (int t = 0; t < 16; ++t) { const size_t o = goff + (size_t)t * RW; lw[t] = LW[o]; kk_[t] = KKg[o]; bv_[t] = BVg[o]; kp_[t] = KPg[o]; rr_[t] = RLg[o]; }
    float lp[16]; { float acc = 0.f;
#pragma unroll
        for (int t = 0; t < 16; ++t) { acc += lw[t]; lp[t] = acc; } }
    const float lpc = lp[15];
    float At[16], Bh[16], Kh[16];
#pragma unroll
    for (int t = 0; t < 16; ++t) {
        const float P = __expf(lp[t]), Pm1 = __expf(lp[t] - lw[t]), iP = __expf(-lp[t]), PcP = __expf(lpc - lp[t]);
        const float kkf = bf2f(kk_[t]), bvf = bf2f(bv_[t]), kpf = bf2f(kp_[t]), rf = bf2f(rr_[t]);
        At[t] = -kkf * Pm1; Bh[t] = bvf * PcP; Kh[t] = kpf * PcP;
        *(LAS unsigned short*)(wl + S1_XA + t * 144 + lane * 2) = f2bf1(At[t]);
        *(LAS unsigned short*)(wl + S1_XB + t * 144 + lane * 2) = f2bf1(bvf * iP);
        *(LAS unsigned short*)(wl + S1_XK + t * 144 + lane * 2) = f2bf1(kpf * iP);
        *(LAS unsigned short*)(wl + S1_XR + t * 144 + lane * 2) = f2bf1(rf * P);
    }
    const int m = lane & 15, q = lane >> 4;
    bf16x8 fa[2], fb[2], fk[2], fr[2];
#pragma unroll
    for (int ks = 0; ks < 2; ++ks) { const int o = m * 144 + (8 * q + 32 * ks) * 2;
        fa[ks] = *(LAS const bf16x8*)(wl + S1_XA + o); fb[ks] = *(LAS const bf16x8*)(wl + S1_XB + o);
        fk[ks] = *(LAS const bf16x8*)(wl + S1_XK + o); fr[ks] = *(LAS const bf16x8*)(wl + S1_XR + o); }
    const f32x4 z4 = (f32x4){0.f, 0.f, 0.f, 0.f};
    f32x4 nab = MFMA16(fb[0], fa[0], z4); nab = MFMA16(fb[1], fa[1], nab);
    f32x4 nak = MFMA16(fk[0], fa[0], z4); nak = MFMA16(fk[1], fa[1], nak);
    f32x4 nbr = MFMA16(fb[0], fr[0], z4); nbr = MFMA16(fb[1], fr[1], nbr);
    f32x4 nkr = MFMA16(fk[0], fr[0], z4); nkr = MFMA16(fk[1], fr[1], nkr);
#pragma unroll
    for (int i = 0; i < 4; ++i) { const int s = 4 * q + i;
        nab[i] = (s < m) ? nab[i] : 0.f; nak[i] = (s < m) ? nak[i] : 0.f; nbr[i] = (s <= m) ? nbr[i] : 0.f; nkr[i] = (s <= m) ? nkr[i] : 0.f; }
    *(u32x4*)((bf16*)(ws + WS_NN) + (size_t)ci * 512 + lane * 8) = (u32x4){pk2(nbr[0], nbr[1]), pk2(nbr[2], nbr[3]), pk2(nkr[0], nkr[1]), pk2(nkr[2], nkr[3])};
    *(LAS f32x4*)(wl + S1_NABT + m * 64 + q * 16) = nab;
#pragma unroll
    for (int i = 0; i < 4; ++i) *(LAS float*)(wl + S1_NAK + (4 * q + i) * 64 + m * 4) = nak[i];
    float Tr[16];
#pragma unroll
    for (int t = 0; t < 16; ++t) {
        float acc = (m == t) ? 1.f : 0.f;
#pragma unroll
        for (int j4 = 0; j4 < (t + 3) / 4; ++j4) { const f32x4 nv = *(LAS const f32x4*)(wl + S1_NABT + t * 64 + j4 * 16);
#pragma unroll
            for (int jj = 0; jj < 4; ++jj) if (4 * j4 + jj < t) acc += Tr[4 * j4 + jj] * nv[jj]; }
        Tr[t] = acc;
        *(LAS float*)(wl + S1_TT + t * 80 + m * 4) = acc;
    }
#pragma unroll
    for (int t = 0; t < 16; ++t) {
        float acc = 0.f;
#pragma unroll
        for (int s4 = 0; s4 < t / 4 + 1; ++s4) { const f32x4 tv = *(LAS const f32x4*)(wl + S1_TT + t * 80 + s4 * 16);
#pragma unroll
            for (int ss = 0; ss < 4; ++ss) if (4 * s4 + ss <= t) acc += tv[ss] * At[4 * s4 + ss]; }
        *(LAS unsigned short*)(wl + S1_AHL + t * 144 + lane * 2) = f2bf1(acc);
    }
    {
        f32x4 tt[4];
#pragma unroll
        for (int s4 = 0; s4 < 4; ++s4) tt[s4] = *(LAS const f32x4*)(wl + S1_TT + m * 80 + s4 * 16);
        float mak[4];
#pragma unroll
        for (int i = 0; i < 4; ++i) { float acc = 0.f;
#pragma unroll
            for (int s4 = 0; s4 < 4; ++s4) { const f32x4 nv = *(LAS const f32x4*)(wl + S1_NAK + (4 * q + i) * 64 + s4 * 16);
                acc += tt[s4][0] * nv[0] + tt[s4][1] * nv[1] + tt[s4][2] * nv[2] + tt[s4][3] * nv[3]; }
            mak[i] = acc; }
        *(u32x4*)((bf16*)(ws + WS_MA) + (size_t)ci * 512 + lane * 8) = (u32x4){0u, 0u, pk2(mak[0], mak[1]), pk2(mak[2], mak[3])};
    }
#pragma unroll
    for (int hh = 0; hh < 2; ++hh) {
        const int o = m * 144 + (32 * hh + 4 * q) * 2;
        const u32x2 alo = *(LAS const u32x2*)(wl + S1_AHL + o), ahi = *(LAS const u32x2*)(wl + S1_AHL + o + 32);
        const u32x2 rlo = *(LAS const u32x2*)(wl + S1_XR + o), rhi = *(LAS const u32x2*)(wl + S1_XR + o + 32);
        *(u32x4*)((bf16*)(ws + WS_AH) + (size_t)ci * 1024 + (hh * 64 + lane) * 8) = (u32x4){alo.x, alo.y, ahi.x, ahi.y};
        *(u32x4*)((bf16*)(ws + WS_RT) + (size_t)ci * 1024 + (hh * 64 + lane) * 8) = (u32x4){rlo.x, rlo.y, rhi.x, rhi.y};
    }
    {
        bf16* BKg = (bf16*)(outb + OUT_BK) + (size_t)ci * 2048; const int kt = lane >> 4, mm = lane & 15;
#pragma unroll
        for (int qq = 0; qq < 4; ++qq)
            *(u32x4*)(BKg + (kt * 64 + mm + 16 * qq) * 8) = (u32x4){pk2(Bh[4 * qq], Bh[4 * qq + 1]), pk2(Bh[4 * qq + 2], Bh[4 * qq + 3]), pk2(Kh[4 * qq], Kh[4 * qq + 1]), pk2(Kh[4 * qq + 2], Kh[4 * qq + 3])};
        ((float*)(outb + OUT_PC))[(size_t)ci * 256 + lane] = __expf(lpc);
    }
    asm volatile("s_waitcnt lgkmcnt(0)" ::: "memory");
}

constexpr int S2_SLOT = 13312, S2_D = 8, S2_NS = S2_D + 1;
constexpr int SO_AH = 0, SO_RT = 2048, SO_MA = 4096, SO_NN = 5120, SO_BK = 6144, SO_V = 10240, SO_PC = 12288;
static_assert(S2_NS * S2_SLOT <= 131072, "S2 ring");
struct S2Ops { bf16x8 ah0, ah1, rt0, rt1, ma, nn, bk0, bk1, bk2, bk3; f32x4 pc0, pc1, pc2, pc3; unsigned vm01, vm23; };
#define S2_DMA(gptr, loff) __builtin_amdgcn_global_load_lds((const unsigned*)(gptr), (LAS unsigned*)(slot_ + (loff)), 16, 0, 0)
__device__ __forceinline__ void s2_phase(unsigned char* ws, unsigned char* outb, LAS unsigned char* lds, int tid, int lane, int wid) {
    const bf16* AHg = (const bf16*)(ws + WS_AH); const bf16* RTg = (const bf16*)(ws + WS_RT); const bf16* MAg = (const bf16*)(ws + WS_MA); const bf16* NNg = (const bf16*)(ws + WS_NN);
    const bf16* BKg = (const bf16*)(outb + OUT_BK); const float* PCg = (const float*)(outb + OUT_PC); const bf16* VLg = (const bf16*)(ws + WS_VL);
    float* Yg = (float*)(ws + WS_Y);
    for (int bh = blockIdx.x; bh < 64; bh += gridDim.x) {
        const int b = bh >> 3, h = bh & 7; const size_t rowbase = (size_t)b * SEQ;
        const int q = lane >> 4, n = lane & 15;
        if (wid >= 4) {
            const int lw = wid - 4;
#define S2_ISSUE(cc) do { LAS unsigned char* slot_ = lds + ((cc) % S2_NS) * S2_SLOT; const size_t ci_ = (size_t)bh * 512 + (cc); \
                if (lw == 0) { S2_DMA(AHg + ci_ * 1024 + lane * 8, SO_AH); S2_DMA(AHg + ci_ * 1024 + 512 + lane * 8, SO_AH + 1024); S2_DMA(PCg + ci_ * 256 + lane * 4, SO_PC); } \
                else if (lw == 1) { S2_DMA(RTg + ci_ * 1024 + lane * 8, SO_RT); S2_DMA(RTg + ci_ * 1024 + 512 + lane * 8, SO_RT + 1024); S2_DMA(MAg + ci_ * 512 + lane * 8, SO_MA); } \
                else if (lw == 2) { S2_DMA(NNg + ci_ * 512 + lane * 8, SO_NN); \
                    S2_DMA(VLg + (rowbase + (size_t)(cc) * 16 + (lane >> 3)) * RW + h * 64 + (lane & 7) * 8, SO_V); \
                    S2_DMA(VLg + (rowbase + (size_t)(cc) * 16 + 8 + (lane >> 3)) * RW + h * 64 + (lane & 7) * 8, SO_V + 1024); } \
                else { S2_DMA(BKg + ci_ * 2048 + lane * 8, SO_BK); S2_DMA(BKg + ci_ * 2048 + 512 + lane * 8, SO_BK + 1024); \
                    S2_DMA(BKg + ci_ * 2048 + 1024 + lane * 8, SO_BK + 2048); S2_DMA(BKg + ci_ * 2048 + 1536 + lane * 8, SO_BK + 3072); } } while (0)
#define S2_WAIT() do { if (lw == 3) asm volatile("s_waitcnt vmcnt(24)" ::: "memory"); else asm volatile("s_waitcnt vmcnt(18)" ::: "memory"); } while (0)
#pragma unroll 1
            for (int cc = 0; cc < S2_D; ++cc) S2_ISSUE(cc);
            S2_WAIT(); __builtin_amdgcn_s_barrier(); asm volatile("" ::: "memory");
#pragma unroll 1
            for (int i = 0; i < 512; ++i) {
                if (i + S2_D < 512) { S2_ISSUE(i + S2_D); S2_WAIT(); } else asm volatile("s_waitcnt vmcnt(0)" ::: "memory");
                __builtin_amdgcn_s_barrier(); asm volatile("" ::: "memory");
            }
#undef S2_ISSUE
#undef S2_WAIT
        } else {
            const int vq = wid;
            f32x4 ST0 = (f32x4){0.f, 0.f, 0.f, 0.f}, ST1 = ST0, ST2 = ST0, ST3 = ST0;
            const f32x4 z4 = ST0;
            S2Ops A_, B_;
#define S2_LOAD(O, cc) do { LAS const unsigned char* sb_ = lds + ((cc) % S2_NS) * S2_SLOT; \
                O.ah0 = *(LAS const bf16x8*)(sb_ + SO_AH + lane * 16); O.ah1 = *(LAS const bf16x8*)(sb_ + SO_AH + 1024 + lane * 16); \
                O.rt0 = *(LAS const bf16x8*)(sb_ + SO_RT + lane * 16); O.rt1 = *(LAS const bf16x8*)(sb_ + SO_RT + 1024 + lane * 16); \
                O.ma = *(LAS const bf16x8*)(sb_ + SO_MA + lane * 16); O.nn = *(LAS const bf16x8*)(sb_ + SO_NN + lane * 16); \
                O.bk0 = *(LAS const bf16x8*)(sb_ + SO_BK + lane * 16); O.bk1 = *(LAS const bf16x8*)(sb_ + SO_BK + 1024 + lane * 16); \
                O.bk2 = *(LAS const bf16x8*)(sb_ + SO_BK + 2048 + lane * 16); O.bk3 = *(LAS const bf16x8*)(sb_ + SO_BK + 3072 + lane * 16); \
                O.pc0 = *(LAS const f32x4*)(sb_ + SO_PC + (0 + 4 * q) * 4); O.pc1 = *(LAS const f32x4*)(sb_ + SO_PC + (16 + 4 * q) * 4); \
                O.pc2 = *(LAS const f32x4*)(sb_ + SO_PC + (32 + 4 * q) * 4); O.pc3 = *(LAS const f32x4*)(sb_ + SO_PC + (48 + 4 * q) * 4); \
                { const LAS unsigned short* vp_ = (const LAS unsigned short*)(sb_ + SO_V + (4 * q) * 128 + (16 * vq + n) * 2); \
                  O.vm01 = (unsigned)vp_[0] | ((unsigned)vp_[64] << 16); O.vm23 = (unsigned)vp_[128] | ((unsigned)vp_[192] << 16); } } while (0)
#define S2_STEP(O, cc) do { \
                const bf16x8 bs0_ = mk8(pk2(ST0[0], ST0[1]), pk2(ST0[2], ST0[3]), pk2(ST1[0], ST1[1]), pk2(ST1[2], ST1[3])); \
                const bf16x8 bs1_ = mk8(pk2(ST2[0], ST2[1]), pk2(ST2[2], ST2[3]), pk2(ST3[0], ST3[1]), pk2(ST3[2], ST3[3])); \
                const bf16x8 vb_ = mk8(0u, 0u, O.vm01, O.vm23); \
                f32x4 ut_ = MFMA16(O.ah0, bs0_, z4); ut_ = MFMA16(O.ah1, bs1_, ut_); ut_ = MFMA16(O.ma, vb_, ut_); \
                const bf16x8 uv_ = mk8(pk2(ut_[0], ut_[1]), pk2(ut_[2], ut_[3]), O.vm01, O.vm23); \
                f32x4 yt_ = MFMA16(O.rt0, bs0_, z4); yt_ = MFMA16(O.rt1, bs1_, yt_); yt_ = MFMA16(O.nn, uv_, yt_); \
                ST0 = MFMA16(O.bk0, uv_, O.pc0 * ST0); ST1 = MFMA16(O.bk1, uv_, O.pc1 * ST1); ST2 = MFMA16(O.bk2, uv_, O.pc2 * ST2); ST3 = MFMA16(O.bk3, uv_, O.pc3 * ST3); \
                float* yp_ = Yg + (rowbase + (size_t)(cc) * 16 + 4 * q) * RW + h * 64 + 16 * vq + n; \
                yp_[0] = yt_[0]; yp_[RW] = yt_[1]; yp_[2 * RW] = yt_[2]; yp_[3 * RW] = yt_[3]; } while (0)
            __builtin_amdgcn_s_barrier(); asm volatile("" ::: "memory");
            S2_LOAD(A_, 0);
#pragma unroll 1
            for (int i = 0; i < 512; i += 2) {
                S2_LOAD(B_, i + 1);
                S2_STEP(A_, i);
                asm volatile("s_waitcnt lgkmcnt(0)" ::: "memory"); __builtin_amdgcn_s_barrier(); asm volatile("" ::: "memory");
                if (i + 2 < 512) S2_LOAD(A_, i + 2);
                S2_STEP(B_, i + 1);
                asm volatile("s_waitcnt lgkmcnt(0)" ::: "memory"); __builtin_amdgcn_s_barrier(); asm volatile("" ::: "memory");
            }
#undef S2_LOAD
#undef S2_STEP
        }
        __builtin_amdgcn_s_barrier(); asm volatile("" ::: "memory");
    }
}

__global__ void __launch_bounds__(NTHR, 2) fwd_megakernel(Args A) {
    extern __shared__ __attribute__((aligned(16))) unsigned char lds_raw[];
    LAS unsigned char* lds = (LAS unsigned char*)lds_raw;
    cg::grid_group grid = cg::this_grid();
    const int tid = threadIdx.x, lane = tid & 63, wave = __builtin_amdgcn_readfirstlane(tid >> 6);
    unsigned char* ws = A.ws;
    const int lo = A.ph_lo, hi = A.ph_hi;
    const int gw = blockIdx.x * NWAVES + wave, NGW = gridDim.x * NWAVES;
    float* MOD = (float*)(ws + WS_MOD);
#ifndef PHASE_MASK
#define PHASE_MASK 0xfff
#endif
#define IN(k) (((PHASE_MASK >> (k)) & 1) && lo <= (k) && (k) < hi)
#define SEAM(k) do { if (IN(k) && IN((k) + 1)) grid.sync(); } while (0)
#ifndef REPEAT_MASK
#define REPEAT_MASK 0
#endif
#define REP(k) for (int rep_ = 0; rep_ < (((REPEAT_MASK >> (k)) & 1) ? 2 : 1); ++rep_, (void)((rep_ < (((REPEAT_MASK >> (k)) & 1) ? 2 : 1)) ? (grid.sync(), 0) : 0))

    if (IN(0)) { p0_prologue(A, lds, tid, lane, wave); } SEAM(0);
    REP(1) if (IN(1)) {
        int m = gw;
        for (; m + 3 * NGW < M; m += 4 * NGW) norm_mod_rows<4>(A.in[0], (bf16*)(ws + WS_XN), MOD, 0, m, NGW, lane);
        for (; m < M; m += NGW) norm_mod_rows<1>(A.in[0], (bf16*)(ws + WS_XN), MOD, 0, m, NGW, lane);
    } SEAM(1);
#ifdef DUP2
    if (IN(2)) {
        pg8::Gemm g{(const bf16*)(ws + WS_XN), (const bf16*)(ws + WS_WIN), M, PT, D}; pg8::StaticOrder S; S.init(M, PT, gridDim.x, blockIdx.x);
        EpiBf<0> E{(bf16*)(ws + WS_P), PT};
        pg8::gemm_phase<EpiBf<0>, pg8::StaticOrder, true, true>(lds, g, S, E);
    } grid.sync();
#endif
    REP(2) if (IN(2)) {
        pg8::Gemm g{(const bf16*)(ws + WS_XN), (const bf16*)(ws + WS_WIN), M, PT, D}; pg8::StaticOrder S; S.init(M, PT, gridDim.x, blockIdx.x);
        EpiBf<0> E{(bf16*)(ws + WS_P), PT};
        pg8::gemm_phase<EpiBf<0>, pg8::StaticOrder, true, true>(lds, g, S, E);
    } SEAM(2);
    REP(3) if (IN(3)) { for (int m = gw; m < M; m += NGW) mix_row(A, m, lane); } SEAM(3);
    REP(4) if (IN(4)) {
        pg8::Gemm g{(const bf16*)(ws + WS_LA), (const bf16*)(ws + WS_LT), M, LN, LK}; pg8::StaticOrder S; S.init(M, LN, gridDim.x, blockIdx.x);
        EpiLora E{A.in[7], A.in[9], A.in[13], (const bf16*)(ws + WS_KL), (const bf16*)(ws + WS_KK), (float*)(ws + WS_DEC), (bf16*)(ws + WS_KP), (bf16*)(ws + WS_BV), (bf16*)(ws + WS_G)};
        pg8::gemm_phase<EpiLora, pg8::StaticOrder, true, true>(lds, g, S, E);
    } SEAM(4);
#if SCAN_CHUNKED
    if (IN(5)) {
        for (int ci = gw; ci < 64 * 512; ci += NGW) s1_item(ws, (unsigned char*)A.out, lds + wave * S1_WAVE, ci, lane);
        grid.sync();
        s2_phase(ws, (unsigned char*)A.out, lds, tid, lane, wave);
    } SEAM(5);
#else
    REP(5) if (IN(5)) { scan_phase(ws, lds, tid, lane, wave); } SEAM(5);
#endif
    REP(6) if (IN(6)) { int m = gw; for (; m + 3 * NGW < M; m += 4 * NGW) post_rows<4>(A, m, NGW, lane); for (; m < M; m += NGW) post_rows<1>(A, m, NGW, lane); } SEAM(6);
    REP(7) if (IN(7)) {
        pg8::Gemm g{(const bf16*)(ws + WS_MIX), (const bf16*)(ws + WS_WOUT), M, D, D}; pg8::StaticOrder S; S.init(M, D, gridDim.x, blockIdx.x);
        EpiRes E{A.in[0], A.out, MOD + 2 * D};
        pg8::gemm_phase<EpiRes, pg8::StaticOrder, true, true>(lds, g, S, E);
    } SEAM(7);
    REP(8) if (IN(8)) {
        int m = gw;
        for (; m + 3 * NGW < M; m += 4 * NGW) norm_mod_rows<4>(A.out, (bf16*)(ws + WS_XN), MOD, 3, m, NGW, lane);
        for (; m < M; m += NGW) norm_mod_rows<1>(A.out, (bf16*)(ws + WS_XN), MOD, 3, m, NGW, lane);
    } SEAM(8);
#ifdef DUP9
    if (IN(9)) {
        pg8::Gemm g{(const bf16*)(ws + WS_XN), (const bf16*)(ws + WS_WUP), M, FF, D}; pg8::StaticOrder S; S.init(M, FF, gridDim.x, blockIdx.x);
        EpiBf<1> E{(bf16*)(ws + WS_H), FF};
        pg8::gemm_phase<EpiBf<1>, pg8::StaticOrder, true, true>(lds, g, S, E);
    } grid.sync();
#endif
    REP(9) if (IN(9)) {
        pg8::Gemm g{(const bf16*)(ws + WS_XN), (const bf16*)(ws + WS_WUP), M, FF, D}; pg8::StaticOrder S; S.init(M, FF, gridDim.x, blockIdx.x);
        EpiBf<1> E{(bf16*)(ws + WS_H), FF};
        pg8::gemm_phase<EpiBf<1>, pg8::StaticOrder, true, true>(lds, g, S, E);
    } SEAM(9);
    if (IN(10)) {
        pg8::Gemm g{(const bf16*)(ws + WS_H), (const bf16*)(ws + WS_WDN), M, D, FF}; pg8::StaticOrder S; S.init(M, D, gridDim.x, blockIdx.x);
        EpiRes E{A.out, A.out, MOD + 5 * D};
        pg8::gemm_phase<EpiRes, pg8::StaticOrder, true, true>(lds, g, S, E);
    } SEAM(10);
    if (IN(11)) { int m = gw; for (; m + 3 * NGW < M; m += 4 * NGW) final_rows<4>(A.out, A.in[20], m, NGW, lane); for (; m < M; m += NGW) final_rows<1>(A.out, A.in[20], m, NGW, lane); }
#undef IN
#undef SEAM
}

extern "C" void kernel_launch(void* const* d_in, const int* in_sizes, int n_in, void* d_out, int out_size, void* d_ws, size_t ws_size, hipStream_t stream) {
    static int grid_blocks = 0;
    if (grid_blocks == 0) {
        if (n_in != 21 || out_size != M * D || ws_size < WS_END) { fprintf(stderr, "kernel_launch: unexpected shapes (n_in %d out %d ws %zu)\n", n_in, out_size, ws_size); grid_blocks = -1; return; }
        int dev = 0, cus = 0, per_cu = 0;
        hipGetDevice(&dev);
        hipDeviceGetAttribute(&cus, hipDeviceAttributeMultiprocessorCount, dev);
        if (hipFuncSetAttribute((const void*)fwd_megakernel, hipFuncAttributeMaxDynamicSharedMemorySize, LDS_BYTES) != hipSuccess) { fprintf(stderr, "kernel_launch: hipFuncSetAttribute failed\n"); grid_blocks = -1; return; }
        if (hipOccupancyMaxActiveBlocksPerMultiprocessor(&per_cu, (const void*)fwd_megakernel, NTHR, LDS_BYTES) != hipSuccess || per_cu < 1) { fprintf(stderr, "kernel_launch: occupancy query failed (%d)\n", per_cu); grid_blocks = -1; return; }
        grid_blocks = cus * per_cu;
    }
    if (grid_blocks < 0) return;
    hipMemsetAsync((char*)d_ws + WS_MOD, 0, CTL_ZERO_BYTES, stream);
    Args a{};
    for (int i = 0; i < 21; ++i) a.in[i] = (const float*)d_in[i];
    a.out = (float*)d_out; a.ws = (unsigned char*)d_ws;
#if MK_SPLIT
    for (int ph = 0; ph < NPHASE; ++ph) {
        a.ph_lo = ph; a.ph_hi = ph + 1;
#else
    {
        a.ph_lo = 0; a.ph_hi = NPHASE;
#endif
        void* args[] = {&a};
        hipError_t e = hipLaunchCooperativeKernel((const void*)fwd_megakernel, dim3(grid_blocks), dim3(NTHR), args, LDS_BYTES, stream);
        if (e != hipSuccess) fprintf(stderr, "kernel_launch: cooperative launch failed: %s (grid %d)\n", hipGetErrorString(e), grid_blocks);
    }
}
```

```cpp
#include <hip/hip_runtime.h>
#include <hip/hip_cooperative_groups.h>
#include <cstdio>
#include <cstdint>
namespace cg = cooperative_groups;
namespace pg8 {
#define PG8_LAS __attribute__((address_space(3)))
typedef unsigned short bf16_t;
typedef short bf16x8 __attribute__((ext_vector_type(8)));
typedef float f32x4 __attribute__((ext_vector_type(4)));
typedef unsigned u32x4 __attribute__((ext_vector_type(4)));
constexpr int BM = 256, BK = 64, HALF = 128, HTB = HALF * BK * 2  , STAGE_BYTES = 8 * HTB, NXCD = 8, WGM = 8;

__host__ __device__ __forceinline__ int lds_byte(int r, int c) { const int st = (r >> 4) * 2 + (c >> 5), rr = r & 15, cc = c & 31, ob = rr * 64 + cc * 2; return st * 1024 + (ob ^ (((ob >> 9) & 1) << 5)); }
__host__ __device__ __forceinline__ void stage_rc(int b, int& R, int& C) { const int st = b / 1024, sb = b % 1024, swz = sb ^ (((sb >> 9) & 1) << 5); R = (st >> 1) * 16 + swz / 64; C = (st & 1) * 32 + (swz % 64) / 2; }
__host__ __device__ __forceinline__ int perm32(int rho) { const int n = rho >> 4, i = rho & 15; return 8 * (i >> 2) + 4 * n + (i & 3); }

struct Unit { int pm, pn; };
struct Gemm { const bf16_t* A; const bf16_t* Bt; int M, N, K; };

struct StaticOrder {
    int nM, nN, nwg, G, c;
    __host__ __device__ void init(int M, int N, int G_, int c_) { nM = M / BM; nN = N / BM; nwg = nM * nN; G = G_; c = c_; }
    __host__ __device__ bool next(int i, Unit& u) const {
        const long L = (long)i * G + c; if (L >= nwg) return false;
        int wgid = (int)L; { const int q = nwg / NXCD, r = nwg % NXCD, xcd = wgid % NXCD, off = wgid / NXCD; wgid = (xcd < r ? xcd * (q + 1) : r * (q + 1) + (xcd - r) * q) + off; }
        const int nig = WGM * nN, gid = wgid / nig, fm = gid * WGM, gsz = (nM - fm) < WGM ? (nM - fm) : WGM;
        u.pm = fm + ((wgid % nig) % gsz); u.pn = (wgid % nig) / gsz; return true;
    }
    __device__ __forceinline__ void a_ready(const Unit&) const {}
    __device__ __forceinline__ void done(const Unit&) const {}
};
__device__ __forceinline__ unsigned cvt_pk_bf16(float lo, float hi) { unsigned r; asm volatile("v_cvt_pk_bf16_f32 %0, %1, %2" : "=v"(r) : "v"(lo), "v"(hi)); return r; }
template <class Epi, class Sched, bool ALIGN_EPI = false, bool SP2 = false>
__device__ __forceinline__ void gemm_phase(PG8_LAS unsigned char* lds, const Gemm g, const Sched& S, const Epi& E) {
    const int tid = threadIdx.x, wid = __builtin_amdgcn_readfirstlane(tid >> 6), lane = tid & 63, wr = wid >> 2, wc = wid & 3, fr = lane & 15, fq = lane >> 4;
    const int K = g.K, nt = K / BK;
    unsigned voffA[2], voffB[2];
#pragma unroll
    for (int i = 0; i < 2; ++i) { int R, C; stage_rc(tid * 16 + i * 8192, R, C); const int Rb = Epi::PERM ? ((R & ~31) + perm32(R & 31)) : R;
        voffA[i] = (unsigned)(R * K + C) * 2u; voffB[i] = (unsigned)(Rb * K + C) * 2u; }
    const size_t kstep = (size_t)(BK * 2);
    const size_t hstep = (size_t)HALF * K * 2;
    const size_t tstep = 2 * hstep;
    const unsigned ldsw = (unsigned)wid * 1024u;
    const int aoff = lds_byte(wr * 64 + fr, fq * 8), boff = lds_byte(wc * 32 + fr, fq * 8);
#define PG8_SA(b, h) (((b) * 2 + (h)) * HTB)
#define PG8_SB(b, h) ((4 + (b) * 2 + (h)) * HTB)
#define PG8_STAGE(bufoff, gbase, voff) do { _Pragma("unroll") for (int _i = 0; _i < 2; ++_i) \
        __builtin_amdgcn_global_load_lds((const unsigned*)((const char*)(gbase) + (voff)[_i]), (PG8_LAS unsigned*)(lds + (bufoff) + ldsw + _i * 8192), 16, 0, 0); } while (0)
#define PG8_LDA(dst, b, h) do { _Pragma("unroll") for (int m = 0; m < 4; ++m) _Pragma("unroll") for (int k = 0; k < 2; ++k) dst[m][k] = *(const PG8_LAS bf16x8*)(lds + PG8_SA(b, h) + aoff + m * 2048 + k * 1024); } while (0)
#define PG8_LDB(dst, b, h) do { _Pragma("unroll") for (int n = 0; n < 2; ++n) _Pragma("unroll") for (int k = 0; k < 2; ++k) dst[n][k] = *(const PG8_LAS bf16x8*)(lds + PG8_SB(b, h) + boff + n * 2048 + k * 1024); } while (0)
#define PG8_MMA(ai, bj, At, Bt) do { __builtin_amdgcn_s_setprio(1); _Pragma("unroll") for (int m = 0; m < 4; ++m) _Pragma("unroll") for (int n = 0; n < 2; ++n) _Pragma("unroll") for (int k = 0; k < 2; ++k) \
        acc[ai][bj][m][n] = __builtin_amdgcn_mfma_f32_16x16x32_bf16(Bt[n][k], At[m][k], acc[ai][bj][m][n], 0, 0, 0); __builtin_amdgcn_s_setprio(0); } while (0)
#define PG8_WAIT_V(n) asm volatile("s_waitcnt vmcnt(" #n ")" ::: "memory")
#define PG8_WAIT_L(n) asm volatile("s_waitcnt lgkmcnt(" #n ")" ::: "memory")
#define PG8_BAR __builtin_amdgcn_s_barrier()
#define PG8_SCHED __builtin_amdgcn_sched_barrier(0)
    Unit cur, nxt; int ui = 0;
    if (!S.next(0, cur)) return;
    f32x4 acc[2][2][4][2];
#pragma unroll
    for (int a = 0; a < 2; ++a)
#pragma unroll
        for (int b = 0; b < 2; ++b)
#pragma unroll
            for (int m = 0; m < 4; ++m)
#pragma unroll
                for (int n = 0; n < 2; ++n) acc[a][b][m][n] = (f32x4){0.f, 0.f, 0.f, 0.f};
    bf16x8 At[4][2], B0[2][2], B1[2][2];
    const char* cA = (const char*)g.A + (size_t)cur.pm * tstep; const char* cB = (const char*)g.Bt + (size_t)cur.pn * tstep;
    S.a_ready(cur);
    if constexpr (SP2) {
        PG8_STAGE(PG8_SB(0, 0), cB, voffB); PG8_STAGE(PG8_SB(0, 1), cB + hstep, voffB); PG8_STAGE(PG8_SA(0, 0), cA, voffA); PG8_STAGE(PG8_SA(0, 1), cA + hstep, voffA);
        if (wr == 1) PG8_BAR;
        PG8_WAIT_V(2); PG8_BAR;
        PG8_STAGE(PG8_SB(1, 0), cB + kstep, voffB); PG8_STAGE(PG8_SA(1, 0), cA + kstep, voffA); PG8_STAGE(PG8_SB(1, 1), cB + hstep + kstep, voffB);
        PG8_WAIT_V(6); PG8_BAR;
    } else {
        PG8_STAGE(PG8_SB(0, 0), cB, voffB); PG8_STAGE(PG8_SA(0, 0), cA, voffA); PG8_STAGE(PG8_SB(0, 1), cB + hstep, voffB); PG8_STAGE(PG8_SA(0, 1), cA + hstep, voffA);
        if (wr == 1) PG8_BAR;
        PG8_WAIT_V(4); PG8_BAR;
        PG8_STAGE(PG8_SB(1, 0), cB + kstep, voffB); PG8_STAGE(PG8_SA(1, 0), cA + kstep, voffA); PG8_STAGE(PG8_SB(1, 1), cB + hstep + kstep, voffB);
        PG8_WAIT_V(6); PG8_BAR;
    }
    for (;;) {
        const bool has_next = S.next(ui + 1, nxt);
        const char* nA = has_next ? (const char*)g.A + (size_t)nxt.pm * tstep : cA; const char* nB = has_next ? (const char*)g.Bt + (size_t)nxt.pn * tstep : cB;
#pragma unroll 1
        for (int t = 0; t < nt; t += 2) {
            const bool last = (t == nt - 2);
            const char* a1 = cA + (size_t)(t + 1) * kstep;
            const char* a2 = last ? nA : cA + (size_t)(t + 2) * kstep; const char* b2 = last ? nB : cB + (size_t)(t + 2) * kstep;
            const char* a3 = a2 + kstep; const char* b3 = b2 + kstep;
            if (last && has_next) S.a_ready(nxt);
            if constexpr (SP2) {
            PG8_LDB(B0, 0, 0); PG8_LDB(B1, 0, 1); PG8_SCHED; PG8_LDA(At, 0, 0); PG8_STAGE(PG8_SA(1, 1), a1 + hstep, voffA);
            PG8_WAIT_V(8); PG8_WAIT_L(0); PG8_BAR; PG8_MMA(0, 0, At, B0); PG8_MMA(0, 1, At, B1); PG8_BAR; PG8_SCHED;
            PG8_LDA(At, 0, 1); PG8_STAGE(PG8_SB(0, 0), b2, voffB); PG8_STAGE(PG8_SB(0, 1), b2 + hstep, voffB); PG8_STAGE(PG8_SA(0, 0), a2, voffA);
            PG8_WAIT_V(8); PG8_WAIT_L(0); PG8_BAR; PG8_MMA(1, 0, At, B0); PG8_MMA(1, 1, At, B1); PG8_BAR; PG8_SCHED;
            PG8_LDB(B0, 1, 0); PG8_LDB(B1, 1, 1); PG8_SCHED; PG8_LDA(At, 1, 0); PG8_STAGE(PG8_SA(0, 1), a2 + hstep, voffA);
            PG8_WAIT_V(8); PG8_WAIT_L(0); PG8_BAR; PG8_MMA(0, 0, At, B0); PG8_MMA(0, 1, At, B1); PG8_BAR; PG8_SCHED;
            PG8_LDA(At, 1, 1); PG8_STAGE(PG8_SB(1, 0), b3, voffB); PG8_STAGE(PG8_SB(1, 1), b3 + hstep, voffB); PG8_STAGE(PG8_SA(1, 0), a3, voffA);
            PG8_WAIT_V(8); PG8_WAIT_L(0); PG8_BAR; PG8_MMA(1, 0, At, B0); PG8_MMA(1, 1, At, B1); PG8_BAR; PG8_SCHED;
            } else {
            PG8_LDB(B0, 0, 0); PG8_SCHED; PG8_LDA(At, 0, 0); PG8_STAGE(PG8_SA(1, 1), a1 + hstep, voffA);
            PG8_WAIT_L(8); PG8_BAR; PG8_WAIT_L(0); PG8_MMA(0, 0, At, B0); PG8_BAR; PG8_SCHED;
            PG8_LDB(B1, 0, 1); PG8_STAGE(PG8_SB(0, 0), b2, voffB);
            PG8_BAR; PG8_WAIT_L(0); PG8_MMA(0, 1, At, B1); PG8_BAR;
            PG8_LDA(At, 0, 1); PG8_STAGE(PG8_SA(0, 0), a2, voffA);
            PG8_BAR; PG8_WAIT_L(0); PG8_MMA(1, 0, At, B0); PG8_BAR; PG8_SCHED;
            PG8_STAGE(PG8_SB(0, 1), b2 + hstep, voffB);
            PG8_WAIT_V(6); PG8_BAR; PG8_MMA(1, 1, At, B1); PG8_BAR;
            PG8_LDB(B0, 1, 0); PG8_SCHED; PG8_LDA(At, 1, 0); PG8_STAGE(PG8_SA(0, 1), a2 + hstep, voffA);
            PG8_WAIT_L(8); PG8_BAR; PG8_WAIT_L(0); PG8_MMA(0, 0, At, B0); PG8_BAR; PG8_SCHED;
            PG8_LDB(B1, 1, 1); PG8_STAGE(PG8_SB(1, 0), b3, voffB);
            PG8_BAR; PG8_WAIT_L(0); PG8_MMA(0, 1, At, B1); PG8_BAR;
            PG8_LDA(At, 1, 1); PG8_STAGE(PG8_SA(1, 0), a3, voffA);
            PG8_BAR; PG8_WAIT_L(0); PG8_MMA(1, 0, At, B0); PG8_BAR; PG8_SCHED;
            PG8_STAGE(PG8_SB(1, 1), b3 + hstep, voffB);
            PG8_WAIT_V(6); PG8_BAR; PG8_MMA(1, 1, At, B1); PG8_BAR;
            }
        }
        if constexpr (ALIGN_EPI) { if (wr == 0) PG8_BAR; }
        if constexpr (!Epi::AFTER_DRAIN) { E(acc, cur, wr, wc, fr, fq); S.done(cur); }
        if (!has_next) break;
#pragma unroll
        for (int a = 0; a < 2; ++a)
#pragma unroll
            for (int b = 0; b < 2; ++b)
#pragma unroll
                for (int m = 0; m < 4; ++m)
#pragma unroll
                    for (int n = 0; n < 2; ++n) acc[a][b][m][n] = (f32x4){0.f, 0.f, 0.f, 0.f};
        cur = nxt; cA = nA; cB = nB; ++ui;
        if constexpr (ALIGN_EPI) { if (wr == 1) PG8_BAR; }
    }
    PG8_WAIT_V(0);
    if constexpr (!ALIGN_EPI) { if (wr == 0) PG8_BAR; }
    PG8_BAR;
    if constexpr (Epi::AFTER_DRAIN) { E.fused(acc, cur, wr, wc, fr, fq, lds, wid, lane); S.done(cur); }
#undef PG8_SA
#undef PG8_SB
#undef PG8_STAGE
#undef PG8_LDA
#undef PG8_LDB
#undef PG8_MMA
#undef PG8_WAIT_V
#undef PG8_WAIT_L
#undef PG8_BAR
#undef PG8_SCHED
}
}

#ifndef CONV_UNDER_S2
#define CONV_UNDER_S2 1
#endif
#ifndef SHADOW_EXTRA
#define SHADOW_EXTRA 1
#endif
#ifndef MK_SPLIT
#define MK_SPLIT 0
#endif
constexpr int NWAVES = 8, NTHR = 512;
constexpr int BATCH = 8, SEQ = 8192, D = 1024, M = BATCH * SEQ;
constexpr int PCONV = 1536, PT = 3328, FF = 4096, RW = 512;
constexpr int LK = 256, LN = 1536;
constexpr int NMOD = 6 * D;
constexpr int NPHASE = 12;
constexpr size_t MiB = 1u << 20;
constexpr size_t WS_MOD = 0, WS_RS2 = 256 * 1024, WS_RS3 = 512 * 1024, WS_BIAS2 = 768 * 1024, CTL_ZERO_BYTES = 1024 * 1024;
constexpr size_t WS_X1B = 704ull << 20, WS_X2B = 864ull << 20;
constexpr size_t WS_WIN = 1 * MiB, WS_WOUT = 8 * MiB, WS_WUP = 10 * MiB, WS_WDN = 18 * MiB, WS_LT = 26 * MiB;
constexpr size_t WS_XN = 32 * MiB;
constexpr size_t WS_Y = 32 * MiB;
constexpr size_t WS_P = 160 * MiB;
constexpr size_t WS_DEC = 32 * MiB  , WS_KP = 576 * MiB  , WS_BV = 352 * MiB  , WS_G = 640 * MiB  ;
constexpr size_t WS_H = 160 * MiB;
constexpr size_t WS_RL = 576 * MiB, WS_KL = 640 * MiB, WS_VL = 704 * MiB, WS_KK = 768 * MiB;
constexpr size_t WS_LA = 832 * MiB;
constexpr size_t WS_MIX = 864 * MiB;
constexpr size_t WS_END = 1024 * MiB;
constexpr int LDS_MISC = 131072, LDS_BYTES = 131072 + 2048;

typedef unsigned short bf16;
typedef float f32x4 __attribute__((ext_vector_type(4)));
typedef float f32x2 __attribute__((ext_vector_type(2)));
typedef unsigned u32x4 __attribute__((ext_vector_type(4)));
typedef unsigned u32x2 __attribute__((ext_vector_type(2)));
#define LAS __attribute__((address_space(3)))

typedef __bf16 bf16v2_t __attribute__((ext_vector_type(2)));
__device__ __forceinline__ unsigned pk2(float lo, float hi) { return __builtin_bit_cast(unsigned, __builtin_convertvector((f32x2){lo, hi}, bf16v2_t)); }
__device__ __forceinline__ float bflo(unsigned w) { return __uint_as_float(w << 16); }
__device__ __forceinline__ float bfhi(unsigned w) { return __uint_as_float(w & 0xffff0000u); }
__device__ __forceinline__ void unpack8(const u32x4 w, float (&f)[8]) {
    f[0] = bflo(w.x); f[1] = bfhi(w.x); f[2] = bflo(w.y); f[3] = bfhi(w.y); f[4] = bflo(w.z); f[5] = bfhi(w.z); f[6] = bflo(w.w); f[7] = bfhi(w.w);
}
__device__ __forceinline__ u32x4 pack8(const float (&f)[8]) { u32x4 w; w.x = pk2(f[0], f[1]); w.y = pk2(f[2], f[3]); w.z = pk2(f[4], f[5]); w.w = pk2(f[6], f[7]); return w; }
__device__ __forceinline__ void ld8f(const float* p, float (&f)[8]) { const f32x4 a = *(const f32x4*)p, b = *(const f32x4*)(p + 4); f[0] = a.x; f[1] = a.y; f[2] = a.z; f[3] = a.w; f[4] = b.x; f[5] = b.y; f[6] = b.z; f[7] = b.w; }
__device__ __forceinline__ float wave_sum(float v) {
#pragma unroll
    for (int o = 1; o < 64; o <<= 1) v += __shfl_xor(v, o);
    return v;
}
__device__ __forceinline__ float sum8(float v) { v += __shfl_xor(v, 1); v += __shfl_xor(v, 2); v += __shfl_xor(v, 4); return v; }
__device__ __forceinline__ float sigmoidf_(float x) { return 1.0f / (1.0f + __expf(-x)); }

struct Args { const float* in[21]; float* out; unsigned char* ws; int ph_lo, ph_hi; };

template <int ACT  , bool TILED = false> struct EpiBf {
    static constexpr bool PERM = true, AFTER_DRAIN = false;
    bf16* O; int ldc;
    __device__ __forceinline__ void operator()(const pg8::f32x4 (&acc)[2][2][4][2], const pg8::Unit& u, int wr, int wc, int fr, int fq) const {
        const int row0 = u.pm * 256 + wr * 64 + fr, col0 = u.pn * 256 + wc * 32 + 8 * fq;
        unsigned long long rp = (unsigned long long)(TILED ? O + ((size_t)(u.pm * 13 + u.pn) << 16) + (size_t)(wr * 64 + fr) * 256 + wc * 32 + 8 * fq : O + (size_t)row0 * ldc + col0);
        const unsigned long long rstep = (unsigned long long)(TILED ? 256 : ldc) * 2ull;
#pragma unroll
        for (int ai = 0; ai < 2; ++ai)
#pragma unroll
            for (int m = 0; m < 4; ++m) { bf16* rowp = (bf16*)rp;
#pragma unroll
                for (int bj = 0; bj < 2; ++bj) { pg8::f32x4 v0 = acc[ai][bj][m][0], v1 = acc[ai][bj][m][1];
                    if (ACT == 1) {
#pragma unroll
                        for (int j = 0; j < 4; ++j) { const float a = fmaxf(v0[j], 0.f), b = fmaxf(v1[j], 0.f); v0[j] = a * a; v1[j] = b * b; } }
                    u32x4 w; w.x = pk2(v0[0], v0[1]); w.y = pk2(v0[2], v0[3]); w.z = pk2(v1[0], v1[1]); w.w = pk2(v1[2], v1[3]);
                    *(u32x4*)(rowp + bj * 128) = w; }
                rp += (m == 3 ? 80ull : 16ull) * rstep;
                asm volatile("" : "+v"(rp) :: "memory"); }
    }
};
struct EpiNull { static constexpr bool PERM = true, AFTER_DRAIN = false; float* sink;
    __device__ __forceinline__ void operator()(const pg8::f32x4 (&acc)[2][2][4][2], const pg8::Unit& u, int wr, int wc, int fr, int fq) const {
        float s = 0.f;
#pragma unroll
        for (int ai = 0; ai < 2; ++ai)
#pragma unroll
            for (int bj = 0; bj < 2; ++bj)
#pragma unroll
                for (int m = 0; m < 4; ++m)
#pragma unroll
                    for (int n = 0; n < 2; ++n) s += acc[ai][bj][m][n][0] + acc[ai][bj][m][n][1] + acc[ai][bj][m][n][2] + acc[ai][bj][m][n][3];
        if (s == 123.456f) sink[0] = s; } };
struct EpiRes {
    static constexpr bool PERM = false, AFTER_DRAIN = false;
    const float* X; float* O; const float* gate;
    __device__ __forceinline__ void operator()(const pg8::f32x4 (&acc)[2][2][4][2], const pg8::Unit& u, int wr, int wc, int fr, int fq) const {
        const int row0 = u.pm * 256 + wr * 64 + fr, col0 = u.pn * 256 + wc * 32 + 4 * fq, b = u.pm >> 5;
        f32x4 gv[2][2];
#pragma unroll
        for (int bj = 0; bj < 2; ++bj)
#pragma unroll
            for (int n = 0; n < 2; ++n) gv[bj][n] = *(const f32x4*)(gate + (size_t)b * NMOD + col0 + bj * 128 + n * 16);
#pragma unroll
        for (int ai = 0; ai < 2; ++ai)
#pragma unroll
            for (int m = 0; m < 4; ++m) { const size_t off = (size_t)(row0 + ai * 128 + m * 16) * D + col0;
#pragma unroll
                for (int bj = 0; bj < 2; ++bj)
#pragma unroll
                    for (int n = 0; n < 2; ++n) { const f32x4 xv = *(const f32x4*)(X + off + bj * 128 + n * 16);
                        *(f32x4*)(O + off + bj * 128 + n * 16) = xv + gv[bj][n] * acc[ai][bj][m][n]; }
                asm volatile("" ::: "memory"); }
    }
};
#ifndef LK0
#define LK0 1
#endif
#ifndef LK1
#define LK1 1
#endif
#ifndef LK2
#define LK2 1
#endif
#ifndef SCAN_CHUNKED
#define SCAN_CHUNKED 1
#endif
#define LORA_LOGW SCAN_CHUNKED
struct EpiLora {
    static constexpr bool PERM = true, AFTER_DRAIN = false;
    const float *w0, *a0, *k_a; const bf16 *KL, *KK; float* DEC; bf16 *KP, *BV, *G;
    __device__ __forceinline__ void operator()(const pg8::f32x4 (&acc)[2][2][4][2], const pg8::Unit& u, int wr, int wc, int fr, int fq) const {
        const int kind = u.pn >> 1, row0 = u.pm * 256 + wr * 64 + fr, cb = (u.pn & 1) * 256 + wc * 32 + 8 * fq;
#pragma unroll
        for (int bj = 0; bj < 2; ++bj) {
            const int c = cb + bj * 128;
            if (LK0 && kind == 0) {
                float wv[8]; ld8f(w0 + c, wv);
#pragma unroll
                for (int ai = 0; ai < 2; ++ai)
#pragma unroll
                    for (int m = 0; m < 4; ++m) { const size_t off = (size_t)(row0 + ai * 128 + m * 16) * RW + c; float o8[8];
#pragma unroll
                        for (int n = 0; n < 2; ++n)
#pragma unroll
                            for (int j = 0; j < 4; ++j) { const float pre = acc[ai][bj][m][n][j] + wv[4 * n + j];
                                o8[4 * n + j] = -0.6065306597f * sigmoidf_(pre); }
                        *(u32x4*)((bf16*)DEC + off) = pack8(o8); asm volatile("" ::: "memory"); }
            } else if (LK1 && kind == 1) {
                float av[8]; ld8f(a0 + c, av);
#pragma unroll
                for (int ai = 0; ai < 2; ++ai)
#pragma unroll
                    for (int m = 0; m < 4; ++m) { const size_t off = (size_t)(row0 + ai * 128 + m * 16) * RW + c; float a8[8];
#pragma unroll
                        for (int n = 0; n < 2; ++n)
#pragma unroll
                            for (int j = 0; j < 4; ++j) a8[4 * n + j] = sigmoidf_(acc[ai][bj][m][n][j] + av[4 * n + j]);
                        *(u32x4*)(KP + off) = pack8(a8); }
            } else if (LK2) {
#pragma unroll
                for (int ai = 0; ai < 2; ++ai)
#pragma unroll
                    for (int m = 0; m < 4; ++m) { const size_t off = (size_t)(row0 + ai * 128 + m * 16) * RW + c;
                        const pg8::f32x4 v0 = acc[ai][bj][m][0], v1 = acc[ai][bj][m][1];
                        u32x4 w; w.x = pk2(v0[0], v0[1]); w.y = pk2(v0[2], v0[3]); w.z = pk2(v1[0], v1[1]); w.w = pk2(v1[2], v1[3]);
                        *(u32x4*)(G + off) = w; }
            }
        }
    }
};


#ifndef FUSED_RES
#define FUSED_RES 1
#endif
#ifndef CONV_UNDER_S2
#define CONV_UNDER_S2 1
#endif
struct EpiRes7 {
    static constexpr bool PERM = true, AFTER_DRAIN = false;
    const float* X; bf16* X1B; bf16* A2; const float* MODp; float* RS;
    __device__ __forceinline__ void operator()(const pg8::f32x4 (&acc)[2][2][4][2], const pg8::Unit& u, int wr, int wc, int fr, int fq) const {
        const int row0 = u.pm * 256 + wr * 64 + fr, col0 = u.pn * 256 + wc * 32 + 8 * fq, b = u.pm >> 5;
        float gv[2][8], sv[2][8];
#pragma unroll
        for (int bj = 0; bj < 2; ++bj) { ld8f(MODp + (size_t)b * NMOD + 2 * D + col0 + bj * 128, gv[bj]); ld8f(MODp + (size_t)b * NMOD + 4 * D + col0 + bj * 128, sv[bj]); }
#pragma unroll
        for (int ai = 0; ai < 2; ++ai)
#pragma unroll
            for (int m = 0; m < 4; ++m) { const int row = row0 + ai * 128 + m * 16; const size_t off = (size_t)row * D + col0; float ss = 0.f;
#pragma unroll
                for (int bj = 0; bj < 2; ++bj) { float xv[8], x1[8], a2[8]; { const f32x4 xa_ = __builtin_nontemporal_load((const f32x4*)(X + off + bj * 128)), xb_ = __builtin_nontemporal_load((const f32x4*)(X + off + bj * 128 + 4)); xv[0] = xa_.x; xv[1] = xa_.y; xv[2] = xa_.z; xv[3] = xa_.w; xv[4] = xb_.x; xv[5] = xb_.y; xv[6] = xb_.z; xv[7] = xb_.w; }
#pragma unroll
                    for (int i = 0; i < 8; ++i) { x1[i] = xv[i] + gv[bj][i] * acc[ai][bj][m][i >> 2][i & 3]; ss += x1[i] * x1[i]; a2[i] = x1[i] * (1.0f + sv[bj][i]); }
                    *(u32x4*)(X1B + off + bj * 128) = pack8(x1); *(u32x4*)(A2 + off + bj * 128) = pack8(a2); }
                ss += __shfl_xor(ss, 16); ss += __shfl_xor(ss, 32);
                if (fq == 0) unsafeAtomicAdd(RS + row, ss);
                asm volatile("" ::: "memory"); }
    }
};
struct EpiUp2 {
    static constexpr bool PERM = true, AFTER_DRAIN = false;
    bf16* O; const float* RS; const float* BIAS;
    __device__ __forceinline__ void operator()(const pg8::f32x4 (&acc)[2][2][4][2], const pg8::Unit& u, int wr, int wc, int fr, int fq) const {
        const int row0 = u.pm * 256 + wr * 64 + fr, col0 = u.pn * 256 + wc * 32 + 8 * fq, b = u.pm >> 5;
        float bv[2][8];
#pragma unroll
        for (int bj = 0; bj < 2; ++bj) ld8f(BIAS + (size_t)b * FF + col0 + bj * 128, bv[bj]);
#pragma unroll
        for (int ai = 0; ai < 2; ++ai)
#pragma unroll
            for (int m = 0; m < 4; ++m) { const int row = row0 + ai * 128 + m * 16; const float rstd = rsqrtf(RS[row] * (1.f / D) + 1e-6f);
                bf16* rowp = O + (size_t)row * FF + col0;
#pragma unroll
                for (int bj = 0; bj < 2; ++bj) { float hv[8];
#pragma unroll
                    for (int i = 0; i < 8; ++i) { const float v = fmaxf(acc[ai][bj][m][i >> 2][i & 3] * rstd + bv[bj][i], 0.f); hv[i] = v * v; }
                    *(u32x4*)(rowp + bj * 128) = pack8(hv); } }
    }
};
struct EpiDown2 {
    static constexpr bool PERM = true, AFTER_DRAIN = false;
    const bf16* X1B; bf16* X2B; const float* MODp; float* RS;
    __device__ __forceinline__ void operator()(const pg8::f32x4 (&acc)[2][2][4][2], const pg8::Unit& u, int wr, int wc, int fr, int fq) const {
        const int row0 = u.pm * 256 + wr * 64 + fr, col0 = u.pn * 256 + wc * 32 + 8 * fq, b = u.pm >> 5;
        float gv[2][8];
#pragma unroll
        for (int bj = 0; bj < 2; ++bj) ld8f(MODp + (size_t)b * NMOD + 5 * D + col0 + bj * 128, gv[bj]);
#pragma unroll
        for (int ai = 0; ai < 2; ++ai)
#pragma unroll
            for (int m = 0; m < 4; ++m) { const int row = row0 + ai * 128 + m * 16; const size_t off = (size_t)row * D + col0; float ss = 0.f;
#pragma unroll
                for (int bj = 0; bj < 2; ++bj) { float xv[8], x2[8]; unpack8(*(const u32x4*)(X1B + off + bj * 128), xv);
#pragma unroll
                    for (int i = 0; i < 8; ++i) { x2[i] = xv[i] + gv[bj][i] * acc[ai][bj][m][i >> 2][i & 3]; ss += x2[i] * x2[i]; }
                    *(u32x4*)(X2B + off + bj * 128) = pack8(x2); }
                ss += __shfl_xor(ss, 16); ss += __shfl_xor(ss, 32);
                if (fq == 0) unsafeAtomicAdd(RS + row, ss);
                asm volatile("" ::: "memory"); }
    }
};

#ifndef FUSED_FINAL
#define FUSED_FINAL 1
#endif
constexpr size_t WS_CNT = 928 * 1024;
struct EpiDownF {
    static constexpr bool PERM = true, AFTER_DRAIN = false;
    const bf16* X1B; float* OUT; const float* MODp; const float* G; float* RS; unsigned* CNT;
    __device__ __forceinline__ void operator()(const pg8::f32x4 (&acc_)[2][2][4][2], const pg8::Unit& u, int wr, int wc, int fr, int fq) const {
        pg8::f32x4 (&acc)[2][2][4][2] = const_cast<pg8::f32x4 (&)[2][2][4][2]>(acc_);
        const int row0 = u.pm * 256 + wr * 64 + fr, col0 = u.pn * 256 + wc * 32 + 8 * fq, b = u.pm >> 5;
        {
            float gv[2][8];
#pragma unroll
            for (int bj = 0; bj < 2; ++bj) ld8f(MODp + (size_t)b * NMOD + 5 * D + col0 + bj * 128, gv[bj]);
#pragma unroll
            for (int ai = 0; ai < 2; ++ai)
#pragma unroll
                for (int m = 0; m < 4; ++m) { const int row = row0 + ai * 128 + m * 16; const size_t off = (size_t)row * D + col0; float ss = 0.f;
#pragma unroll
                    for (int bj = 0; bj < 2; ++bj) { float xv[8]; unpack8(*(const u32x4*)(X1B + off + bj * 128), xv);
#pragma unroll
                        for (int i = 0; i < 8; ++i) { const float x2 = xv[i] + gv[bj][i] * acc[ai][bj][m][i >> 2][i & 3]; acc[ai][bj][m][i >> 2][i & 3] = x2; ss += x2 * x2; } }
                    ss += __shfl_xor(ss, 16); ss += __shfl_xor(ss, 32);
                    if (fq == 0) unsafeAtomicAdd(RS + row, ss);
                    asm volatile("" ::: "memory"); }
        }
        asm volatile("s_waitcnt vmcnt(0)" ::: "memory");
        unsigned* cnt = CNT + 64 * u.pm;
        if ((threadIdx.x & 63) == 0) __hip_atomic_fetch_add(cnt, 1u, __ATOMIC_RELAXED, __HIP_MEMORY_SCOPE_AGENT);
        { unsigned sp = 0;
          while ((unsigned)__builtin_amdgcn_readfirstlane(__hip_atomic_load(cnt, __ATOMIC_RELAXED, __HIP_MEMORY_SCOPE_AGENT)) < 32u) { __builtin_amdgcn_s_sleep(2); if (++sp > (1u << 20)) break; } }
        float rstd[2][4];
#pragma unroll
        for (int ai = 0; ai < 2; ++ai)
#pragma unroll
            for (int m = 0; m < 4; ++m) rstd[ai][m] = rsqrtf(__hip_atomic_load(RS + row0 + ai * 128 + m * 16, __ATOMIC_RELAXED, __HIP_MEMORY_SCOPE_AGENT) * (1.f / D) + 1e-6f);
#pragma unroll
        for (int bj = 0; bj < 2; ++bj) {
            float g8[8]; ld8f(G + col0 + bj * 128, g8);
#pragma unroll
            for (int ai = 0; ai < 2; ++ai)
#pragma unroll
                for (int m = 0; m < 4; ++m) { float* op = OUT + (size_t)(row0 + ai * 128 + m * 16) * D + col0 + bj * 128; const float r_ = rstd[ai][m];
                    const pg8::f32x4 a0 = acc[ai][bj][m][0], a1 = acc[ai][bj][m][1];
                    *(f32x4*)(op) = (f32x4){a0[0] * r_ * g8[0], a0[1] * r_ * g8[1], a0[2] * r_ * g8[2], a0[3] * r_ * g8[3]};
                    *(f32x4*)(op + 4) = (f32x4){a1[0] * r_ * g8[4], a1[1] * r_ * g8[5], a1[2] * r_ * g8[6], a1[3] * r_ * g8[7]}; }
        }
    }
};
template <int R> __device__ __forceinline__ void final_rows2(const bf16* X2B, const float* RS, float* OUT, const float* g, int m0, int stride, int lane) {
    u32x4 w0[R], w1[R]; float rs[R];
#pragma unroll
    for (int r = 0; r < R; ++r) { const size_t off = (size_t)(m0 + r * stride) * D + lane * 8; w0[r] = *(const u32x4*)(X2B + off); w1[r] = *(const u32x4*)(X2B + off + 512); rs[r] = RS[m0 + r * stride]; }
    float g0[8], g1[8]; ld8f(g + lane * 8, g0); ld8f(g + 512 + lane * 8, g1);
#pragma unroll
    for (int r = 0; r < R; ++r) { const float rstd = rsqrtf(rs[r] * (1.f / D) + 1e-6f); float a[8], c[8]; unpack8(w0[r], a); unpack8(w1[r], c);
        float* op = OUT + (size_t)(m0 + r * stride) * D + lane * 8;
        *(f32x4*)(op) = (f32x4){a[0] * rstd * g0[0], a[1] * rstd * g0[1], a[2] * rstd * g0[2], a[3] * rstd * g0[3]};
        *(f32x4*)(op + 4) = (f32x4){a[4] * rstd * g0[4], a[5] * rstd * g0[5], a[6] * rstd * g0[6], a[7] * rstd * g0[7]};
        *(f32x4*)(op + 512) = (f32x4){c[0] * rstd * g1[0], c[1] * rstd * g1[1], c[2] * rstd * g1[2], c[3] * rstd * g1[3]};
        *(f32x4*)(op + 516) = (f32x4){c[4] * rstd * g1[4], c[5] * rstd * g1[5], c[6] * rstd * g1[6], c[7] * rstd * g1[7]}; }
}
__device__ __forceinline__ void transpose_item(const float* W, int K, int N, bf16* WT, LAS float* scr, int item, int lane) {
    const int nblk = N / 32, kb = item / nblk, nb = item % nblk, k0 = 64 * kb, n0 = 32 * nb;
#pragma unroll 8
    for (int i = 0; i < 32; ++i) { const int kk = 2 * i + (lane >> 5); scr[kk * 33 + (lane & 31)] = W[(size_t)(k0 + kk) * N + n0 + (lane & 31)]; }
    asm volatile("s_waitcnt lgkmcnt(0)" ::: "memory");
    const int c = lane & 7;
#pragma unroll
    for (int j = 0; j < 4; ++j) { const int n = (lane >> 3) + 8 * j; const LAS float* s = scr + (8 * c) * 33 + n;
        u32x4 o; o.x = pk2(s[0 * 33], s[1 * 33]); o.y = pk2(s[2 * 33], s[3 * 33]); o.z = pk2(s[4 * 33], s[5 * 33]); o.w = pk2(s[6 * 33], s[7 * 33]);
        *(u32x4*)(WT + (size_t)(n0 + n) * K + k0 + 8 * c) = o; }
    asm volatile("s_waitcnt lgkmcnt(0)" ::: "memory");
}
__device__ __forceinline__ void p0_prologue(const Args& A, LAS unsigned char* lds, int tid, int lane, int wave) {
    unsigned char* ws = A.ws;
    {
        const float* c = A.in[1]; const float* w_ada = A.in[2]; const float* b_ada = A.in[3]; float* MOD = (float*)(ws + WS_MOD);
        LAS float* cs = (LAS float*)(lds + LDS_MISC);
        for (int item = blockIdx.x; item < 384; item += gridDim.x) {
            const int kc = item / 12, cb = item % 12;
            __syncthreads();
            if (tid < 256) { const float cv = c[(tid >> 5) * D + kc * 32 + (tid & 31)]; cs[tid] = cv * sigmoidf_(cv); }
            __syncthreads();
            const int col = cb * 512 + tid;
            float acc[8];
#pragma unroll
            for (int b = 0; b < 8; ++b) acc[b] = 0.f;
#pragma unroll 4
            for (int kk = 0; kk < 32; ++kk) { const float w = w_ada[(size_t)(kc * 32 + kk) * NMOD + col];
#pragma unroll
                for (int b = 0; b < 8; ++b) acc[b] += cs[b * 32 + kk] * w; }
            const float bias = (kc == 0) ? b_ada[col] : 0.f;
#pragma unroll
            for (int b = 0; b < 8; ++b) unsafeAtomicAdd(MOD + b * NMOD + col, acc[b] + bias);
        }
        __syncthreads();
    }
    {
        LAS float* scr = (LAS float*)(lds + wave * 16384);
        const int gw = blockIdx.x * NWAVES + wave, NGW = gridDim.x * NWAVES;
        constexpr int I_IN = (D / 64) * (PT / 32), I_OUT = (D / 64) * (D / 32), I_UP = (D / 64) * (FF / 32), I_DN = (FF / 64) * (D / 32);
        for (int it = gw; it < ((CONV_UNDER_S2 && SHADOW_EXTRA) ? I_IN : I_IN + I_OUT + I_UP + I_DN); it += NGW) {
            int r = it;
            if (r < I_IN) { transpose_item(A.in[4], D, PT, (bf16*)(ws + WS_WIN), scr, r, lane); continue; } r -= I_IN;
            if (r < I_OUT) { transpose_item(A.in[17], D, D, (bf16*)(ws + WS_WOUT), scr, r, lane); continue; } r -= I_OUT;
            if (r < I_UP) { transpose_item(A.in[18], D, FF, (bf16*)(ws + WS_WUP), scr, r, lane); continue; } r -= I_UP;
            transpose_item(A.in[19], FF, D, (bf16*)(ws + WS_WDN), scr, r, lane);
        }
    }
    {
        const float* w2 = A.in[8]; const float* a2 = A.in[10]; const float* g2 = A.in[11]; bf16* LT = (bf16*)(ws + WS_LT);
        for (int idx = blockIdx.x * NTHR + tid; idx < LN * LK; idx += gridDim.x * NTHR) {
            const int n = idx >> 8, k = idx & 255; float v = 0.f;
            if (n < 512) { if (k < 64) v = w2[k * 512 + n]; }
            else if (n < 1024) { if (k >= 64 && k < 128) v = a2[(k - 64) * 512 + (n - 512)]; }
            else { if (k >= 128) v = g2[(k - 128) * 512 + (n - 1024)]; }
            LT[idx] = (bf16)(pk2(v, 0.f) & 0xffffu);
        }
    }
}

template <int R> __device__ __forceinline__ void norm_mod_rows(const float* X, bf16* O, const float* MOD, int sh_chunk, int m0, int stride, int lane) {
    f32x4 v[R][4];
#pragma unroll
    for (int r = 0; r < R; ++r) { const f32x4* xr = (const f32x4*)(X + (size_t)(m0 + r * stride) * D) + lane;
#pragma unroll
        for (int j = 0; j < 4; ++j) v[r][j] = __builtin_nontemporal_load(&xr[64 * j]); }
#pragma unroll
    for (int r = 0; r < R; ++r) { const int m = m0 + r * stride; const float* sh = MOD + (m >> 13) * NMOD + sh_chunk * D; const float* sc = sh + D;
        float s = 0.f;
#pragma unroll
        for (int j = 0; j < 4; ++j) s += (v[r][j].x * v[r][j].x + v[r][j].y * v[r][j].y) + (v[r][j].z * v[r][j].z + v[r][j].w * v[r][j].w);
        const float rstd = rsqrtf(wave_sum(s) * (1.f / D) + 1e-6f);
        bf16* orow = O + (size_t)m * D;
#pragma unroll
        for (int j = 0; j < 4; ++j) { const f32x4 a = ((const f32x4*)sc)[lane + 64 * j], b = ((const f32x4*)sh)[lane + 64 * j];
            const f32x4 h = v[r][j] * rstd * (1.f + a) + b;
            ((u32x2*)orow)[lane + 64 * j] = (u32x2){pk2(h.x, h.y), pk2(h.z, h.w)}; } }
}
template <int R> __device__ __forceinline__ void final_rows(float* X, const float* g, int m0, int stride, int lane) {
    f32x4 v[R][4];
#pragma unroll
    for (int r = 0; r < R; ++r) { const f32x4* xr = (const f32x4*)(X + (size_t)(m0 + r * stride) * D) + lane;
#pragma unroll
        for (int j = 0; j < 4; ++j) v[r][j] = xr[64 * j]; }
    f32x4 gv[4];
#pragma unroll
    for (int j = 0; j < 4; ++j) gv[j] = ((const f32x4*)g)[lane + 64 * j];
#pragma unroll
    for (int r = 0; r < R; ++r) { f32x4* xr = (f32x4*)(X + (size_t)(m0 + r * stride) * D) + lane; float s = 0.f;
#pragma unroll
        for (int j = 0; j < 4; ++j) s += (v[r][j].x * v[r][j].x + v[r][j].y * v[r][j].y) + (v[r][j].z * v[r][j].z + v[r][j].w * v[r][j].w);
        const float rstd = rsqrtf(wave_sum(s) * (1.f / D) + 1e-6f);
#pragma unroll
        for (int j = 0; j < 4; ++j) xr[64 * j] = v[r][j] * rstd * gv[j]; }
}
__device__ __forceinline__ size_t pidx(int m, int col) { return ((size_t)((m >> 8) * 13 + (col >> 8)) << 16) + (size_t)(((m & 255) << 8) + (col & 255)); }
#define PAT(mm, cc) (P + pidx((mm), (cc)))
struct ConvRegs { u32x4 bg, c0, u0, c1, u1, c2, u2; };
struct VlRegs { u32x4 vc, vp; u32x2 lc, lp; };
__device__ __forceinline__ void conv_load(ConvRegs& R, const bf16* P, int m, int lane) {
    const int tt = m & (SEQ - 1); const bool has1 = tt >= 1, has2 = tt >= 2;
    const u32x4 zero4 = (u32x4){0u, 0u, 0u, 0u}; const int ch = 8 * lane;
    R.bg = *(const u32x4*)PAT(m, ch); R.c0 = *(const u32x4*)PAT(m, 512 + ch); R.u0 = *(const u32x4*)PAT(m, 1024 + ch);
    R.c1 = has1 ? *(const u32x4*)PAT(m - 1, 512 + ch) : zero4; R.u1 = has1 ? *(const u32x4*)PAT(m - 1, 1024 + ch) : zero4;
    R.c2 = has2 ? *(const u32x4*)PAT(m - 2, 512 + ch) : zero4; R.u2 = has2 ? *(const u32x4*)PAT(m - 2, 1024 + ch) : zero4;
}
__device__ __forceinline__ void conv_compute(const Args& A, const ConvRegs& R, int m, int lane) {
    const int ch = 8 * lane; const float* cw = A.in[5];
    float bg[8], c0[8], u0[8], c1[8], u1[8], c2[8], u2[8], w0[8], w1[8], w2[8], y[8];
    unpack8(R.bg, bg); unpack8(R.c0, c0); unpack8(R.u0, u0); unpack8(R.c1, c1); unpack8(R.u1, u1); unpack8(R.c2, c2); unpack8(R.u2, u2);
    ld8f(cw + ch, w0); ld8f(cw + 512 + ch, w1); ld8f(cw + 1024 + ch, w2);
#pragma unroll
    for (int i = 0; i < 8; ++i) y[i] = bg[i] * (w0[i] * (c2[i] * u2[i]) + w1[i] * (c1[i] * u1[i]) + w2[i] * (c0[i] * u0[i]));
    *(u32x4*)((bf16*)(A.ws + WS_MIX) + (size_t)m * D + ch) = pack8(y);
}
__device__ __forceinline__ void vl_load(VlRegs& R, const bf16* P, int m, int lane) {
    const int tt = m & (SEQ - 1); const bool has1 = tt >= 1;
    const u32x4 zero4 = (u32x4){0u, 0u, 0u, 0u}; const int ch = 8 * lane, c4 = 4 * lane;
    R.vc = *(const u32x4*)PAT(m, PCONV + 1024 + ch); R.lc = *(const u32x2*)PAT(m, PCONV + 1536 + c4);
    R.vp = has1 ? *(const u32x4*)PAT(m - 1, PCONV + 1024 + ch) : zero4; R.lp = has1 ? *(const u32x2*)PAT(m - 1, PCONV + 1536 + c4) : (u32x2){0u, 0u};
}
__device__ __forceinline__ void vl_compute(const Args& A, const VlRegs& R, int m, int lane) {
    unsigned char* ws = A.ws; const int ch = 8 * lane; const float* mu = A.in[6];
    {
        float cur[8], prv[8], mv[8], o[8];
        unpack8(R.vc, cur); unpack8(R.vp, prv); ld8f(mu + 1024 + ch, mv);
#pragma unroll
        for (int i = 0; i < 8; ++i) o[i] = cur[i] + (prv[i] - cur[i]) * mv[i];
        *(u32x4*)((bf16*)(ws + WS_VL) + (size_t)m * RW + ch) = pack8(o);
    }
    {
        const int c4 = 4 * lane;
        const u32x2 cw = R.lc, pw = R.lp;
        const f32x4 mv = *(const f32x4*)(mu + 1536 + c4);
        float cur[4] = {bflo(cw.x), bfhi(cw.x), bflo(cw.y), bfhi(cw.y)}, prv[4] = {bflo(pw.x), bfhi(pw.x), bflo(pw.y), bfhi(pw.y)}, o[4];
#pragma unroll
        for (int i = 0; i < 4; ++i) { const float xl = cur[i] + (prv[i] - cur[i]) * mv[i];
            const float sg = sigmoidf_(lane < 16 ? 2.0f * xl : xl);
            o[i] = lane < 16 ? (2.0f * sg - 1.0f) : (lane < 32 ? xl : sg); }
        *(u32x2*)((bf16*)(ws + WS_LA) + (size_t)m * LK + c4) = (u32x2){pk2(o[0], o[1]), pk2(o[2], o[3])};
    }
}
__device__ __forceinline__ void conv_pass(const Args& A, int w0, int nw, int lane) {
    const bf16* Pp = (const bf16*)(A.ws + WS_P); ConvRegs Ra, Rb; int m = w0;
    if (m < M) conv_load(Ra, Pp, m, lane);
    for (; m < M; m += 2 * nw) { const bool hb = m + nw < M;
        if (hb) conv_load(Rb, Pp, m + nw, lane);
        conv_compute(A, Ra, m, lane);
        if (m + 2 * nw < M) conv_load(Ra, Pp, m + 2 * nw, lane);
        if (hb) conv_compute(A, Rb, m + nw, lane); }
}
__device__ __forceinline__ void vl_pass(const Args& A, int w0, int nw, int lane) {
    const bf16* Pp = (const bf16*)(A.ws + WS_P); VlRegs Ra, Rb; int m = w0;
    if (m < M) vl_load(Ra, Pp, m, lane);
    for (; m < M; m += 2 * nw) { const bool hb = m + nw < M;
        if (hb) vl_load(Rb, Pp, m + nw, lane);
        vl_compute(A, Ra, m, lane);
        if (m + 2 * nw < M) vl_load(Ra, Pp, m + 2 * nw, lane);
        if (hb) vl_compute(A, Rb, m + nw, lane); }
}
template <int R> __device__ __forceinline__ void post_rows(const Args& A, int m0, int stride, int lane) {
    unsigned char* ws = A.ws;
    const int ch = 8 * lane;
    f32x4 y0[R], y1[R]; u32x4 rw[R], kw[R], vw[R], gw_[R];
#pragma unroll
    for (int r = 0; r < R; ++r) { const size_t off = (size_t)(m0 + r * stride) * RW + ch;
        y0[r] = *(const f32x4*)((const float*)(ws + WS_Y) + off); y1[r] = *(const f32x4*)((const float*)(ws + WS_Y) + off + 4);
        rw[r] = *(const u32x4*)((const bf16*)(ws + WS_RL) + off); kw[r] = *(const u32x4*)((const bf16*)(ws + WS_KP) + off);
        vw[r] = *(const u32x4*)((const bf16*)(ws + WS_VL) + off); gw_[r] = *(const u32x4*)((const bf16*)(ws + WS_G) + off); }
    float rk[8], lg[8], lb[8];
    ld8f(A.in[14] + ch, rk); ld8f(A.in[15] + ch, lg); ld8f(A.in[16] + ch, lb);
#pragma unroll
    for (int r = 0; r < R; ++r) {
        float y[8] = {y0[r].x, y0[r].y, y0[r].z, y0[r].w, y1[r].x, y1[r].y, y1[r].z, y1[r].w}, rr[8], kp[8], v[8], g[8], o[8];
        unpack8(rw[r], rr); unpack8(kw[r], kp); unpack8(vw[r], v); unpack8(gw_[r], g);
        float s = 0.f, bs = 0.f;
#pragma unroll
        for (int i = 0; i < 8; ++i) { s += y[i]; bs += rr[i] * kp[i] * rk[i]; }
        s = sum8(s); bs = sum8(bs);
        const float mean = s * (1.f / 64.f); float q = 0.f;
#pragma unroll
        for (int i = 0; i < 8; ++i) { y[i] -= mean; q += y[i] * y[i]; }
        q = sum8(q);
        const float rstd = rsqrtf(q * (1.f / 64.f) + 64e-5f);
#pragma unroll
        for (int i = 0; i < 8; ++i) o[i] = (y[i] * rstd * lg[i] + lb[i] + bs * v[i]) * g[i];
        *(u32x4*)((bf16*)(ws + WS_MIX) + (size_t)(m0 + r * stride) * D + 512 + ch) = pack8(o); }
}

constexpr int TC = 32, NCH = SEQ / TC;
constexpr int OPB = 5 * TC * 256 + TC * 64;
constexpr int YB_OFF = 2 * OPB, DUMP_OFF = YB_OFF + 4096;
static_assert(DUMP_OFF + 4608 <= 131072, "scan LDS");
#define SCAN_BAR() do { asm volatile("s_waitcnt lgkmcnt(0)" ::: "memory"); __builtin_amdgcn_s_barrier(); asm volatile("" ::: "memory"); } while (0)
template <int CTRL> __device__ __forceinline__ float dpp_add(float x) {
    return x + __builtin_bit_cast(float, __builtin_amdgcn_update_dpp(0, __builtin_bit_cast(int, x), CTRL, 0xf, 0xf, false));
}
__device__ __forceinline__ float rsum16(float x) { x = dpp_add<0x128>(x); x = dpp_add<0x124>(x); x = dpp_add<0x122>(x); x = dpp_add<0x121>(x); return x; }
struct ScanRegs { u32x4 rl, kp, kk, bv, vv; f32x4 d0, d1; };
__device__ __forceinline__ void st8(LAS unsigned char* p, const u32x4 w) {
    *(LAS f32x4*)p = (f32x4){bflo(w.x), bfhi(w.x), bflo(w.y), bfhi(w.y)}; *(LAS f32x4*)(p + 16) = (f32x4){bflo(w.z), bfhi(w.z), bflo(w.w), bfhi(w.w)};
}
__device__ __forceinline__ void scan_phase(unsigned char* ws, LAS unsigned char* lds, int tid, int lane, int wid) {
    const bf16* RL = (const bf16*)(ws + WS_RL); const bf16* KP = (const bf16*)(ws + WS_KP); const bf16* KK = (const bf16*)(ws + WS_KK);
    const bf16* BV = (const bf16*)(ws + WS_BV); const bf16* VL = (const bf16*)(ws + WS_VL); const float* DEC = (const float*)(ws + WS_DEC);
    float* Y = (float*)(ws + WS_Y);
    for (int item = blockIdx.x; item < 256; item += gridDim.x) {
        const int xcd = item & 7, slot = item >> 3, bh = xcd * 8 + (slot >> 2), q = slot & 3, b = bh >> 3, h = bh & 7;
        const size_t rowbase = (size_t)b * SEQ;
        const bool loader = wid >= 4;
        const int L = tid - 256;
        const int lt = L >> 3, lc = (L & 7) * 8;
        ScanRegs R;
#define SCAN_ISSUE(cc) do { const size_t o_ = (rowbase + (size_t)(cc) * TC + lt) * RW + h * 64 + lc; \
            R.rl = *(const u32x4*)(RL + o_); R.kp = *(const u32x4*)(KP + o_); R.kk = *(const u32x4*)(KK + o_); R.bv = *(const u32x4*)(BV + o_); \
            R.d0 = *(const f32x4*)(DEC + o_); R.d1 = *(const f32x4*)(DEC + o_ + 4); \
            if (wid == 4) R.vv = *(const u32x4*)(VL + (rowbase + (size_t)(cc) * TC + (lane >> 1)) * RW + h * 64 + q * 16 + (lane & 1) * 8); } while (0)
#define SCAN_WRITE(buf) do { LAS unsigned char* ob_ = lds + (buf) * OPB + lt * 256 + lc * 4; \
            st8(ob_ + 0 * TC * 256, R.rl); *(LAS f32x4*)(ob_ + 1 * TC * 256) = R.d0; *(LAS f32x4*)(ob_ + 1 * TC * 256 + 16) = R.d1; \
            st8(ob_ + 2 * TC * 256, R.kp); st8(ob_ + 3 * TC * 256, R.kk); st8(ob_ + 4 * TC * 256, R.bv); \
            if (wid == 4) st8(lds + (buf) * OPB + 5 * TC * 256 + (lane >> 1) * 64 + (lane & 1) * 32, R.vv); } while (0)
#define SCAN_FLUSH(cc) do { if (L < 128) { const f32x4 yv_ = *(LAS const f32x4*)(lds + YB_OFF + ((cc) & 1) * 2048 + (L >> 2) * 64 + (L & 3) * 16); \
            *(f32x4*)(Y + (rowbase + (size_t)(cc) * TC + (L >> 2)) * RW + h * 64 + q * 16 + (L & 3) * 4) = yv_; } } while (0)
        const int rg = lane >> 4, cl = lane & 15, rb = (wid & 3) * 4 + rg;
        f32x2 S01 = (f32x2){0.f, 0.f}, S23 = (f32x2){0.f, 0.f};
        const unsigned opoff = cl * 16, voff = 5 * TC * 256 + rb * 4;
        const unsigned ybase = (cl == 0) ? (unsigned)(YB_OFF + rb * 4) : (unsigned)(DUMP_OFF + lane * 4);
        if (loader) { SCAN_ISSUE(0); SCAN_WRITE(0); SCAN_ISSUE(1); }
        SCAN_BAR();
        for (int c = 0; c < NCH; ++c) {
            if (!loader) {
                LAS const unsigned char* ob = lds + (c & 1) * OPB;
                LAS unsigned char* yb = lds + ybase + (c & 1) * 2048;
                f32x4 r_[3], w_[3], k_[3], a_[3], b_[3]; float v_[3];
#define SCAN_LD(st, tt) do { r_[st] = *(LAS const f32x4*)(ob + opoff + (0 * TC + (tt)) * 256); w_[st] = *(LAS const f32x4*)(ob + opoff + (1 * TC + (tt)) * 256); \
                    k_[st] = *(LAS const f32x4*)(ob + opoff + (2 * TC + (tt)) * 256); a_[st] = *(LAS const f32x4*)(ob + opoff + (3 * TC + (tt)) * 256); \
                    b_[st] = *(LAS const f32x4*)(ob + opoff + (4 * TC + (tt)) * 256); v_[st] = *(LAS const float*)(ob + voff + (tt) * 64); } while (0)
                SCAN_LD(0, 0); SCAN_LD(1, 1);
#pragma unroll
                for (int t = 0; t < TC; ++t) {
                    const int st = t % 3;
                    if (t + 2 < TC) SCAN_LD((t + 2) % 3, t + 2);
                    const f32x4 r = r_[st], w = w_[st], k = k_[st], a = a_[st], bb = b_[st]; const float v = v_[st];
                    const f32x2 sp2 = S01 * (f32x2){a.x, a.y} + S23 * (f32x2){a.z, a.w};
                    const float sa = rsum16(sp2.x + sp2.y);
                    const f32x2 vv = (f32x2){v, v}, nsa = (f32x2){-sa, -sa};
                    const f32x2 t01 = vv * (f32x2){k.x, k.y} + nsa * (f32x2){bb.x, bb.y};
                    const f32x2 t23 = vv * (f32x2){k.z, k.w} + nsa * (f32x2){bb.z, bb.w};
                    S01 = S01 * (f32x2){w.x, w.y} + t01;
                    S23 = S23 * (f32x2){w.z, w.w} + t23;
                    const f32x2 yp2 = S01 * (f32x2){r.x, r.y} + S23 * (f32x2){r.z, r.w};
                    const float yv = rsum16(yp2.x + yp2.y);
                    *(LAS float*)(yb + t * 64) = yv;
                }
#undef SCAN_LD
            } else {
                if (c + 1 < NCH) SCAN_WRITE((c + 1) & 1);
                if (c + 2 < NCH) SCAN_ISSUE(c + 2);
                if (c >= 1) SCAN_FLUSH(c - 1);
            }
            SCAN_BAR();
        }
        if (loader) SCAN_FLUSH(NCH - 1);
        SCAN_BAR();
#undef SCAN_ISSUE
#undef SCAN_WRITE
#undef SCAN_FLUSH
    }
}

#ifndef SCAN_CHUNKED
#define SCAN_CHUNKED 1
#endif
constexpr size_t WS_AH = 768 * MiB  , WS_NN = 992 * MiB, WS_MA = 832 * MiB;
constexpr size_t OUT_BK = 0, OUT_PC = 128 * MiB, OUT_RT = 160 * MiB;
constexpr int S1_XA = 0, S1_XB = 2304, S1_XK = 4608, S1_XR = 6912, S1_AHL = 9216, S1_NABT = 11520, S1_TT = 12544, S1_NAK = 13824, S1_WAVE = 15360;
typedef short bf16x8 __attribute__((ext_vector_type(8)));
__device__ __forceinline__ float bf2f(unsigned short v) { return __uint_as_float(((unsigned)v) << 16); }
__device__ __forceinline__ unsigned short f2bf1(float f) { return (unsigned short)(pk2(f, 0.f) & 0xffffu); }
__device__ __forceinline__ bf16x8 mk8(unsigned a, unsigned b, unsigned c, unsigned d) { return __builtin_bit_cast(bf16x8, (u32x4){a, b, c, d}); }
#define MFMA16(a, b, c) __builtin_amdgcn_mfma_f32_16x16x32_bf16((a), (b), (c), 0, 0, 0)

__device__ __forceinline__ void s1_item(unsigned char* ws, unsigned char* outb, const float* rkp, const float* kap, const float* mup, const float* kkp, LAS unsigned char* wl, int ci, int lane) {
    const int bh = ci >> 9, c = ci & 511, b = bh >> 3, h = bh & 7;
    const size_t goff = ((size_t)b * SEQ + (size_t)c * 16) * RW + h * 64 + lane;
    const bf16* LW = (const bf16*)(ws + WS_DEC); const bf16* AVg = (const bf16*)(ws + WS_KP); const bf16* Pg = (const bf16*)(ws + WS_P);
    const int m0 = b * SEQ + c * 16, colr = PCONV + h * 64 + lane, colk = colr + 512;
    float lw[16]; unsigned short a_[16], pr_[17], pk_[17];
#pragma unroll
    for (int t = 0; t < 16; ++t) { const size_t o = goff + (size_t)t * RW; lw[t] = bf2f(LW[o]); a_[t] = AVg[o]; pr_[t + 1] = Pg[pidx(m0 + t, colr)]; pk_[t + 1] = Pg[pidx(m0 + t, colk)]; }
    if (c > 0) { pr_[0] = Pg[pidx(m0 - 1, colr)]; pk_[0] = Pg[pidx(m0 - 1, colk)]; } else { pr_[0] = 0; pk_[0] = 0; }
    const float mur = mup[h * 64 + lane], muk = mup[512 + h * 64 + lane], kkc = kkp[h * 64 + lane];
    float rv[16], kv[16], kkn[16];
#pragma unroll
    for (int t = 0; t < 16; ++t) { const float rc = bf2f(pr_[t + 1]), rp = bf2f(pr_[t]), kc = bf2f(pk_[t + 1]), kp0 = bf2f(pk_[t]);
        rv[t] = rc + (rp - rc) * mur; kv[t] = kc + (kp0 - kc) * muk; const float kx = kv[t] * kkc; kkn[t] = kx; }
#pragma unroll
    for (int t = 0; t < 16; ++t) { float ss = rsum16(kkn[t] * kkn[t]);
        { const int si_ = __builtin_bit_cast(int, ss);
          ss = __builtin_bit_cast(float, __builtin_amdgcn_readlane(si_, 0)) + __builtin_bit_cast(float, __builtin_amdgcn_readlane(si_, 16)) + __builtin_bit_cast(float, __builtin_amdgcn_readlane(si_, 32)) + __builtin_bit_cast(float, __builtin_amdgcn_readlane(si_, 48)); }
        kkn[t] *= 1.0f / fmaxf(sqrtf(ss), 1e-12f); }
    float lp[16]; { float acc = 0.f;
#pragma unroll
        for (int t = 0; t < 16; ++t) { acc += lw[t]; lp[t] = acc; } }
    const float lpc = lp[15];
    float At[16], Bh[16], Kh[16];
    const float rkh = rkp[h * 64 + lane], kah = kap[h * 64 + lane];
#pragma unroll
    for (int t = 0; t < 16; ++t) {
        const float P = __expf(lp[t]), Pm1 = __expf(lp[t] - lw[t]), iP = __expf(-lp[t]), PcP = __expf(lpc - lp[t]);
        const float kkf = kkn[t], af_ = bf2f(a_[t]), bvf = kkf * af_, kpf = kv[t] * (1.0f + (af_ - 1.0f) * kah), rf = rv[t];
        At[t] = -kkf * Pm1; Bh[t] = bvf * PcP; Kh[t] = kpf * PcP;
        *(LAS unsigned short*)(wl + S1_XA + t * 144 + lane * 2) = f2bf1(At[t]);
        *(LAS unsigned short*)(wl + S1_XB + t * 144 + lane * 2) = f2bf1(bvf * iP);
        *(LAS unsigned short*)(wl + S1_XK + t * 144 + lane * 2) = f2bf1(kpf * iP);
        *(LAS unsigned short*)(wl + S1_XR + t * 144 + lane * 2) = f2bf1(rf * P);
        *(LAS unsigned short*)(wl + S1_AHL + t * 144 + lane * 2) = f2bf1(rf * P * rkh);
    }
    const int m = lane & 15, q = lane >> 4;
    bf16x8 fa[2], fb[2], fk[2], fr[2];
#pragma unroll
    for (int ks = 0; ks < 2; ++ks) { const int o = m * 144 + (8 * q + 32 * ks) * 2;
        fa[ks] = *(LAS const bf16x8*)(wl + S1_XA + o); fb[ks] = *(LAS const bf16x8*)(wl + S1_XB + o);
        fk[ks] = *(LAS const bf16x8*)(wl + S1_XK + o); fr[ks] = *(LAS const bf16x8*)(wl + S1_XR + o); }
    const f32x4 z4 = (f32x4){0.f, 0.f, 0.f, 0.f};
    f32x4 nab = MFMA16(fb[0], fa[0], z4); nab = MFMA16(fb[1], fa[1], nab);
    f32x4 nak = MFMA16(fk[0], fa[0], z4); nak = MFMA16(fk[1], fa[1], nak);
    f32x4 nbr = MFMA16(fb[0], fr[0], z4); nbr = MFMA16(fb[1], fr[1], nbr);
    f32x4 nkr = MFMA16(fk[0], fr[0], z4); nkr = MFMA16(fk[1], fr[1], nkr);
    {
        bf16x8 frk0 = *(LAS const bf16x8*)(wl + S1_AHL + m * 144 + (8 * q) * 2), frk1 = *(LAS const bf16x8*)(wl + S1_AHL + m * 144 + (8 * q + 32) * 2);
        f32x4 cb = MFMA16(fk[0], frk0, z4); cb = MFMA16(fk[1], frk1, cb);
        const float cd = (m & 3) == 0 ? cb[0] : ((m & 3) == 1 ? cb[1] : ((m & 3) == 2 ? cb[2] : cb[3]));
        if (q == (m >> 2)) ((float*)(outb + OUT_PC))[(size_t)ci * 256 + 64 + m] = cd;
        asm volatile("s_waitcnt lgkmcnt(0)" ::: "memory");
    }
#pragma unroll
    for (int i = 0; i < 4; ++i) { const int s = 4 * q + i;
        nab[i] = (s < m) ? nab[i] : 0.f; nak[i] = (s < m) ? nak[i] : 0.f; nbr[i] = (s <= m) ? nbr[i] : 0.f; nkr[i] = (s <= m) ? nkr[i] : 0.f; }
    *(u32x4*)((bf16*)(ws + WS_NN) + (size_t)ci * 512 + lane * 8) = (u32x4){pk2(nbr[0], nbr[1]), pk2(nbr[2], nbr[3]), pk2(nkr[0], nkr[1]), pk2(nkr[2], nkr[3])};
    *(LAS f32x4*)(wl + S1_NABT + m * 64 + q * 16) = nab;
#pragma unroll
    for (int i = 0; i < 4; ++i) *(LAS float*)(wl + S1_NAK + (4 * q + i) * 64 + m * 4) = nak[i];
    float Tr[16];
#pragma unroll
    for (int t = 0; t < 16; ++t) {
        float acc = (m == t) ? 1.f : 0.f;
#pragma unroll
        for (int j4 = 0; j4 < (t + 3) / 4; ++j4) { const f32x4 nv = *(LAS const f32x4*)(wl + S1_NABT + t * 64 + j4 * 16);
#pragma unroll
            for (int jj = 0; jj < 4; ++jj) if (4 * j4 + jj < t) acc += Tr[4 * j4 + jj] * nv[jj]; }
        Tr[t] = acc;
        *(LAS float*)(wl + S1_TT + t * 80 + m * 4) = acc;
    }
#pragma unroll
    for (int t = 0; t < 16; ++t) {
        float acc = 0.f;
#pragma unroll
        for (int s4 = 0; s4 < t / 4 + 1; ++s4) { const f32x4 tv = *(LAS const f32x4*)(wl + S1_TT + t * 80 + s4 * 16);
#pragma unroll
            for (int ss = 0; ss < 4; ++ss) if (4 * s4 + ss <= t) acc += tv[ss] * At[4 * s4 + ss]; }
        *(LAS unsigned short*)(wl + S1_AHL + t * 144 + lane * 2) = f2bf1(acc);
    }
    {
        f32x4 tt[4];
#pragma unroll
        for (int s4 = 0; s4 < 4; ++s4) tt[s4] = *(LAS const f32x4*)(wl + S1_TT + m * 80 + s4 * 16);
        float mak[4];
#pragma unroll
        for (int i = 0; i < 4; ++i) { float acc = 0.f;
#pragma unroll
            for (int s4 = 0; s4 < 4; ++s4) { const f32x4 nv = *(LAS const f32x4*)(wl + S1_NAK + (4 * q + i) * 64 + s4 * 16);
                acc += tt[s4][0] * nv[0] + tt[s4][1] * nv[1] + tt[s4][2] * nv[2] + tt[s4][3] * nv[3]; }
            mak[i] = acc; }
        *(u32x4*)((bf16*)(ws + WS_MA) + (size_t)ci * 512 + lane * 8) = (u32x4){0u, 0u, pk2(mak[0], mak[1]), pk2(mak[2], mak[3])};
    }
#pragma unroll
    for (int hh = 0; hh < 2; ++hh) {
        const int o = m * 144 + (32 * hh + 4 * q) * 2;
        const u32x2 alo = *(LAS const u32x2*)(wl + S1_AHL + o), ahi = *(LAS const u32x2*)(wl + S1_AHL + o + 32);
        const u32x2 rlo = *(LAS const u32x2*)(wl + S1_XR + o), rhi = *(LAS const u32x2*)(wl + S1_XR + o + 32);
        *(u32x4*)((bf16*)(ws + WS_AH) + (size_t)ci * 1024 + (hh * 64 + lane) * 8) = (u32x4){alo.x, alo.y, ahi.x, ahi.y};
        *(u32x4*)((bf16*)(outb + OUT_RT) + (size_t)ci * 1024 + (hh * 64 + lane) * 8) = (u32x4){rlo.x, rlo.y, rhi.x, rhi.y};
    }
    {
        bf16* BKg = (bf16*)(outb + OUT_BK) + (size_t)ci * 2048; const int kt = lane >> 4, mm = lane & 15;
#pragma unroll
        for (int qq = 0; qq < 4; ++qq)
            *(u32x4*)(BKg + (kt * 64 + mm + 16 * qq) * 8) = (u32x4){pk2(Bh[4 * qq], Bh[4 * qq + 1]), pk2(Bh[4 * qq + 2], Bh[4 * qq + 3]), pk2(Kh[4 * qq], Kh[4 * qq + 1]), pk2(Kh[4 * qq + 2], Kh[4 * qq + 3])};
        ((float*)(outb + OUT_PC))[(size_t)ci * 256 + lane] = __expf(lpc);
    }
    asm volatile("s_waitcnt lgkmcnt(0)" ::: "memory");
}

constexpr int S2_SLOT = 15360, S2_D = 6, S2_NS = S2_D + 2;
constexpr int SO_AH = 0, SO_RT = 2048, SO_MA = 4096, SO_NN = 5120, SO_BK = 6144, SO_V = 10240, SO_PC = 12288, SO_G = 13312;
static_assert(S2_NS * S2_SLOT <= 131072, "S2 ring");
struct S2Ops { bf16x8 ah0, ah1, rt0, rt1, ma, nn, bk0, bk1, bk2, bk3; f32x4 pc0, pc1, pc2, pc3; unsigned vm01, vm23; };
#define S2_DMA(gptr, loff) __builtin_amdgcn_global_load_lds((const unsigned*)(gptr), (LAS unsigned*)(slot_ + (loff)), 16, 0, 2)
#ifndef S2_POST
#define S2_POST 1
#endif
constexpr int S2_YB = S2_NS * S2_SLOT;
static_assert(S2_YB + 8192 <= 131072, "S2 LDS");
__device__ __forceinline__ void s2_phase(unsigned char* ws, unsigned char* outb, const float* rk_, const float* lg_, const float* lb_, LAS unsigned char* lds, int tid, int lane, int wid) {
    const bf16* AHg = (const bf16*)(ws + WS_AH); const bf16* RTg = (const bf16*)(outb + OUT_RT); const bf16* MAg = (const bf16*)(ws + WS_MA); const bf16* NNg = (const bf16*)(ws + WS_NN);
    const bf16* BKg = (const bf16*)(outb + OUT_BK); const float* PCg = (const float*)(outb + OUT_PC); const bf16* VLg = (const bf16*)(ws + WS_VL);
    const bf16* GGg = (const bf16*)(ws + WS_G);
    for (int bh = blockIdx.x; bh < 64; bh += gridDim.x) {
        const int b = bh >> 3, h = bh & 7; const size_t rowbase = (size_t)b * SEQ;
        const int q = lane >> 4, n = lane & 15;
        if (wid == 4 || wid == 5) {
            const int lw = wid - 4;
#define S2_ISSUE(cc) do { LAS unsigned char* slot_ = lds + ((cc) % S2_NS) * S2_SLOT; const size_t ci_ = (size_t)bh * 512 + (cc); \
                if (lw == 0) { S2_DMA(AHg + ci_ * 1024 + lane * 8, SO_AH); S2_DMA(AHg + ci_ * 1024 + 512 + lane * 8, SO_AH + 1024); \
                    S2_DMA(RTg + ci_ * 1024 + lane * 8, SO_RT); S2_DMA(RTg + ci_ * 1024 + 512 + lane * 8, SO_RT + 1024); \
                    S2_DMA(MAg + ci_ * 512 + lane * 8, SO_MA); S2_DMA(NNg + ci_ * 512 + lane * 8, SO_NN); \
                    S2_DMA(GGg + (rowbase + (size_t)(cc) * 16 + (lane >> 3)) * RW + h * 64 + (lane & 7) * 8, SO_G); \
                    S2_DMA(GGg + (rowbase + (size_t)(cc) * 16 + 8 + (lane >> 3)) * RW + h * 64 + (lane & 7) * 8, SO_G + 1024); } \
                else { S2_DMA(BKg + ci_ * 2048 + lane * 8, SO_BK); S2_DMA(BKg + ci_ * 2048 + 512 + lane * 8, SO_BK + 1024); \
                    S2_DMA(BKg + ci_ * 2048 + 1024 + lane * 8, SO_BK + 2048); S2_DMA(BKg + ci_ * 2048 + 1536 + lane * 8, SO_BK + 3072); \
                    S2_DMA(VLg + (rowbase + (size_t)(cc) * 16 + (lane >> 3)) * RW + h * 64 + (lane & 7) * 8, SO_V); \
                    S2_DMA(VLg + (rowbase + (size_t)(cc) * 16 + 8 + (lane >> 3)) * RW + h * 64 + (lane & 7) * 8, SO_V + 1024); \
                    S2_DMA(PCg + ci_ * 256 + lane * 4, SO_PC); } } while (0)
#define S2_WAIT() do { if (lw == 1) asm volatile("s_waitcnt vmcnt(28)" ::: "memory"); else asm volatile("s_waitcnt vmcnt(32)" ::: "memory"); } while (0)
#pragma unroll 1
            for (int cc = 0; cc < S2_D; ++cc) S2_ISSUE(cc);
            S2_WAIT(); __builtin_amdgcn_s_barrier(); asm volatile("" ::: "memory");
#pragma unroll 1
            for (int i = 0; i < 512; ++i) {
                if (i + S2_D < 512) { S2_ISSUE(i + S2_D); S2_WAIT(); } else asm volatile("s_waitcnt vmcnt(0)" ::: "memory");
                __builtin_amdgcn_s_barrier(); asm volatile("" ::: "memory");
            }
#undef S2_ISSUE
#undef S2_WAIT
        } else if (wid >= 6) {
            const int L = (wid - 6) * 64 + lane, pt = L >> 3, c8 = (L & 7) * 8;
            bf16* MIXg = (bf16*)(ws + WS_MIX);
            float lg[8], lb[8]; ld8f(lg_ + h * 64 + c8, lg); ld8f(lb_ + h * 64 + c8, lb);
#define S2P_PROC(cc) do { LAS const unsigned char* yb_ = lds + S2_YB + ((cc) & 1) * 4096 + pt * 256 + c8 * 4; LAS const unsigned char* sl_ = lds + ((cc) % S2_NS) * S2_SLOT; \
                const f32x4 ya_ = *(LAS const f32x4*)yb_, yb2_ = *(LAS const f32x4*)(yb_ + 16); \
                const u32x4 vw_ = *(LAS const u32x4*)(sl_ + SO_V + pt * 128 + c8 * 2); const u32x4 gw__ = *(LAS const u32x4*)(sl_ + SO_G + pt * 128 + c8 * 2); \
                const float bs_ = *(LAS const float*)(sl_ + SO_PC + (64 + pt) * 4); \
                float y_[8] = {ya_.x, ya_.y, ya_.z, ya_.w, yb2_.x, yb2_.y, yb2_.z, yb2_.w}, v_[8], g_[8], o_[8]; \
                unpack8(vw_, v_); unpack8(gw__, g_); \
                float s_ = 0.f; \
                _Pragma("unroll") for (int i_ = 0; i_ < 8; ++i_) s_ += y_[i_]; \
                s_ = dpp_add<0xB1>(s_); s_ = dpp_add<0x4E>(s_); s_ = dpp_add<0x141>(s_); \
                const float mean_ = s_ * (1.f / 64.f); float q_ = 0.f; \
                _Pragma("unroll") for (int i_ = 0; i_ < 8; ++i_) { y_[i_] -= mean_; q_ += y_[i_] * y_[i_]; } \
                q_ = dpp_add<0xB1>(q_); q_ = dpp_add<0x4E>(q_); q_ = dpp_add<0x141>(q_); \
                const float rstd_ = rsqrtf(q_ * (1.f / 64.f) + 64e-5f); \
                _Pragma("unroll") for (int i_ = 0; i_ < 8; ++i_) o_[i_] = (y_[i_] * rstd_ * lg[i_] + lb[i_] + bs_ * v_[i_]) * g_[i_]; \
                *(u32x4*)(MIXg + (rowbase + (size_t)(cc) * 16 + pt) * D + 512 + h * 64 + c8) = pack8(o_); } while (0)
            __builtin_amdgcn_s_barrier(); asm volatile("" ::: "memory");
#pragma unroll 1
            for (int jj = 0; jj < 512; ++jj) {
                if (jj >= 1) S2P_PROC(jj - 1);
                asm volatile("s_waitcnt lgkmcnt(0)" ::: "memory"); __builtin_amdgcn_s_barrier(); asm volatile("" ::: "memory");
            }
            S2P_PROC(511);
#undef S2P_PROC
        } else {
            const int vq = wid;
            __builtin_amdgcn_s_setprio(3);
            f32x4 ST0 = (f32x4){0.f, 0.f, 0.f, 0.f}, ST1 = ST0, ST2 = ST0, ST3 = ST0;
            const f32x4 z4 = ST0;
            S2Ops A_, B_;
#define S2_LOAD(O, cc) do { LAS const unsigned char* sb_ = lds + ((cc) % S2_NS) * S2_SLOT; \
                O.ah0 = *(LAS const bf16x8*)(sb_ + SO_AH + lane * 16); O.ah1 = *(LAS const bf16x8*)(sb_ + SO_AH + 1024 + lane * 16); \
                O.rt0 = *(LAS const bf16x8*)(sb_ + SO_RT + lane * 16); O.rt1 = *(LAS const bf16x8*)(sb_ + SO_RT + 1024 + lane * 16); \
                O.ma = *(LAS const bf16x8*)(sb_ + SO_MA + lane * 16); O.nn = *(LAS const bf16x8*)(sb_ + SO_NN + lane * 16); \
                O.bk0 = *(LAS const bf16x8*)(sb_ + SO_BK + lane * 16); O.bk1 = *(LAS const bf16x8*)(sb_ + SO_BK + 1024 + lane * 16); \
                O.bk2 = *(LAS const bf16x8*)(sb_ + SO_BK + 2048 + lane * 16); O.bk3 = *(LAS const bf16x8*)(sb_ + SO_BK + 3072 + lane * 16); \
                O.pc0 = *(LAS const f32x4*)(sb_ + SO_PC + (0 + 4 * q) * 4); O.pc1 = *(LAS const f32x4*)(sb_ + SO_PC + (16 + 4 * q) * 4); \
                O.pc2 = *(LAS const f32x4*)(sb_ + SO_PC + (32 + 4 * q) * 4); O.pc3 = *(LAS const f32x4*)(sb_ + SO_PC + (48 + 4 * q) * 4); \
                { const LAS unsigned short* vp_ = (const LAS unsigned short*)(sb_ + SO_V + (4 * q) * 128 + (16 * vq + n) * 2); \
                  O.vm01 = (unsigned)vp_[0] | ((unsigned)vp_[64] << 16); O.vm23 = (unsigned)vp_[128] | ((unsigned)vp_[192] << 16); } } while (0)
#define S2_STEP(O, cc) do { \
                const bf16x8 bs0_ = mk8(pk2(ST0[0], ST0[1]), pk2(ST0[2], ST0[3]), pk2(ST1[0], ST1[1]), pk2(ST1[2], ST1[3])); \
                const bf16x8 bs1_ = mk8(pk2(ST2[0], ST2[1]), pk2(ST2[2], ST2[3]), pk2(ST3[0], ST3[1]), pk2(ST3[2], ST3[3])); \
                const bf16x8 vb_ = mk8(0u, 0u, O.vm01, O.vm23); \
                f32x4 ut_ = MFMA16(O.ma, vb_, z4); ut_ = MFMA16(O.ah0, bs0_, ut_); ut_ = MFMA16(O.ah1, bs1_, ut_);     \
                const bf16x8 uv_ = mk8(pk2(ut_[0], ut_[1]), pk2(ut_[2], ut_[3]), O.vm01, O.vm23); \
                f32x4 yt_ = MFMA16(O.rt0, bs0_, z4); yt_ = MFMA16(O.rt1, bs1_, yt_); yt_ = MFMA16(O.nn, uv_, yt_); \
                ST0 = MFMA16(O.bk0, uv_, O.pc0 * ST0); ST1 = MFMA16(O.bk1, uv_, O.pc1 * ST1); ST2 = MFMA16(O.bk2, uv_, O.pc2 * ST2); ST3 = MFMA16(O.bk3, uv_, O.pc3 * ST3); \
                LAS float* yp_ = (LAS float*)(lds + S2_YB + ((cc) & 1) * 4096 + (4 * q) * 256 + (16 * vq + n) * 4); \
                yp_[0] = yt_[0]; yp_[64] = yt_[1]; yp_[128] = yt_[2]; yp_[192] = yt_[3]; } while (0)
            __builtin_amdgcn_s_barrier(); asm volatile("" ::: "memory");
            S2_LOAD(A_, 0);
#pragma unroll 1
            for (int i = 0; i < 512; i += 2) {
                S2_LOAD(B_, i + 1); __builtin_amdgcn_sched_barrier(0);
                S2_STEP(A_, i);
                asm volatile("s_waitcnt lgkmcnt(0)" ::: "memory"); __builtin_amdgcn_s_barrier(); asm volatile("" ::: "memory");
                if (i + 2 < 512) S2_LOAD(A_, i + 2);
                __builtin_amdgcn_sched_barrier(0);
                S2_STEP(B_, i + 1);
                asm volatile("s_waitcnt lgkmcnt(0)" ::: "memory"); __builtin_amdgcn_s_barrier(); asm volatile("" ::: "memory");
            }
#undef S2_LOAD
#undef S2_STEP
        }
        __builtin_amdgcn_s_barrier(); asm volatile("" ::: "memory");
    }
}

#ifndef STAGGER
#define STAGGER 0
#endif
__device__ __forceinline__ void stagger_start(unsigned step_ticks) {
#if STAGGER
    const unsigned ticks = ((blockIdx.x >> 3) & 7u) * step_ticks;
    const unsigned long long t0 = __builtin_amdgcn_s_memrealtime();
    while ((unsigned)(__builtin_amdgcn_s_memrealtime() - t0) < ticks) __builtin_amdgcn_s_sleep(16);
#endif
}
__device__ __forceinline__ void shadow_work(const Args& A, LAS unsigned char* lds, int w0, int nw, int lane, int wave) {
    unsigned char* ws = A.ws;
    LAS float* scr = (LAS float*)(lds + wave * 16384);
    constexpr int I_OUT = (D / 64) * (D / 32), I_UP = (D / 64) * (FF / 32), I_DN = (FF / 64) * (D / 32);
    for (int it = w0; it < I_OUT + I_UP + I_DN; it += nw) {
        int r = it;
        if (r < I_OUT) { transpose_item(A.in[17], D, D, (bf16*)(ws + WS_WOUT), scr, r, lane); continue; } r -= I_OUT;
        if (r < I_UP) { transpose_item(A.in[18], D, FF, (bf16*)(ws + WS_WUP), scr, r, lane); continue; } r -= I_UP;
        transpose_item(A.in[19], FF, D, (bf16*)(ws + WS_WDN), scr, r, lane);
    }
    const float* MOD = (const float*)(ws + WS_MOD); const float* wup = A.in[18]; float* B2 = (float*)(ws + WS_BIAS2);
    for (int it = w0; it < 64 * 32; it += nw) {
        const int n = (it >> 5) * 64 + lane, k0 = (it & 31) * 32;
        float acc[8];
#pragma unroll
        for (int b = 0; b < 8; ++b) acc[b] = 0.f;
#pragma unroll 16
        for (int k = k0; k < k0 + 32; ++k) { const float w = wup[(size_t)k * FF + n];
#pragma unroll
            for (int b = 0; b < 8; ++b) acc[b] += MOD[b * NMOD + 3 * D + k] * w; }
#pragma unroll
        for (int b = 0; b < 8; ++b) unsafeAtomicAdd(B2 + b * FF + n, acc[b]);
    }
}
#define XB_TMO      128
#define XB_XCNT(j)  (256  + 64 * (j))
#define XB_XSUB(j)  (1280 + 64 * (j))
#define XB_XGEN(j)  (2304 + 64 * (j))
#define XB_TOP      3328
#define XB_TOPGEN   3392
#define XCD_BAR_WORDS 3456
#define XB_SPIN_CAP (1u << 18)

__device__ __forceinline__ unsigned xb_ld(unsigned* p)              { return __hip_atomic_load(p, __ATOMIC_RELAXED, __HIP_MEMORY_SCOPE_AGENT); }
__device__ __forceinline__ unsigned xb_add(unsigned* p, unsigned v) { return __hip_atomic_fetch_add(p, v, __ATOMIC_RELAXED, __HIP_MEMORY_SCOPE_AGENT); }
__device__ __forceinline__ unsigned xb_xcc_id() { return (unsigned)__builtin_amdgcn_s_getreg((3 << 11) | 20) & 0xFu; }
#define XB_SPIN(cond, bar) do { unsigned _sp = 0; while (cond) { __builtin_amdgcn_s_sleep(1); \
    if ((++_sp & 255u) == 0u) { if (xb_ld(&(bar)[XB_TMO])) break; if (_sp > XB_SPIN_CAP) { atomicAdd(&(bar)[XB_TMO], 1u); break; } } } } while (0)

struct XcdBarrier {
    unsigned* bar; unsigned x;
    volatile LAS unsigned* st;
};

__device__ __forceinline__ XcdBarrier xcd_barrier_post(unsigned* bar, volatile LAS unsigned* st) {
    XcdBarrier b; b.bar = bar; b.x = xb_xcc_id(); b.st = st;
    if (threadIdx.x == 0) (void)xb_add(&bar[XB_XCNT(b.x)], 1u);
    return b;
}
__device__ __forceinline__ void xcd_barrier_complete(unsigned* bar, unsigned x, unsigned& nloc, unsigned& nx) {
    const unsigned G = gridDim.x * gridDim.y * gridDim.z;
    unsigned sum, cnt, mine, sp = 0u;
    for (;;) {
        sum = 0u; cnt = 0u; mine = 0u;
#pragma unroll
        for (unsigned j = 0; j < 16; ++j) { const unsigned c = xb_ld(&bar[XB_XCNT(j)]); sum += c; cnt += (c > 0u) ? 1u : 0u; mine = (j == x) ? c : mine; }
        if (sum == G) break;
        __builtin_amdgcn_s_sleep(1);
        if ((++sp & 255u) == 0u) { if (xb_ld(&bar[XB_TMO])) break; if (sp > XB_SPIN_CAP) { atomicAdd(&bar[XB_TMO], 1u); break; } }
    }
    nloc = mine > 0u ? mine : 1u; nx = cnt > 0u ? cnt : 1u;
}

__device__ __forceinline__ void xcd_barrier(const XcdBarrier& b) {
    asm volatile("s_waitcnt vmcnt(0)" ::: "memory");
    __syncthreads();
    if (threadIdx.x == 0) {
        unsigned* bar = b.bar;
        __builtin_amdgcn_s_waitcnt(0);
        unsigned nloc = b.st[0], nx = b.st[1];
        if (nloc == 0u) { xcd_barrier_complete(bar, b.x, nloc, nx); b.st[0] = nloc; b.st[1] = nx; }
        const unsigned old = xb_add(&bar[XB_XSUB(b.x)], 1u);
        const unsigned gen = old / nloc;
        if (old + 1u == (gen + 1u) * nloc) {
            __builtin_amdgcn_fence(__ATOMIC_RELEASE, "agent");
            asm volatile("s_waitcnt vmcnt(0)" ::: "memory");
            const unsigned og = xb_add(&bar[XB_TOP], 1u);
            const unsigned tg = og / nx;
            if (og + 1u == (tg + 1u) * nx) xb_add(&bar[XB_TOPGEN], 1u);
            else XB_SPIN(xb_ld(&bar[XB_TOPGEN]) == tg, bar);
            __builtin_amdgcn_fence(__ATOMIC_ACQUIRE, "agent");
            xb_add(&bar[XB_XGEN(b.x)], 1u);
            asm volatile("s_waitcnt vmcnt(0)" ::: "memory");
        } else {
            XB_SPIN(xb_ld(&bar[XB_XGEN(b.x)]) == gen, bar);
            __builtin_amdgcn_fence(__ATOMIC_ACQUIRE, "agent");
            asm volatile("s_waitcnt vmcnt(0)" ::: "memory");
        }
    }
    __syncthreads();
}

constexpr size_t WS_BAR = 896 * 1024;
#ifndef STAGGER2
#define STAGGER2 0
#endif
__device__ __forceinline__ void stagger2(unsigned step_ticks) {
#if STAGGER2
    const unsigned ticks = ((blockIdx.x >> 3) & 7u) * step_ticks;
    const unsigned long long t0 = __builtin_amdgcn_s_memrealtime();
    while ((unsigned)(__builtin_amdgcn_s_memrealtime() - t0) < ticks) __builtin_amdgcn_s_sleep(16);
#endif
}
struct Order13 : pg8::StaticOrder {
    __device__ __forceinline__ void init13(int G_, int c_) { init(M, 12 * 256, G_, c_); }
    __device__ __forceinline__ bool next(int i, pg8::Unit& u) const {
        const long L = (long)i * G + c;
        if (L < nwg) return pg8::StaticOrder::next(i, u);
        const int j = (int)(L - nwg); if (j >= 256) return false;
        u.pm = (j % 8) * 32 + j / 8; u.pn = 12; return true;
    }
};
__global__ void __launch_bounds__(NTHR, 2) fwd_megakernel(Args A) {
    extern __shared__ __attribute__((aligned(16))) unsigned char lds_raw[];
    LAS unsigned char* lds = (LAS unsigned char*)lds_raw;
    cg::grid_group grid = cg::this_grid();
    if (threadIdx.x < 4) ((LAS unsigned*)(lds + LDS_MISC + 1024))[threadIdx.x] = 0u;
    __syncthreads();
    if (A.ph_lo < 0) grid.sync();
    (void)xcd_barrier_post((unsigned*)(A.ws + WS_BAR), (volatile LAS unsigned*)(lds + LDS_MISC + 1024));
    const int tid = threadIdx.x, lane = tid & 63, wave = __builtin_amdgcn_readfirstlane(tid >> 6);
    unsigned char* ws = A.ws;
    const int lo = A.ph_lo, hi = A.ph_hi;
    const int gw = blockIdx.x * NWAVES + wave, NGW = gridDim.x * NWAVES;
    float* MOD = (float*)(ws + WS_MOD);
#ifndef PHASE_MASK
#define PHASE_MASK 0xfff
#endif
#define IN(k) (((PHASE_MASK >> (k)) & 1) && lo <= (k) && (k) < hi)
#ifndef USE_XBAR
#define USE_XBAR 1
#endif
#define GSYNC(k) do { if (USE_XBAR) { XcdBarrier xb_; xb_.bar = (unsigned*)(A.ws + WS_BAR); xb_.x = xb_xcc_id(); xb_.st = (volatile LAS unsigned*)(lds + LDS_MISC + 1024); xcd_barrier(xb_); } else grid.sync(); } while (0)
#define SEAM(k) do { if (IN(k) && IN((k) + 1)) GSYNC(k); } while (0)
#ifndef REPEAT_MASK
#define REPEAT_MASK 0
#endif
#define REP(k) for (int rep_ = 0; rep_ < (((REPEAT_MASK >> (k)) & 1) ? 2 : 1); ++rep_, (void)((rep_ < (((REPEAT_MASK >> (k)) & 1) ? 2 : 1)) ? (grid.sync(), 0) : 0))

    if (IN(0)) { p0_prologue(A, lds, tid, lane, wave); } SEAM(0);
#ifdef EXTRA_SYNCS
    for (int e_ = 0; e_ < EXTRA_SYNCS; ++e_) grid.sync();
#endif
    REP(1) if (IN(1)) {
        int m = gw;
        for (; m + 3 * NGW < M; m += 4 * NGW) norm_mod_rows<4>(A.in[0], (bf16*)(ws + WS_XN), MOD, 0, m, NGW, lane);
        for (; m < M; m += NGW) norm_mod_rows<1>(A.in[0], (bf16*)(ws + WS_XN), MOD, 0, m, NGW, lane);
#if FUSED_RES && !(CONV_UNDER_S2 && SHADOW_EXTRA)
        for (int nn = gw; nn < FF; nn += NGW) {
            const bf16* wrow = (const bf16*)(ws + WS_WUP) + (size_t)nn * D; float wa[8], wb[8];
            unpack8(*(const u32x4*)(wrow + lane * 8), wa); unpack8(*(const u32x4*)(wrow + 512 + lane * 8), wb);
#pragma unroll 1
            for (int b = 0; b < BATCH; ++b) { const float* sh = MOD + b * NMOD + 3 * D; float sa[8], sb[8]; ld8f(sh + lane * 8, sa); ld8f(sh + 512 + lane * 8, sb); float acc_ = 0.f;
#pragma unroll
                for (int i = 0; i < 8; ++i) acc_ += sa[i] * wa[i] + sb[i] * wb[i];
                acc_ = wave_sum(acc_);
                if (lane == 0) ((float*)(ws + WS_BIAS2))[b * FF + nn] = acc_; }
        }
#endif
    } SEAM(1);
#ifdef DUP2N
    if (IN(2)) {
        pg8::Gemm g{(const bf16*)(ws + WS_XN), (const bf16*)(ws + WS_WIN), M, PT, D}; pg8::StaticOrder S; S.init(M, PT, gridDim.x, blockIdx.x);
        EpiNull E{(float*)(ws + WS_MOD) + 60000};
        pg8::gemm_phase<EpiNull, pg8::StaticOrder, true, true>(lds, g, S, E);
    } GSYNC(2);
#endif
#ifdef DUP2
    if (IN(2)) {
        pg8::Gemm g{(const bf16*)(ws + WS_XN), (const bf16*)(ws + WS_WIN), M, PT, D}; pg8::StaticOrder S; S.init(M, PT, gridDim.x, blockIdx.x);
        stagger_start(250); EpiBf<0, true> E{(bf16*)(ws + WS_P), PT};
        pg8::gemm_phase<EpiBf<0, true>, pg8::StaticOrder, true, true>(lds, g, S, E);
    } GSYNC(2);
#endif
    REP(2) if (IN(2)) {
        pg8::Gemm g{(const bf16*)(ws + WS_XN), (const bf16*)(ws + WS_WIN), M, PT, D}; Order13 S; S.init13(gridDim.x, blockIdx.x);
        EpiBf<0, true> E{(bf16*)(ws + WS_P), PT};
        pg8::gemm_phase<EpiBf<0, true>, Order13, true, true>(lds, g, S, E);
    } SEAM(2);
    REP(3) if (IN(3)) {
        vl_pass(A, gw, NGW, lane);
#if !(SCAN_CHUNKED && CONV_UNDER_S2)
        conv_pass(A, gw, NGW, lane);
#endif
    } SEAM(3);
    REP(4) if (IN(4)) {
        pg8::Gemm g{(const bf16*)(ws + WS_LA), (const bf16*)(ws + WS_LT), M, LN, LK}; pg8::StaticOrder S; S.init(M, LN, gridDim.x, blockIdx.x);
        stagger_start(100); EpiLora E{A.in[7], A.in[9], A.in[13], (const bf16*)(ws + WS_KL), (const bf16*)(ws + WS_KK), (float*)(ws + WS_DEC), (bf16*)(ws + WS_KP), (bf16*)(ws + WS_BV), (bf16*)(ws + WS_G)};
        pg8::gemm_phase<EpiLora, pg8::StaticOrder, true, true>(lds, g, S, E);
    } SEAM(4);
#if SCAN_CHUNKED
    if (IN(5)) {
        for (int ci = gw; ci < 64 * 512; ci += NGW) s1_item(ws, (unsigned char*)A.out, A.in[14], A.in[13], A.in[6], A.in[12], lds + wave * S1_WAVE, ci, lane);
#ifdef DUPS1
        grid.sync();
#pragma unroll 1
        for (int ci = gw; ci < 64 * 512; ci += NGW) s1_item(ws, (unsigned char*)A.out, A.in[14], A.in[13], A.in[6], A.in[12], lds + wave * S1_WAVE, ci, lane);
#endif
        GSYNC(5);
#ifdef DUPS2
        s2_phase(ws, (unsigned char*)A.out, A.in[14], A.in[15], A.in[16], lds, tid, lane, wave);
        GSYNC(5);
#endif
#ifdef DUPCONV
        if (blockIdx.x >= 64) conv_pass(A, (blockIdx.x - 64) * NWAVES + wave, (gridDim.x - 64) * NWAVES, lane);
        GSYNC(5);
#endif
        s2_phase(ws, (unsigned char*)A.out, A.in[14], A.in[15], A.in[16], lds, tid, lane, wave);
#if CONV_UNDER_S2
        if (gridDim.x > 64) { if (blockIdx.x >= 64) { conv_pass(A, (blockIdx.x - 64) * NWAVES + wave, (gridDim.x - 64) * NWAVES, lane); if (SHADOW_EXTRA) shadow_work(A, lds, (blockIdx.x - 64) * NWAVES + wave, (gridDim.x - 64) * NWAVES, lane, wave); } }
        else { conv_pass(A, gw, NGW, lane); if (SHADOW_EXTRA) shadow_work(A, lds, gw, NGW, lane, wave); }
#endif
    } SEAM(5);
#else
    REP(5) if (IN(5)) { scan_phase(ws, lds, tid, lane, wave); } SEAM(5);
#endif
#if !(SCAN_CHUNKED && S2_POST)
    REP(6) if (IN(6)) { int m = gw; for (; m + 3 * NGW < M; m += 4 * NGW) post_rows<4>(A, m, NGW, lane); for (; m < M; m += NGW) post_rows<1>(A, m, NGW, lane); } SEAM(6);
#endif
    REP(7) if (IN(7)) {
        pg8::Gemm g{(const bf16*)(ws + WS_MIX), (const bf16*)(ws + WS_WOUT), M, D, D}; pg8::StaticOrder S; S.init(M, D, gridDim.x, blockIdx.x);
#if FUSED_RES
        EpiRes7 E{A.in[0], (bf16*)(ws + WS_X1B), (bf16*)(ws + WS_XN), MOD, (float*)(ws + WS_RS2)};
        pg8::gemm_phase<EpiRes7, pg8::StaticOrder, true, true>(lds, g, S, E);
#else
        stagger_start(500); EpiRes E{A.in[0], A.out, MOD + 2 * D};
        pg8::gemm_phase<EpiRes, pg8::StaticOrder, true, true>(lds, g, S, E);
#endif
    } SEAM(7);
#if !FUSED_RES
    REP(8) if (IN(8)) {
        int m = gw;
        for (; m + 3 * NGW < M; m += 4 * NGW) norm_mod_rows<4>(A.out, (bf16*)(ws + WS_XN), MOD, 3, m, NGW, lane);
        for (; m < M; m += NGW) norm_mod_rows<1>(A.out, (bf16*)(ws + WS_XN), MOD, 3, m, NGW, lane);
    } SEAM(8);
#endif
#ifdef DUP9H
    if (IN(9)) {
        pg8::Gemm g{(const bf16*)(ws + WS_XN), (const bf16*)(ws + WS_WUP), M, FF / 2, D}; pg8::StaticOrder S; S.init(M, FF / 2, gridDim.x, blockIdx.x);
        EpiNull E{(float*)(ws + WS_MOD) + 60000};
        pg8::gemm_phase<EpiNull, pg8::StaticOrder, true, true>(lds, g, S, E);
    } GSYNC(9);
#endif
#ifdef DUP9N
    if (IN(9)) {
        pg8::Gemm g{(const bf16*)(ws + WS_XN), (const bf16*)(ws + WS_WUP), M, FF, D}; pg8::StaticOrder S; S.init(M, FF, gridDim.x, blockIdx.x);
        EpiNull E{(float*)(ws + WS_MOD) + 60000};
        pg8::gemm_phase<EpiNull, pg8::StaticOrder, true, true>(lds, g, S, E);
    } GSYNC(9);
#endif
#ifdef DUP9
    if (IN(9)) {
        pg8::Gemm g{(const bf16*)(ws + WS_XN), (const bf16*)(ws + WS_WUP), M, FF, D}; pg8::StaticOrder S; S.init(M, FF, gridDim.x, blockIdx.x);
        stagger_start(250); EpiBf<1> E{(bf16*)(ws + WS_H), FF};
        pg8::gemm_phase<EpiBf<1>, pg8::StaticOrder, true, true>(lds, g, S, E);
    } grid.sync();
#endif
    REP(9) if (IN(9)) {
        pg8::Gemm g{(const bf16*)(ws + WS_XN), (const bf16*)(ws + WS_WUP), M, FF, D}; pg8::StaticOrder S; S.init(M, FF, gridDim.x, blockIdx.x);
#if FUSED_RES
        stagger2(275); EpiUp2 E{(bf16*)(ws + WS_H), (const float*)(ws + WS_RS2), (const float*)(ws + WS_BIAS2)};
        pg8::gemm_phase<EpiUp2, pg8::StaticOrder, true, true>(lds, g, S, E);
#else
        stagger_start(250); EpiBf<1> E{(bf16*)(ws + WS_H), FF};
        pg8::gemm_phase<EpiBf<1>, pg8::StaticOrder, true, true>(lds, g, S, E);
#endif
    } SEAM(9);
    if (IN(10)) {
        pg8::Gemm g{(const bf16*)(ws + WS_H), (const bf16*)(ws + WS_WDN), M, D, FF}; pg8::StaticOrder S; S.init(M, D, gridDim.x, blockIdx.x);
#if FUSED_RES && FUSED_FINAL
        EpiDownF E{(const bf16*)(ws + WS_X1B), A.out, MOD, A.in[20], (float*)(ws + WS_RS3), (unsigned*)(ws + WS_CNT)};
        pg8::gemm_phase<EpiDownF, pg8::StaticOrder, true, true>(lds, g, S, E);
#elif FUSED_RES
        EpiDown2 E{(const bf16*)(ws + WS_X1B), (bf16*)(ws + WS_X2B), MOD, (float*)(ws + WS_RS3)};
        pg8::gemm_phase<EpiDown2, pg8::StaticOrder, true, true>(lds, g, S, E);
#else
        stagger_start(600); EpiRes E{A.out, A.out, MOD + 5 * D};
        pg8::gemm_phase<EpiRes, pg8::StaticOrder, true, true>(lds, g, S, E);
#endif
    }
#if FUSED_RES && FUSED_FINAL
#elif FUSED_RES
    SEAM(10);
    if (IN(11)) { int m = gw; for (; m + 3 * NGW < M; m += 4 * NGW) final_rows2<4>((const bf16*)(ws + WS_X2B), (const float*)(ws + WS_RS3), A.out, A.in[20], m, NGW, lane);
        for (; m < M; m += NGW) final_rows2<1>((const bf16*)(ws + WS_X2B), (const float*)(ws + WS_RS3), A.out, A.in[20], m, NGW, lane); }
#else
    if (IN(11)) { int m = gw; for (; m + 3 * NGW < M; m += 4 * NGW) final_rows<4>(A.out, A.in[20], m, NGW, lane); for (; m < M; m += NGW) final_rows<1>(A.out, A.in[20], m, NGW, lane); }
#endif
#undef IN
#undef SEAM
}

extern "C" void kernel_launch(void* const* d_in, const int* in_sizes, int n_in, void* d_out, int out_size, void* d_ws, size_t ws_size, hipStream_t stream) {
    static int grid_blocks = 0;
    if (grid_blocks == 0) {
        if (n_in != 21 || out_size != M * D || ws_size < WS_END) { fprintf(stderr, "kernel_launch: unexpected shapes (n_in %d out %d ws %zu)\n", n_in, out_size, ws_size); grid_blocks = -1; return; }
        int dev = 0, cus = 0, per_cu = 0;
        hipGetDevice(&dev);
        hipDeviceGetAttribute(&cus, hipDeviceAttributeMultiprocessorCount, dev);
        if (hipFuncSetAttribute((const void*)fwd_megakernel, hipFuncAttributeMaxDynamicSharedMemorySize, LDS_BYTES) != hipSuccess) { fprintf(stderr, "kernel_launch: hipFuncSetAttribute failed\n"); grid_blocks = -1; return; }
        if (hipOccupancyMaxActiveBlocksPerMultiprocessor(&per_cu, (const void*)fwd_megakernel, NTHR, LDS_BYTES) != hipSuccess || per_cu < 1) { fprintf(stderr, "kernel_launch: occupancy query failed (%d)\n", per_cu); grid_blocks = -1; return; }
        grid_blocks = cus * per_cu;
    }
    if (grid_blocks < 0) return;
    hipMemsetAsync((char*)d_ws + WS_MOD, 0, CTL_ZERO_BYTES, stream);
    Args a{};
    for (int i = 0; i < 21; ++i) a.in[i] = (const float*)d_in[i];
    a.out = (float*)d_out; a.ws = (unsigned char*)d_ws;
#if MK_SPLIT
    for (int ph = 0; ph < NPHASE; ++ph) {
        a.ph_lo = ph; a.ph_hi = ph + 1;
#else
    {
        a.ph_lo = 0; a.ph_hi = NPHASE;
#endif
        void* args[] = {&a};
        hipError_t e = hipLaunchCooperativeKernel((const void*)fwd_megakernel, dim3(grid_blocks), dim3(NTHR), args, LDS_BYTES, stream);
        if (e != hipSuccess) fprintf(stderr, "kernel_launch: cooperative launch failed: %s (grid %d)\n", hipGetErrorString(e), grid_blocks);
    }
}
```

```cpp
#include <hip/hip_runtime.h>
#include <hip/hip_cooperative_groups.h>
#include <cstdio>
#include <cstdint>
namespace cg = cooperative_groups;
namespace pg8 {
#define PG8_LAS __attribute__((address_space(3)))
typedef unsigned short bf16_t;
typedef short bf16x8 __attribute__((ext_vector_type(8)));
typedef float f32x4 __attribute__((ext_vector_type(4)));
typedef unsigned u32x4 __attribute__((ext_vector_type(4)));
constexpr int BM = 256, BK = 64, HALF = 128, HTB = HALF * BK * 2  , STAGE_BYTES = 8 * HTB, NXCD = 8, WGM = 8;

__host__ __device__ __forceinline__ int lds_byte(int r, int c) { const int st = (r >> 4) * 2 + (c >> 5), rr = r & 15, cc = c & 31, ob = rr * 64 + cc * 2; return st * 1024 + (ob ^ (((ob >> 9) & 1) << 5)); }
__host__ __device__ __forceinline__ void stage_rc(int b, int& R, int& C) { const int st = b / 1024, sb = b % 1024, swz = sb ^ (((sb >> 9) & 1) << 5); R = (st >> 1) * 16 + swz / 64; C = (st & 1) * 32 + (swz % 64) / 2; }
__host__ __device__ __forceinline__ int perm32(int rho) { const int n = rho >> 4, i = rho & 15; return 8 * (i >> 2) + 4 * n + (i & 3); }

struct Unit { int pm, pn; };
struct Gemm { const bf16_t* A; const bf16_t* Bt; int M, N, K; };

struct StaticOrder {
    int nM, nN, nwg, G, c;
    __host__ __device__ void init(int M, int N, int G_, int c_) { nM = M / BM; nN = N / BM; nwg = nM * nN; G = G_; c = c_; }
    __host__ __device__ bool next(int i, Unit& u) const {
        const long L = (long)i * G + c; if (L >= nwg) return false;
        int wgid = (int)L; { const int q = nwg / NXCD, r = nwg % NXCD, xcd = wgid % NXCD, off = wgid / NXCD; wgid = (xcd < r ? xcd * (q + 1) : r * (q + 1) + (xcd - r) * q) + off; }
        const int nig = WGM * nN, gid = wgid / nig, fm = gid * WGM, gsz = (nM - fm) < WGM ? (nM - fm) : WGM;
        u.pm = fm + ((wgid % nig) % gsz); u.pn = (wgid % nig) / gsz; return true;
    }
    __device__ __forceinline__ void a_ready(const Unit&) const {}
    __device__ __forceinline__ void done(const Unit&) const {}
};
__device__ __forceinline__ unsigned cvt_pk_bf16(float lo, float hi) { unsigned r; asm volatile("v_cvt_pk_bf16_f32 %0, %1, %2" : "=v"(r) : "v"(lo), "v"(hi)); return r; }
template <class Epi, class Sched, bool ALIGN_EPI = false, bool SP2 = false>
__device__ __forceinline__ void gemm_phase(PG8_LAS unsigned char* lds, const Gemm g, const Sched& S, const Epi& E) {
    const int tid = threadIdx.x, wid = __builtin_amdgcn_readfirstlane(tid >> 6), lane = tid & 63, wr = wid >> 2, wc = wid & 3, fr = lane & 15, fq = lane >> 4;
    const int K = g.K, nt = K / BK;
    unsigned voffA[2], voffB[2];
#pragma unroll
    for (int i = 0; i < 2; ++i) { int R, C; stage_rc(tid * 16 + i * 8192, R, C); const int Rb = Epi::PERM ? ((R & ~31) + perm32(R & 31)) : R;
        voffA[i] = (unsigned)(R * K + C) * 2u; voffB[i] = (unsigned)(Rb * K + C) * 2u; }
    const size_t kstep = (size_t)(BK * 2);
    const size_t hstep = (size_t)HALF * K * 2;
    const size_t tstep = 2 * hstep;
    const unsigned ldsw = (unsigned)wid * 1024u;
    const int aoff = lds_byte(wr * 64 + fr, fq * 8), boff = lds_byte(wc * 32 + fr, fq * 8);
#define PG8_SA(b, h) (((b) * 2 + (h)) * HTB)
#define PG8_SB(b, h) ((4 + (b) * 2 + (h)) * HTB)
#define PG8_STAGE(bufoff, gbase, voff) do { _Pragma("unroll") for (int _i = 0; _i < 2; ++_i) \
        __builtin_amdgcn_global_load_lds((const unsigned*)((const char*)(gbase) + (voff)[_i]), (PG8_LAS unsigned*)(lds + (bufoff) + ldsw + _i * 8192), 16, 0, 0); } while (0)
#define PG8_LDA(dst, b, h) do { _Pragma("unroll") for (int m = 0; m < 4; ++m) _Pragma("unroll") for (int k = 0; k < 2; ++k) dst[m][k] = *(const PG8_LAS bf16x8*)(lds + PG8_SA(b, h) + aoff + m * 2048 + k * 1024); } while (0)
#define PG8_LDB(dst, b, h) do { _Pragma("unroll") for (int n = 0; n < 2; ++n) _Pragma("unroll") for (int k = 0; k < 2; ++k) dst[n][k] = *(const PG8_LAS bf16x8*)(lds + PG8_SB(b, h) + boff + n * 2048 + k * 1024); } while (0)
#define PG8_MMA(ai, bj, At, Bt) do { __builtin_amdgcn_s_setprio(1); _Pragma("unroll") for (int m = 0; m < 4; ++m) _Pragma("unroll") for (int n = 0; n < 2; ++n) _Pragma("unroll") for (int k = 0; k < 2; ++k) \
        acc[ai][bj][m][n] = __builtin_amdgcn_mfma_f32_16x16x32_bf16(Bt[n][k], At[m][k], acc[ai][bj][m][n], 0, 0, 0); __builtin_amdgcn_s_setprio(0); } while (0)
#define PG8_WAIT_V(n) asm volatile("s_waitcnt vmcnt(" #n ")" ::: "memory")
#define PG8_WAIT_L(n) asm volatile("s_waitcnt lgkmcnt(" #n ")" ::: "memory")
#define PG8_BAR __builtin_amdgcn_s_barrier()
#define PG8_SCHED __builtin_amdgcn_sched_barrier(0)
    Unit cur, nxt; int ui = 0;
    if (!S.next(0, cur)) return;
    f32x4 acc[2][2][4][2];
#pragma unroll
    for (int a = 0; a < 2; ++a)
#pragma unroll
        for (int b = 0; b < 2; ++b)
#pragma unroll
            for (int m = 0; m < 4; ++m)
#pragma unroll
                for (int n = 0; n < 2; ++n) acc[a][b][m][n] = (f32x4){0.f, 0.f, 0.f, 0.f};
    bf16x8 At[4][2], B0[2][2], B1[2][2];
    const char* cA = (const char*)g.A + (size_t)cur.pm * tstep; const char* cB = (const char*)g.Bt + (size_t)cur.pn * tstep;
    S.a_ready(cur);
    if constexpr (SP2) {
        PG8_STAGE(PG8_SB(0, 0), cB, voffB); PG8_STAGE(PG8_SB(0, 1), cB + hstep, voffB); PG8_STAGE(PG8_SA(0, 0), cA, voffA); PG8_STAGE(PG8_SA(0, 1), cA + hstep, voffA);
        if (wr == 1) PG8_BAR;
        PG8_WAIT_V(2); PG8_BAR;
        PG8_STAGE(PG8_SB(1, 0), cB + kstep, voffB); PG8_STAGE(PG8_SA(1, 0), cA + kstep, voffA); PG8_STAGE(PG8_SB(1, 1), cB + hstep + kstep, voffB);
        PG8_WAIT_V(6); PG8_BAR;
    } else {
        PG8_STAGE(PG8_SB(0, 0), cB, voffB); PG8_STAGE(PG8_SA(0, 0), cA, voffA); PG8_STAGE(PG8_SB(0, 1), cB + hstep, voffB); PG8_STAGE(PG8_SA(0, 1), cA + hstep, voffA);
        if (wr == 1) PG8_BAR;
        PG8_WAIT_V(4); PG8_BAR;
        PG8_STAGE(PG8_SB(1, 0), cB + kstep, voffB); PG8_STAGE(PG8_SA(1, 0), cA + kstep, voffA); PG8_STAGE(PG8_SB(1, 1), cB + hstep + kstep, voffB);
        PG8_WAIT_V(6); PG8_BAR;
    }
    for (;;) {
        const bool has_next = S.next(ui + 1, nxt);
        const char* nA = has_next ? (const char*)g.A + (size_t)nxt.pm * tstep : cA; const char* nB = has_next ? (const char*)g.Bt + (size_t)nxt.pn * tstep : cB;
#pragma unroll 1
        for (int t = 0; t < nt; t += 2) {
            const bool last = (t == nt - 2);
            const char* a1 = cA + (size_t)(t + 1) * kstep;
            const char* a2 = last ? nA : cA + (size_t)(t + 2) * kstep; const char* b2 = last ? nB : cB + (size_t)(t + 2) * kstep;
            const char* a3 = a2 + kstep; const char* b3 = b2 + kstep;
            if (last && has_next) S.a_ready(nxt);
            if constexpr (SP2) {
            PG8_LDB(B0, 0, 0); PG8_LDB(B1, 0, 1); PG8_SCHED; PG8_LDA(At, 0, 0); PG8_STAGE(PG8_SA(1, 1), a1 + hstep, voffA);
            PG8_WAIT_V(8); PG8_WAIT_L(0); PG8_BAR; PG8_MMA(0, 0, At, B0); PG8_MMA(0, 1, At, B1); PG8_BAR; PG8_SCHED;
            PG8_LDA(At, 0, 1); PG8_STAGE(PG8_SB(0, 0), b2, voffB); PG8_STAGE(PG8_SB(0, 1), b2 + hstep, voffB); PG8_STAGE(PG8_SA(0, 0), a2, voffA);
            PG8_WAIT_V(8); PG8_WAIT_L(0); PG8_BAR; PG8_MMA(1, 0, At, B0); PG8_MMA(1, 1, At, B1); PG8_BAR; PG8_SCHED;
            PG8_LDB(B0, 1, 0); PG8_LDB(B1, 1, 1); PG8_SCHED; PG8_LDA(At, 1, 0); PG8_STAGE(PG8_SA(0, 1), a2 + hstep, voffA);
            PG8_WAIT_V(8); PG8_WAIT_L(0); PG8_BAR; PG8_MMA(0, 0, At, B0); PG8_MMA(0, 1, At, B1); PG8_BAR; PG8_SCHED;
            PG8_LDA(At, 1, 1); PG8_STAGE(PG8_SB(1, 0), b3, voffB); PG8_STAGE(PG8_SB(1, 1), b3 + hstep, voffB); PG8_STAGE(PG8_SA(1, 0), a3, voffA);
            PG8_WAIT_V(8); PG8_WAIT_L(0); PG8_BAR; PG8_MMA(1, 0, At, B0); PG8_MMA(1, 1, At, B1); PG8_BAR; PG8_SCHED;
            } else {
            PG8_LDB(B0, 0, 0); PG8_SCHED; PG8_LDA(At, 0, 0); PG8_STAGE(PG8_SA(1, 1), a1 + hstep, voffA);
            PG8_WAIT_L(8); PG8_BAR; PG8_WAIT_L(0); PG8_MMA(0, 0, At, B0); PG8_BAR; PG8_SCHED;
            PG8_LDB(B1, 0, 1); PG8_STAGE(PG8_SB(0, 0), b2, voffB);
            PG8_BAR; PG8_WAIT_L(0); PG8_MMA(0, 1, At, B1); PG8_BAR;
            PG8_LDA(At, 0, 1); PG8_STAGE(PG8_SA(0, 0), a2, voffA);
            PG8_BAR; PG8_WAIT_L(0); PG8_MMA(1, 0, At, B0); PG8_BAR; PG8_SCHED;
            PG8_STAGE(PG8_SB(0, 1), b2 + hstep, voffB);
            PG8_WAIT_V(6); PG8_BAR; PG8_MMA(1, 1, At, B1); PG8_BAR;
            PG8_LDB(B0, 1, 0); PG8_SCHED; PG8_LDA(At, 1, 0); PG8_STAGE(PG8_SA(0, 1), a2 + hstep, voffA);
            PG8_WAIT_L(8); PG8_BAR; PG8_WAIT_L(0); PG8_MMA(0, 0, At, B0); PG8_BAR; PG8_SCHED;
            PG8_LDB(B1, 1, 1); PG8_STAGE(PG8_SB(1, 0), b3, voffB);
            PG8_BAR; PG8_WAIT_L(0); PG8_MMA(0, 1, At, B1); PG8_BAR;
            PG8_LDA(At, 1, 1); PG8_STAGE(PG8_SA(1, 0), a3, voffA);
            PG8_BAR; PG8_WAIT_L(0); PG8_MMA(1, 0, At, B0); PG8_BAR; PG8_SCHED;
            PG8_STAGE(PG8_SB(1, 1), b3 + hstep, voffB);
            PG8_WAIT_V(6); PG8_BAR; PG8_MMA(1, 1, At, B1); PG8_BAR;
            }
        }
        if constexpr (ALIGN_EPI) { if (wr == 0) PG8_BAR; }
        if constexpr (!Epi::AFTER_DRAIN) { E(acc, cur, wr, wc, fr, fq); S.done(cur); }
        if (!has_next) break;
#pragma unroll
        for (int a = 0; a < 2; ++a)
#pragma unroll
            for (int b = 0; b < 2; ++b)
#pragma unroll
                for (int m = 0; m < 4; ++m)
#pragma unroll
                    for (int n = 0; n < 2; ++n) acc[a][b][m][n] = (f32x4){0.f, 0.f, 0.f, 0.f};
        cur = nxt; cA = nA; cB = nB; ++ui;
        if constexpr (ALIGN_EPI) { if (wr == 1) PG8_BAR; }
    }
    PG8_WAIT_V(0);
    if constexpr (!ALIGN_EPI) { if (wr == 0) PG8_BAR; }
    PG8_BAR;
    if constexpr (Epi::AFTER_DRAIN) { E.fused(acc, cur, wr, wc, fr, fq, lds, wid, lane); S.done(cur); }
#undef PG8_SA
#undef PG8_SB
#undef PG8_STAGE
#undef PG8_LDA
#undef PG8_LDB
#undef PG8_MMA
#undef PG8_WAIT_V
#undef PG8_WAIT_L
#undef PG8_BAR
#undef PG8_SCHED
}
}

#ifndef CONV_UNDER_S2
#define CONV_UNDER_S2 1
#endif
#ifndef SHADOW_EXTRA
#define SHADOW_EXTRA 1
#endif
#ifndef MK_SPLIT
#define MK_SPLIT 0
#endif
constexpr int NWAVES = 8, NTHR = 512;
constexpr int BATCH = 8, SEQ = 8192, D = 1024, M = BATCH * SEQ;
constexpr int PCONV = 1536, PT = 3328, FF = 4096, RW = 512;
constexpr int LK = 256, LN = 1536;
constexpr int NMOD = 6 * D;
constexpr int NPHASE = 12;
constexpr size_t MiB = 1u << 20;
constexpr size_t WS_MOD = 0, WS_RS2 = 256 * 1024, WS_RS3 = 512 * 1024, WS_BIAS2 = 768 * 1024, CTL_ZERO_BYTES = 1024 * 1024;
constexpr size_t WS_X1B = 704ull << 20, WS_X2B = 864ull << 20;
constexpr size_t WS_WIN = 1 * MiB, WS_WOUT = 8 * MiB, WS_WUP = 10 * MiB, WS_WDN = 18 * MiB, WS_LT = 26 * MiB;
constexpr size_t WS_XN = 32 * MiB;
constexpr size_t WS_Y = 32 * MiB;
constexpr size_t WS_P = 160 * MiB;
constexpr size_t WS_DEC = 32 * MiB  , WS_KP = 576 * MiB  , WS_BV = 352 * MiB  , WS_G = 640 * MiB  ;
constexpr size_t WS_H = 160 * MiB;
constexpr size_t WS_RL = 576 * MiB, WS_KL = 640 * MiB, WS_VL = 704 * MiB, WS_KK = 768 * MiB;
constexpr size_t WS_LA = 832 * MiB;
constexpr size_t WS_MIX = 864 * MiB;
constexpr size_t WS_END = 1024 * MiB;
constexpr int LDS_MISC = 131072, LDS_BYTES = 131072 + 2048;

typedef unsigned short bf16;
typedef float f32x4 __attribute__((ext_vector_type(4)));
typedef float f32x2 __attribute__((ext_vector_type(2)));
typedef unsigned u32x4 __attribute__((ext_vector_type(4)));
typedef unsigned u32x2 __attribute__((ext_vector_type(2)));
#define LAS __attribute__((address_space(3)))

typedef __bf16 bf16v2_t __attribute__((ext_vector_type(2)));
__device__ __forceinline__ unsigned pk2(float lo, float hi) { return __builtin_bit_cast(unsigned, __builtin_convertvector((f32x2){lo, hi}, bf16v2_t)); }
__device__ __forceinline__ float bflo(unsigned w) { return __uint_as_float(w << 16); }
__device__ __forceinline__ float bfhi(unsigned w) { return __uint_as_float(w & 0xffff0000u); }
__device__ __forceinline__ void unpack8(const u32x4 w, float (&f)[8]) {
    f[0] = bflo(w.x); f[1] = bfhi(w.x); f[2] = bflo(w.y); f[3] = bfhi(w.y); f[4] = bflo(w.z); f[5] = bfhi(w.z); f[6] = bflo(w.w); f[7] = bfhi(w.w);
}
__device__ __forceinline__ u32x4 pack8(const float (&f)[8]) { u32x4 w; w.x = pk2(f[0], f[1]); w.y = pk2(f[2], f[3]); w.z = pk2(f[4], f[5]); w.w = pk2(f[6], f[7]); return w; }
__device__ __forceinline__ void ld8f(const float* p, float (&f)[8]) { const f32x4 a = *(const f32x4*)p, b = *(const f32x4*)(p + 4); f[0] = a.x; f[1] = a.y; f[2] = a.z; f[3] = a.w; f[4] = b.x; f[5] = b.y; f[6] = b.z; f[7] = b.w; }
__device__ __forceinline__ float wave_sum(float v) {
#pragma unroll
    for (int o = 1; o < 64; o <<= 1) v += __shfl_xor(v, o);
    return v;
}
__device__ __forceinline__ float sum8(float v) { v += __shfl_xor(v, 1); v += __shfl_xor(v, 2); v += __shfl_xor(v, 4); return v; }
__device__ __forceinline__ float sigmoidf_(float x) { return 1.0f / (1.0f + __expf(-x)); }

struct Args { const float* in[21]; float* out; unsigned char* ws; int ph_lo, ph_hi; };

template <int ACT  , bool TILED = false> struct EpiBf {
    static constexpr bool PERM = true, AFTER_DRAIN = false;
    bf16* O; int ldc;
    __device__ __forceinline__ void operator()(const pg8::f32x4 (&acc)[2][2][4][2], const pg8::Unit& u, int wr, int wc, int fr, int fq) const {
        const int row0 = u.pm * 256 + wr * 64 + fr, col0 = u.pn * 256 + wc * 32 + 8 * fq;
        unsigned long long rp = (unsigned long long)(TILED ? O + ((size_t)(u.pm * 13 + u.pn) << 16) + (size_t)(wr * 64 + fr) * 256 + wc * 32 + 8 * fq : O + (size_t)row0 * ldc + col0);
        const unsigned long long rstep = (unsigned long long)(TILED ? 256 : ldc) * 2ull;
#pragma unroll
        for (int ai = 0; ai < 2; ++ai)
#pragma unroll
            for (int m = 0; m < 4; ++m) { bf16* rowp = (bf16*)rp;
#pragma unroll
                for (int bj = 0; bj < 2; ++bj) { pg8::f32x4 v0 = acc[ai][bj][m][0], v1 = acc[ai][bj][m][1];
                    if (ACT == 1) {
#pragma unroll
                        for (int j = 0; j < 4; ++j) { const float a = fmaxf(v0[j], 0.f), b = fmaxf(v1[j], 0.f); v0[j] = a * a; v1[j] = b * b; } }
                    u32x4 w; w.x = pk2(v0[0], v0[1]); w.y = pk2(v0[2], v0[3]); w.z = pk2(v1[0], v1[1]); w.w = pk2(v1[2], v1[3]);
                    *(u32x4*)(rowp + bj * 128) = w; }
                rp += (m == 3 ? 80ull : 16ull) * rstep;
                asm volatile("" : "+v"(rp) :: "memory"); }
    }
};
struct EpiNull { static constexpr bool PERM = true, AFTER_DRAIN = false; float* sink;
    __device__ __forceinline__ void operator()(const pg8::f32x4 (&acc)[2][2][4][2], const pg8::Unit& u, int wr, int wc, int fr, int fq) const {
        float s = 0.f;
#pragma unroll
        for (int ai = 0; ai < 2; ++ai)
#pragma unroll
            for (int bj = 0; bj < 2; ++bj)
#pragma unroll
                for (int m = 0; m < 4; ++m)
#pragma unroll
                    for (int n = 0; n < 2; ++n) s += acc[ai][bj][m][n][0] + acc[ai][bj][m][n][1] + acc[ai][bj][m][n][2] + acc[ai][bj][m][n][3];
        if (s == 123.456f) sink[0] = s; } };
struct EpiRes {
    static constexpr bool PERM = false, AFTER_DRAIN = false;
    const float* X; float* O; const float* gate;
    __device__ __forceinline__ void operator()(const pg8::f32x4 (&acc)[2][2][4][2], const pg8::Unit& u, int wr, int wc, int fr, int fq) const {
        const int row0 = u.pm * 256 + wr * 64 + fr, col0 = u.pn * 256 + wc * 32 + 4 * fq, b = u.pm >> 5;
        f32x4 gv[2][2];
#pragma unroll
        for (int bj = 0; bj < 2; ++bj)
#pragma unroll
            for (int n = 0; n < 2; ++n) gv[bj][n] = *(const f32x4*)(gate + (size_t)b * NMOD + col0 + bj * 128 + n * 16);
#pragma unroll
        for (int ai = 0; ai < 2; ++ai)
#pragma unroll
            for (int m = 0; m < 4; ++m) { const size_t off = (size_t)(row0 + ai * 128 + m * 16) * D + col0;
#pragma unroll
                for (int bj = 0; bj < 2; ++bj)
#pragma unroll
                    for (int n = 0; n < 2; ++n) { const f32x4 xv = *(const f32x4*)(X + off + bj * 128 + n * 16);
                        *(f32x4*)(O + off + bj * 128 + n * 16) = xv + gv[bj][n] * acc[ai][bj][m][n]; }
                asm volatile("" ::: "memory"); }
    }
};
#ifndef LK0
#define LK0 1
#endif
#ifndef LK1
#define LK1 1
#endif
#ifndef LK2
#define LK2 1
#endif
#ifndef SCAN_CHUNKED
#define SCAN_CHUNKED 1
#endif
#define LORA_LOGW SCAN_CHUNKED
struct EpiLora {
    static constexpr bool PERM = true, AFTER_DRAIN = false;
    const float *w0, *a0, *k_a; const bf16 *KL, *KK; float* DEC; bf16 *KP, *BV, *G;
    __device__ __forceinline__ void operator()(const pg8::f32x4 (&acc)[2][2][4][2], const pg8::Unit& u, int wr, int wc, int fr, int fq) const {
        const int kind = u.pn >> 1, row0 = u.pm * 256 + wr * 64 + fr, cb = (u.pn & 1) * 256 + wc * 32 + 8 * fq;
#pragma unroll
        for (int bj = 0; bj < 2; ++bj) {
            const int c = cb + bj * 128;
            if (LK0 && kind == 0) {
                float wv[8]; ld8f(w0 + c, wv);
#pragma unroll
                for (int ai = 0; ai < 2; ++ai)
#pragma unroll
                    for (int m = 0; m < 4; ++m) { const size_t off = (size_t)(row0 + ai * 128 + m * 16) * RW + c; float o8[8];
#pragma unroll
                        for (int n = 0; n < 2; ++n)
#pragma unroll
                            for (int j = 0; j < 4; ++j) { const float pre = acc[ai][bj][m][n][j] + wv[4 * n + j];
                                o8[4 * n + j] = -0.6065306597f * sigmoidf_(pre); }
                        *(u32x4*)((bf16*)DEC + off) = pack8(o8); asm volatile("" ::: "memory"); }
            } else if (LK1 && kind == 1) {
                float av[8]; ld8f(a0 + c, av);
#pragma unroll
                for (int ai = 0; ai < 2; ++ai)
#pragma unroll
                    for (int m = 0; m < 4; ++m) { const size_t off = (size_t)(row0 + ai * 128 + m * 16) * RW + c; float a8[8];
#pragma unroll
                        for (int n = 0; n < 2; ++n)
#pragma unroll
                            for (int j = 0; j < 4; ++j) a8[4 * n + j] = sigmoidf_(acc[ai][bj][m][n][j] + av[4 * n + j]);
                        *(u32x4*)(KP + off) = pack8(a8); }
            } else if (LK2) {
#pragma unroll
                for (int ai = 0; ai < 2; ++ai)
#pragma unroll
                    for (int m = 0; m < 4; ++m) { const size_t off = (size_t)(row0 + ai * 128 + m * 16) * RW + c;
                        const pg8::f32x4 v0 = acc[ai][bj][m][0], v1 = acc[ai][bj][m][1];
                        u32x4 w; w.x = pk2(v0[0], v0[1]); w.y = pk2(v0[2], v0[3]); w.z = pk2(v1[0], v1[1]); w.w = pk2(v1[2], v1[3]);
                        *(u32x4*)(G + off) = w; }
            }
        }
    }
};


#ifndef FUSED_RES
#define FUSED_RES 1
#endif
#ifndef CONV_UNDER_S2
#define CONV_UNDER_S2 1
#endif
struct EpiRes7 {
    static constexpr bool PERM = true, AFTER_DRAIN = false;
    const float* X; bf16* X1B; bf16* A2; const float* MODp; float* RS;
    __device__ __forceinline__ void operator()(const pg8::f32x4 (&acc)[2][2][4][2], const pg8::Unit& u, int wr, int wc, int fr, int fq) const {
        const int row0 = u.pm * 256 + wr * 64 + fr, col0 = u.pn * 256 + wc * 32 + 8 * fq, b = u.pm >> 5;
        float gv[2][8], sv[2][8];
#pragma unroll
        for (int bj = 0; bj < 2; ++bj) { ld8f(MODp + (size_t)b * NMOD + 2 * D + col0 + bj * 128, gv[bj]); ld8f(MODp + (size_t)b * NMOD + 4 * D + col0 + bj * 128, sv[bj]); }
#pragma unroll
        for (int ai = 0; ai < 2; ++ai)
#pragma unroll
            for (int m = 0; m < 4; ++m) { const int row = row0 + ai * 128 + m * 16; const size_t off = (size_t)row * D + col0; float ss = 0.f;
#pragma unroll
                for (int bj = 0; bj < 2; ++bj) { float xv[8], x1[8], a2[8]; { const f32x4 xa_ = __builtin_nontemporal_load((const f32x4*)(X + off + bj * 128)), xb_ = __builtin_nontemporal_load((const f32x4*)(X + off + bj * 128 + 4)); xv[0] = xa_.x; xv[1] = xa_.y; xv[2] = xa_.z; xv[3] = xa_.w; xv[4] = xb_.x; xv[5] = xb_.y; xv[6] = xb_.z; xv[7] = xb_.w; }
#pragma unroll
                    for (int i = 0; i < 8; ++i) { x1[i] = xv[i] + gv[bj][i] * acc[ai][bj][m][i >> 2][i & 3]; ss += x1[i] * x1[i]; a2[i] = x1[i] * (1.0f + sv[bj][i]); }
                    *(u32x4*)(X1B + off + bj * 128) = pack8(x1); *(u32x4*)(A2 + off + bj * 128) = pack8(a2); }
                ss += __shfl_xor(ss, 16); ss += __shfl_xor(ss, 32);
                if (fq == 0) unsafeAtomicAdd(RS + row, ss);
                asm volatile("" ::: "memory"); }
    }
};
struct EpiUp2 {
    static constexpr bool PERM = true, AFTER_DRAIN = false;
    bf16* O; const float* RS; const float* BIAS;
    __device__ __forceinline__ void operator()(const pg8::f32x4 (&acc)[2][2][4][2], const pg8::Unit& u, int wr, int wc, int fr, int fq) const {
        const int row0 = u.pm * 256 + wr * 64 + fr, col0 = u.pn * 256 + wc * 32 + 8 * fq, b = u.pm >> 5;
        float bv[2][8];
#pragma unroll
        for (int bj = 0; bj < 2; ++bj) ld8f(BIAS + (size_t)b * FF + col0 + bj * 128, bv[bj]);
#pragma unroll
        for (int ai = 0; ai < 2; ++ai)
#pragma unroll
            for (int m = 0; m < 4; ++m) { const int row = row0 + ai * 128 + m * 16; const float rstd = rsqrtf(RS[row] * (1.f / D) + 1e-6f);
                bf16* rowp = O + (size_t)row * FF + col0;
#pragma unroll
                for (int bj = 0; bj < 2; ++bj) { float hv[8];
#pragma unroll
                    for (int i = 0; i < 8; ++i) { const float v = fmaxf(acc[ai][bj][m][i >> 2][i & 3] * rstd + bv[bj][i], 0.f); hv[i] = v * v; }
                    *(u32x4*)(rowp + bj * 128) = pack8(hv); } }
    }
};
struct EpiDown2 {
    static constexpr bool PERM = true, AFTER_DRAIN = false;
    const bf16* X1B; bf16* X2B; const float* MODp; float* RS;
    __device__ __forceinline__ void operator()(const pg8::f32x4 (&acc)[2][2][4][2], const pg8::Unit& u, int wr, int wc, int fr, int fq) const {
        const int row0 = u.pm * 256 + wr * 64 + fr, col0 = u.pn * 256 + wc * 32 + 8 * fq, b = u.pm >> 5;
        float gv[2][8];
#pragma unroll
        for (int bj = 0; bj < 2; ++bj) ld8f(MODp + (size_t)b * NMOD + 5 * D + col0 + bj * 128, gv[bj]);
#pragma unroll
        for (int ai = 0; ai < 2; ++ai)
#pragma unroll
            for (int m = 0; m < 4; ++m) { const int row = row0 + ai * 128 + m * 16; const size_t off = (size_t)row * D + col0; float ss = 0.f;
#pragma unroll
                for (int bj = 0; bj < 2; ++bj) { float xv[8], x2[8]; unpack8(*(const u32x4*)(X1B + off + bj * 128), xv);
#pragma unroll
                    for (int i = 0; i < 8; ++i) { x2[i] = xv[i] + gv[bj][i] * acc[ai][bj][m][i >> 2][i & 3]; ss += x2[i] * x2[i]; }
                    *(u32x4*)(X2B + off + bj * 128) = pack8(x2); }
                ss += __shfl_xor(ss, 16); ss += __shfl_xor(ss, 32);
                if (fq == 0) unsafeAtomicAdd(RS + row, ss);
                asm volatile("" ::: "memory"); }
    }
};

#ifndef FUSED_FINAL
#define FUSED_FINAL 1
#endif
constexpr size_t WS_CNT = 928 * 1024;
struct EpiDownF {
    static constexpr bool PERM = true, AFTER_DRAIN = false;
    const bf16* X1B; float* OUT; const float* MODp; const float* G; float* RS; unsigned* CNT;
    __device__ __forceinline__ void operator()(const pg8::f32x4 (&acc_)[2][2][4][2], const pg8::Unit& u, int wr, int wc, int fr, int fq) const {
        pg8::f32x4 (&acc)[2][2][4][2] = const_cast<pg8::f32x4 (&)[2][2][4][2]>(acc_);
        const int row0 = u.pm * 256 + wr * 64 + fr, col0 = u.pn * 256 + wc * 32 + 8 * fq, b = u.pm >> 5;
        {
            float gv[2][8];
#pragma unroll
            for (int bj = 0; bj < 2; ++bj) ld8f(MODp + (size_t)b * NMOD + 5 * D + col0 + bj * 128, gv[bj]);
#pragma unroll
            for (int ai = 0; ai < 2; ++ai)
#pragma unroll
                for (int m = 0; m < 4; ++m) { const int row = row0 + ai * 128 + m * 16; const size_t off = (size_t)row * D + col0; float ss = 0.f;
#pragma unroll
                    for (int bj = 0; bj < 2; ++bj) { float xv[8]; unpack8(*(const u32x4*)(X1B + off + bj * 128), xv);
#pragma unroll
                        for (int i = 0; i < 8; ++i) { const float x2 = xv[i] + gv[bj][i] * acc[ai][bj][m][i >> 2][i & 3]; acc[ai][bj][m][i >> 2][i & 3] = x2; ss += x2 * x2; } }
                    ss += __shfl_xor(ss, 16); ss += __shfl_xor(ss, 32);
                    if (fq == 0) unsafeAtomicAdd(RS + row, ss);
                    asm volatile("" ::: "memory"); }
        }
        asm volatile("s_waitcnt vmcnt(0)" ::: "memory");
        unsigned* cnt = CNT + 64 * u.pm;
        if ((threadIdx.x & 63) == 0) __hip_atomic_fetch_add(cnt, 1u, __ATOMIC_RELAXED, __HIP_MEMORY_SCOPE_AGENT);
        { unsigned sp = 0;
          while ((unsigned)__builtin_amdgcn_readfirstlane(__hip_atomic_load(cnt, __ATOMIC_RELAXED, __HIP_MEMORY_SCOPE_AGENT)) < 32u) { __builtin_amdgcn_s_sleep(2); if (++sp > (1u << 20)) break; } }
        float rstd[2][4];
#pragma unroll
        for (int ai = 0; ai < 2; ++ai)
#pragma unroll
            for (int m = 0; m < 4; ++m) rstd[ai][m] = rsqrtf(__hip_atomic_load(RS + row0 + ai * 128 + m * 16, __ATOMIC_RELAXED, __HIP_MEMORY_SCOPE_AGENT) * (1.f / D) + 1e-6f);
#pragma unroll
        for (int bj = 0; bj < 2; ++bj) {
            float g8[8]; ld8f(G + col0 + bj * 128, g8);
#pragma unroll
            for (int ai = 0; ai < 2; ++ai)
#pragma unroll
                for (int m = 0; m < 4; ++m) { float* op = OUT + (size_t)(row0 + ai * 128 + m * 16) * D + col0 + bj * 128; const float r_ = rstd[ai][m];
                    const pg8::f32x4 a0 = acc[ai][bj][m][0], a1 = acc[ai][bj][m][1];
                    *(f32x4*)(op) = (f32x4){a0[0] * r_ * g8[0], a0[1] * r_ * g8[1], a0[2] * r_ * g8[2], a0[3] * r_ * g8[3]};
                    *(f32x4*)(op + 4) = (f32x4){a1[0] * r_ * g8[4], a1[1] * r_ * g8[5], a1[2] * r_ * g8[6], a1[3] * r_ * g8[7]}; }
        }
    }
};
template <int R> __device__ __forceinline__ void final_rows2(const bf16* X2B, const float* RS, float* OUT, const float* g, int m0, int stride, int lane) {
    u32x4 w0[R], w1[R]; float rs[R];
#pragma unroll
    for (int r = 0; r < R; ++r) { const size_t off = (size_t)(m0 + r * stride) * D + lane * 8; w0[r] = *(const u32x4*)(X2B + off); w1[r] = *(const u32x4*)(X2B + off + 512); rs[r] = RS[m0 + r * stride]; }
    float g0[8], g1[8]; ld8f(g + lane * 8, g0); ld8f(g + 512 + lane * 8, g1);
#pragma unroll
    for (int r = 0; r < R; ++r) { const float rstd = rsqrtf(rs[r] * (1.f / D) + 1e-6f); float a[8], c[8]; unpack8(w0[r], a); unpack8(w1[r], c);
        float* op = OUT + (size_t)(m0 + r * stride) * D + lane * 8;
        *(f32x4*)(op) = (f32x4){a[0] * rstd * g0[0], a[1] * rstd * g0[1], a[2] * rstd * g0[2], a[3] * rstd * g0[3]};
        *(f32x4*)(op + 4) = (f32x4){a[4] * rstd * g0[4], a[5] * rstd * g0[5], a[6] * rstd * g0[6], a[7] * rstd * g0[7]};
        *(f32x4*)(op + 512) = (f32x4){c[0] * rstd * g1[0], c[1] * rstd * g1[1], c[2] * rstd * g1[2], c[3] * rstd * g1[3]};
        *(f32x4*)(op + 516) = (f32x4){c[4] * rstd * g1[4], c[5] * rstd * g1[5], c[6] * rstd * g1[6], c[7] * rstd * g1[7]}; }
}
__device__ __forceinline__ void transpose_item(const float* W, int K, int N, bf16* WT, LAS float* scr, int item, int lane) {
    const int nblk = N / 32, kb = item / nblk, nb = item % nblk, k0 = 64 * kb, n0 = 32 * nb;
#pragma unroll 8
    for (int i = 0; i < 32; ++i) { const int kk = 2 * i + (lane >> 5); scr[kk * 33 + (lane & 31)] = W[(size_t)(k0 + kk) * N + n0 + (lane & 31)]; }
    asm volatile("s_waitcnt lgkmcnt(0)" ::: "memory");
    const int c = lane & 7;
#pragma unroll
    for (int j = 0; j < 4; ++j) { const int n = (lane >> 3) + 8 * j; const LAS float* s = scr + (8 * c) * 33 + n;
        u32x4 o; o.x = pk2(s[0 * 33], s[1 * 33]); o.y = pk2(s[2 * 33], s[3 * 33]); o.z = pk2(s[4 * 33], s[5 * 33]); o.w = pk2(s[6 * 33], s[7 * 33]);
        *(u32x4*)(WT + (size_t)(n0 + n) * K + k0 + 8 * c) = o; }
    asm volatile("s_waitcnt lgkmcnt(0)" ::: "memory");
}
__device__ __forceinline__ void p0_prologue(const Args& A, LAS unsigned char* lds, int tid, int lane, int wave) {
    unsigned char* ws = A.ws;
    {
        const float* c = A.in[1]; const float* w_ada = A.in[2]; const float* b_ada = A.in[3]; float* MOD = (float*)(ws + WS_MOD);
        LAS float* cs = (LAS float*)(lds + LDS_MISC);
        for (int item = blockIdx.x; item < 384; item += gridDim.x) {
            const int kc = item / 12, cb = item % 12;
            __syncthreads();
            if (tid < 256) { const float cv = c[(tid >> 5) * D + kc * 32 + (tid & 31)]; cs[tid] = cv * sigmoidf_(cv); }
            __syncthreads();
            const int col = cb * 512 + tid;
            float acc[8];
#pragma unroll
            for (int b = 0; b < 8; ++b) acc[b] = 0.f;
#pragma unroll 4
            for (int kk = 0; kk < 32; ++kk) { const float w = w_ada[(size_t)(kc * 32 + kk) * NMOD + col];
#pragma unroll
                for (int b = 0; b < 8; ++b) acc[b] += cs[b * 32 + kk] * w; }
            const float bias = (kc == 0) ? b_ada[col] : 0.f;
#pragma unroll
            for (int b = 0; b < 8; ++b) unsafeAtomicAdd(MOD + b * NMOD + col, acc[b] + bias);
        }
        __syncthreads();
    }
    {
        LAS float* scr = (LAS float*)(lds + wave * 16384);
        const int gw = blockIdx.x * NWAVES + wave, NGW = gridDim.x * NWAVES;
        constexpr int I_IN = (D / 64) * (PT / 32), I_OUT = (D / 64) * (D / 32), I_UP = (D / 64) * (FF / 32), I_DN = (FF / 64) * (D / 32);
        for (int it = gw; it < ((CONV_UNDER_S2 && SHADOW_EXTRA) ? I_IN : I_IN + I_OUT + I_UP + I_DN); it += NGW) {
            int r = it;
            if (r < I_IN) { transpose_item(A.in[4], D, PT, (bf16*)(ws + WS_WIN), scr, r, lane); continue; } r -= I_IN;
            if (r < I_OUT) { transpose_item(A.in[17], D, D, (bf16*)(ws + WS_WOUT), scr, r, lane); continue; } r -= I_OUT;
            if (r < I_UP) { transpose_item(A.in[18], D, FF, (bf16*)(ws + WS_WUP), scr, r, lane); continue; } r -= I_UP;
            transpose_item(A.in[19], FF, D, (bf16*)(ws + WS_WDN), scr, r, lane);
        }
    }
    {
        const float* w2 = A.in[8]; const float* a2 = A.in[10]; const float* g2 = A.in[11]; bf16* LT = (bf16*)(ws + WS_LT);
        for (int idx = blockIdx.x * NTHR + tid; idx < LN * LK; idx += gridDim.x * NTHR) {
            const int n = idx >> 8, k = idx & 255; float v = 0.f;
            if (n < 512) { if (k < 64) v = w2[k * 512 + n]; }
            else if (n < 1024) { if (k >= 64 && k < 128) v = a2[(k - 64) * 512 + (n - 512)]; }
            else { if (k >= 128) v = g2[(k - 128) * 512 + (n - 1024)]; }
            LT[idx] = (bf16)(pk2(v, 0.f) & 0xffffu);
        }
    }
}

template <int R> __device__ __forceinline__ void norm_mod_rows(const float* X, bf16* O, const float* MOD, int sh_chunk, int m0, int stride, int lane) {
    f32x4 v[R][4];
#pragma unroll
    for (int r = 0; r < R; ++r) { const f32x4* xr = (const f32x4*)(X + (size_t)(m0 + r * stride) * D) + lane;
#pragma unroll
        for (int j = 0; j < 4; ++j) v[r][j] = __builtin_nontemporal_load(&xr[64 * j]); }
#pragma unroll
    for (int r = 0; r < R; ++r) { const int m = m0 + r * stride; const float* sh = MOD + (m >> 13) * NMOD + sh_chunk * D; const float* sc = sh + D;
        float s = 0.f;
#pragma unroll
        for (int j = 0; j < 4; ++j) s += (v[r][j].x * v[r][j].x + v[r][j].y * v[r][j].y) + (v[r][j].z * v[r][j].z + v[r][j].w * v[r][j].w);
        const float rstd = rsqrtf(wave_sum(s) * (1.f / D) + 1e-6f);
        bf16* orow = O + (size_t)m * D;
#pragma unroll
        for (int j = 0; j < 4; ++j) { const f32x4 a = ((const f32x4*)sc)[lane + 64 * j], b = ((const f32x4*)sh)[lane + 64 * j];
            const f32x4 h = v[r][j] * rstd * (1.f + a) + b;
            ((u32x2*)orow)[lane + 64 * j] = (u32x2){pk2(h.x, h.y), pk2(h.z, h.w)}; } }
}
template <int R> __device__ __forceinline__ void final_rows(float* X, const float* g, int m0, int stride, int lane) {
    f32x4 v[R][4];
#pragma unroll
    for (int r = 0; r < R; ++r) { const f32x4* xr = (const f32x4*)(X + (size_t)(m0 + r * stride) * D) + lane;
#pragma unroll
        for (int j = 0; j < 4; ++j) v[r][j] = xr[64 * j]; }
    f32x4 gv[4];
#pragma unroll
    for (int j = 0; j < 4; ++j) gv[j] = ((const f32x4*)g)[lane + 64 * j];
#pragma unroll
    for (int r = 0; r < R; ++r) { f32x4* xr = (f32x4*)(X + (size_t)(m0 + r * stride) * D) + lane; float s = 0.f;
#pragma unroll
        for (int j = 0; j < 4; ++j) s += (v[r][j].x * v[r][j].x + v[r][j].y * v[r][j].y) + (v[r][j].z * v[r][j].z + v[r][j].w * v[r][j].w);
        const float rstd = rsqrtf(wave_sum(s) * (1.f / D) + 1e-6f);
#pragma unroll
        for (int j = 0; j < 4; ++j) xr[64 * j] = v[r][j] * rstd * gv[j]; }
}
__device__ __forceinline__ size_t pidx(int m, int col) { return ((size_t)((m >> 8) * 13 + (col >> 8)) << 16) + (size_t)(((m & 255) << 8) + (col & 255)); }
#define PAT(mm, cc) (P + pidx((mm), (cc)))
struct ConvRegs { u32x4 bg, c0, u0, c1, u1, c2, u2; };
struct VlRegs { u32x4 vc, vp; u32x2 lc, lp; };
__device__ __forceinline__ void conv_load(ConvRegs& R, const bf16* P, int m, int lane) {
    const int tt = m & (SEQ - 1); const bool has1 = tt >= 1, has2 = tt >= 2;
    const u32x4 zero4 = (u32x4){0u, 0u, 0u, 0u}; const int ch = 8 * lane;
    R.bg = *(const u32x4*)PAT(m, ch); R.c0 = *(const u32x4*)PAT(m, 512 + ch); R.u0 = *(const u32x4*)PAT(m, 1024 + ch);
    R.c1 = has1 ? *(const u32x4*)PAT(m - 1, 512 + ch) : zero4; R.u1 = has1 ? *(const u32x4*)PAT(m - 1, 1024 + ch) : zero4;
    R.c2 = has2 ? *(const u32x4*)PAT(m - 2, 512 + ch) : zero4; R.u2 = has2 ? *(const u32x4*)PAT(m - 2, 1024 + ch) : zero4;
}
__device__ __forceinline__ void conv_compute(const Args& A, const ConvRegs& R, int m, int lane) {
    const int ch = 8 * lane; const float* cw = A.in[5];
    float bg[8], c0[8], u0[8], c1[8], u1[8], c2[8], u2[8], w0[8], w1[8], w2[8], y[8];
    unpack8(R.bg, bg); unpack8(R.c0, c0); unpack8(R.u0, u0); unpack8(R.c1, c1); unpack8(R.u1, u1); unpack8(R.c2, c2); unpack8(R.u2, u2);
    ld8f(cw + ch, w0); ld8f(cw + 512 + ch, w1); ld8f(cw + 1024 + ch, w2);
#pragma unroll
    for (int i = 0; i < 8; ++i) y[i] = bg[i] * (w0[i] * (c2[i] * u2[i]) + w1[i] * (c1[i] * u1[i]) + w2[i] * (c0[i] * u0[i]));
    __builtin_nontemporal_store(pack8(y), (u32x4*)((bf16*)(A.ws + WS_MIX) + (size_t)m * D + ch));
}
__device__ __forceinline__ void vl_load(VlRegs& R, const bf16* P, int m, int lane) {
    const int tt = m & (SEQ - 1); const bool has1 = tt >= 1;
    const u32x4 zero4 = (u32x4){0u, 0u, 0u, 0u}; const int ch = 8 * lane, c4 = 4 * lane;
    R.vc = *(const u32x4*)PAT(m, PCONV + 1024 + ch); R.lc = *(const u32x2*)PAT(m, PCONV + 1536 + c4);
    R.vp = has1 ? *(const u32x4*)PAT(m - 1, PCONV + 1024 + ch) : zero4; R.lp = has1 ? *(const u32x2*)PAT(m - 1, PCONV + 1536 + c4) : (u32x2){0u, 0u};
}
__device__ __forceinline__ void vl_compute(const Args& A, const VlRegs& R, int m, int lane) {
    unsigned char* ws = A.ws; const int ch = 8 * lane; const float* mu = A.in[6];
    {
        float cur[8], prv[8], mv[8], o[8];
        unpack8(R.vc, cur); unpack8(R.vp, prv); ld8f(mu + 1024 + ch, mv);
#pragma unroll
        for (int i = 0; i < 8; ++i) o[i] = cur[i] + (prv[i] - cur[i]) * mv[i];
        *(u32x4*)((bf16*)(ws + WS_VL) + (size_t)m * RW + ch) = pack8(o);
    }
    {
        const int c4 = 4 * lane;
        const u32x2 cw = R.lc, pw = R.lp;
        const f32x4 mv = *(const f32x4*)(mu + 1536 + c4);
        float cur[4] = {bflo(cw.x), bfhi(cw.x), bflo(cw.y), bfhi(cw.y)}, prv[4] = {bflo(pw.x), bfhi(pw.x), bflo(pw.y), bfhi(pw.y)}, o[4];
#pragma unroll
        for (int i = 0; i < 4; ++i) { const float xl = cur[i] + (prv[i] - cur[i]) * mv[i];
            const float sg = sigmoidf_(lane < 16 ? 2.0f * xl : xl);
            o[i] = lane < 16 ? (2.0f * sg - 1.0f) : (lane < 32 ? xl : sg); }
        *(u32x2*)((bf16*)(ws + WS_LA) + (size_t)m * LK + c4) = (u32x2){pk2(o[0], o[1]), pk2(o[2], o[3])};
    }
}
__device__ __forceinline__ void conv_pass(const Args& A, int w0, int nw, int lane) {
    const bf16* Pp = (const bf16*)(A.ws + WS_P); ConvRegs Ra, Rb; int m = w0;
    if (m < M) conv_load(Ra, Pp, m, lane);
    for (; m < M; m += 2 * nw) { const bool hb = m + nw < M;
        if (hb) conv_load(Rb, Pp, m + nw, lane);
        conv_compute(A, Ra, m, lane);
        if (m + 2 * nw < M) conv_load(Ra, Pp, m + 2 * nw, lane);
        if (hb) conv_compute(A, Rb, m + nw, lane); }
}
__device__ __forceinline__ void vl_pass(const Args& A, int w0, int nw, int lane) {
    const bf16* Pp = (const bf16*)(A.ws + WS_P); VlRegs Ra, Rb; int m = w0;
    if (m < M) vl_load(Ra, Pp, m, lane);
    for (; m < M; m += 2 * nw) { const bool hb = m + nw < M;
        if (hb) vl_load(Rb, Pp, m + nw, lane);
        vl_compute(A, Ra, m, lane);
        if (m + 2 * nw < M) vl_load(Ra, Pp, m + 2 * nw, lane);
        if (hb) vl_compute(A, Rb, m + nw, lane); }
}
template <int R> __device__ __forceinline__ void post_rows(const Args& A, int m0, int stride, int lane) {
    unsigned char* ws = A.ws;
    const int ch = 8 * lane;
    f32x4 y0[R], y1[R]; u32x4 rw[R], kw[R], vw[R], gw_[R];
#pragma unroll
    for (int r = 0; r < R; ++r) { const size_t off = (size_t)(m0 + r * stride) * RW + ch;
        y0[r] = *(const f32x4*)((const float*)(ws + WS_Y) + off); y1[r] = *(const f32x4*)((const float*)(ws + WS_Y) + off + 4);
        rw[r] = *(const u32x4*)((const bf16*)(ws + WS_RL) + off); kw[r] = *(const u32x4*)((const bf16*)(ws + WS_KP) + off);
        vw[r] = *(const u32x4*)((const bf16*)(ws + WS_VL) + off); gw_[r] = *(const u32x4*)((const bf16*)(ws + WS_G) + off); }
    float rk[8], lg[8], lb[8];
    ld8f(A.in[14] + ch, rk); ld8f(A.in[15] + ch, lg); ld8f(A.in[16] + ch, lb);
#pragma unroll
    for (int r = 0; r < R; ++r) {
        float y[8] = {y0[r].x, y0[r].y, y0[r].z, y0[r].w, y1[r].x, y1[r].y, y1[r].z, y1[r].w}, rr[8], kp[8], v[8], g[8], o[8];
        unpack8(rw[r], rr); unpack8(kw[r], kp); unpack8(vw[r], v); unpack8(gw_[r], g);
        float s = 0.f, bs = 0.f;
#pragma unroll
        for (int i = 0; i < 8; ++i) { s += y[i]; bs += rr[i] * kp[i] * rk[i]; }
        s = sum8(s); bs = sum8(bs);
        const float mean = s * (1.f / 64.f); float q = 0.f;
#pragma unroll
        for (int i = 0; i < 8; ++i) { y[i] -= mean; q += y[i] * y[i]; }
        q = sum8(q);
        const float rstd = rsqrtf(q * (1.f / 64.f) + 64e-5f);
#pragma unroll
        for (int i = 0; i < 8; ++i) o[i] = (y[i] * rstd * lg[i] + lb[i] + bs * v[i]) * g[i];
        *(u32x4*)((bf16*)(ws + WS_MIX) + (size_t)(m0 + r * stride) * D + 512 + ch) = pack8(o); }
}

constexpr int TC = 32, NCH = SEQ / TC;
constexpr int OPB = 5 * TC * 256 + TC * 64;
constexpr int YB_OFF = 2 * OPB, DUMP_OFF = YB_OFF + 4096;
static_assert(DUMP_OFF + 4608 <= 131072, "scan LDS");
#define SCAN_BAR() do { asm volatile("s_waitcnt lgkmcnt(0)" ::: "memory"); __builtin_amdgcn_s_barrier(); asm volatile("" ::: "memory"); } while (0)
template <int CTRL> __device__ __forceinline__ float dpp_add(float x) {
    return x + __builtin_bit_cast(float, __builtin_amdgcn_update_dpp(0, __builtin_bit_cast(int, x), CTRL, 0xf, 0xf, false));
}
__device__ __forceinline__ float rsum16(float x) { x = dpp_add<0x128>(x); x = dpp_add<0x124>(x); x = dpp_add<0x122>(x); x = dpp_add<0x121>(x); return x; }
struct ScanRegs { u32x4 rl, kp, kk, bv, vv; f32x4 d0, d1; };
__device__ __forceinline__ void st8(LAS unsigned char* p, const u32x4 w) {
    *(LAS f32x4*)p = (f32x4){bflo(w.x), bfhi(w.x), bflo(w.y), bfhi(w.y)}; *(LAS f32x4*)(p + 16) = (f32x4){bflo(w.z), bfhi(w.z), bflo(w.w), bfhi(w.w)};
}
__device__ __forceinline__ void scan_phase(unsigned char* ws, LAS unsigned char* lds, int tid, int lane, int wid) {
    const bf16* RL = (const bf16*)(ws + WS_RL); const bf16* KP = (const bf16*)(ws + WS_KP); const bf16* KK = (const bf16*)(ws + WS_KK);
    const bf16* BV = (const bf16*)(ws + WS_BV); const bf16* VL = (const bf16*)(ws + WS_VL); const float* DEC = (const float*)(ws + WS_DEC);
    float* Y = (float*)(ws + WS_Y);
    for (int item = blockIdx.x; item < 256; item += gridDim.x) {
        const int xcd = item & 7, slot = item >> 3, bh = xcd * 8 + (slot >> 2), q = slot & 3, b = bh >> 3, h = bh & 7;
        const size_t rowbase = (size_t)b * SEQ;
        const bool loader = wid >= 4;
        const int L = tid - 256;
        const int lt = L >> 3, lc = (L & 7) * 8;
        ScanRegs R;
#define SCAN_ISSUE(cc) do { const size_t o_ = (rowbase + (size_t)(cc) * TC + lt) * RW + h * 64 + lc; \
            R.rl = *(const u32x4*)(RL + o_); R.kp = *(const u32x4*)(KP + o_); R.kk = *(const u32x4*)(KK + o_); R.bv = *(const u32x4*)(BV + o_); \
            R.d0 = *(const f32x4*)(DEC + o_); R.d1 = *(const f32x4*)(DEC + o_ + 4); \
            if (wid == 4) R.vv = *(const u32x4*)(VL + (rowbase + (size_t)(cc) * TC + (lane >> 1)) * RW + h * 64 + q * 16 + (lane & 1) * 8); } while (0)
#define SCAN_WRITE(buf) do { LAS unsigned char* ob_ = lds + (buf) * OPB + lt * 256 + lc * 4; \
            st8(ob_ + 0 * TC * 256, R.rl); *(LAS f32x4*)(ob_ + 1 * TC * 256) = R.d0; *(LAS f32x4*)(ob_ + 1 * TC * 256 + 16) = R.d1; \
            st8(ob_ + 2 * TC * 256, R.kp); st8(ob_ + 3 * TC * 256, R.kk); st8(ob_ + 4 * TC * 256, R.bv); \
            if (wid == 4) st8(lds + (buf) * OPB + 5 * TC * 256 + (lane >> 1) * 64 + (lane & 1) * 32, R.vv); } while (0)
#define SCAN_FLUSH(cc) do { if (L < 128) { const f32x4 yv_ = *(LAS const f32x4*)(lds + YB_OFF + ((cc) & 1) * 2048 + (L >> 2) * 64 + (L & 3) * 16); \
            *(f32x4*)(Y + (rowbase + (size_t)(cc) * TC + (L >> 2)) * RW + h * 64 + q * 16 + (L & 3) * 4) = yv_; } } while (0)
        const int rg = lane >> 4, cl = lane & 15, rb = (wid & 3) * 4 + rg;
        f32x2 S01 = (f32x2){0.f, 0.f}, S23 = (f32x2){0.f, 0.f};
        const unsigned opoff = cl * 16, voff = 5 * TC * 256 + rb * 4;
        const unsigned ybase = (cl == 0) ? (unsigned)(YB_OFF + rb * 4) : (unsigned)(DUMP_OFF + lane * 4);
        if (loader) { SCAN_ISSUE(0); SCAN_WRITE(0); SCAN_ISSUE(1); }
        SCAN_BAR();
        for (int c = 0; c < NCH; ++c) {
            if (!loader) {
                LAS const unsigned char* ob = lds + (c & 1) * OPB;
                LAS unsigned char* yb = lds + ybase + (c & 1) * 2048;
                f32x4 r_[3], w_[3], k_[3], a_[3], b_[3]; float v_[3];
#define SCAN_LD(st, tt) do { r_[st] = *(LAS const f32x4*)(ob + opoff + (0 * TC + (tt)) * 256); w_[st] = *(LAS const f32x4*)(ob + opoff + (1 * TC + (tt)) * 256); \
                    k_[st] = *(LAS const f32x4*)(ob + opoff + (2 * TC + (tt)) * 256); a_[st] = *(LAS const f32x4*)(ob + opoff + (3 * TC + (tt)) * 256); \
                    b_[st] = *(LAS const f32x4*)(ob + opoff + (4 * TC + (tt)) * 256); v_[st] = *(LAS const float*)(ob + voff + (tt) * 64); } while (0)
                SCAN_LD(0, 0); SCAN_LD(1, 1);
#pragma unroll
                for (int t = 0; t < TC; ++t) {
                    const int st = t % 3;
                    if (t + 2 < TC) SCAN_LD((t + 2) % 3, t + 2);
                    const f32x4 r = r_[st], w = w_[st], k = k_[st], a = a_[st], bb = b_[st]; const float v = v_[st];
                    const f32x2 sp2 = S01 * (f32x2){a.x, a.y} + S23 * (f32x2){a.z, a.w};
                    const float sa = rsum16(sp2.x + sp2.y);
                    const f32x2 vv = (f32x2){v, v}, nsa = (f32x2){-sa, -sa};
                    const f32x2 t01 = vv * (f32x2){k.x, k.y} + nsa * (f32x2){bb.x, bb.y};
                    const f32x2 t23 = vv * (f32x2){k.z, k.w} + nsa * (f32x2){bb.z, bb.w};
                    S01 = S01 * (f32x2){w.x, w.y} + t01;
                    S23 = S23 * (f32x2){w.z, w.w} + t23;
                    const f32x2 yp2 = S01 * (f32x2){r.x, r.y} + S23 * (f32x2){r.z, r.w};
                    const float yv = rsum16(yp2.x + yp2.y);
                    *(LAS float*)(yb + t * 64) = yv;
                }
#undef SCAN_LD
            } else {
                if (c + 1 < NCH) SCAN_WRITE((c + 1) & 1);
                if (c + 2 < NCH) SCAN_ISSUE(c + 2);
                if (c >= 1) SCAN_FLUSH(c - 1);
            }
            SCAN_BAR();
        }
        if (loader) SCAN_FLUSH(NCH - 1);
        SCAN_BAR();
#undef SCAN_ISSUE
#undef SCAN_WRITE
#undef SCAN_FLUSH
    }
}

#ifndef SCAN_CHUNKED
#define SCAN_CHUNKED 1
#endif
constexpr size_t WS_AH = 768 * MiB  , WS_NN = 992 * MiB, WS_MA = 832 * MiB;
constexpr size_t OUT_BK = 0, OUT_PC = 128 * MiB, OUT_RT = 160 * MiB;
constexpr int S1_XA = 0, S1_XB = 2304, S1_XK = 4608, S1_XR = 6912, S1_AHL = 9216, S1_NABT = 11520, S1_TT = 12544, S1_NAK = 13824, S1_WAVE = 15360;
typedef short bf16x8 __attribute__((ext_vector_type(8)));
__device__ __forceinline__ float bf2f(unsigned short v) { return __uint_as_float(((unsigned)v) << 16); }
__device__ __forceinline__ unsigned short f2bf1(float f) { return (unsigned short)(pk2(f, 0.f) & 0xffffu); }
__device__ __forceinline__ bf16x8 mk8(unsigned a, unsigned b, unsigned c, unsigned d) { return __builtin_bit_cast(bf16x8, (u32x4){a, b, c, d}); }
#define MFMA16(a, b, c) __builtin_amdgcn_mfma_f32_16x16x32_bf16((a), (b), (c), 0, 0, 0)

__device__ __forceinline__ void s1_item(unsigned char* ws, unsigned char* outb, const float* rkp, const float* kap, const float* mup, const float* kkp, LAS unsigned char* wl, int ci, int lane) {
    const int bh = ci >> 9, c = ci & 511, b = bh >> 3, h = bh & 7;
    const size_t goff = ((size_t)b * SEQ + (size_t)c * 16) * RW + h * 64 + lane;
    const bf16* LW = (const bf16*)(ws + WS_DEC); const bf16* AVg = (const bf16*)(ws + WS_KP); const bf16* Pg = (const bf16*)(ws + WS_P);
    const int m0 = b * SEQ + c * 16, colr = PCONV + h * 64 + lane, colk = colr + 512;
    float lw[16]; unsigned short a_[16], pr_[17], pk_[17];
#pragma unroll
    for (int t = 0; t < 16; ++t) { const size_t o = goff + (size_t)t * RW; lw[t] = bf2f(LW[o]); a_[t] = AVg[o]; pr_[t + 1] = Pg[pidx(m0 + t, colr)]; pk_[t + 1] = Pg[pidx(m0 + t, colk)]; }
    if (c > 0) { pr_[0] = Pg[pidx(m0 - 1, colr)]; pk_[0] = Pg[pidx(m0 - 1, colk)]; } else { pr_[0] = 0; pk_[0] = 0; }
    const float mur = mup[h * 64 + lane], muk = mup[512 + h * 64 + lane], kkc = kkp[h * 64 + lane];
    float rv[16], kv[16], kkn[16];
#pragma unroll
    for (int t = 0; t < 16; ++t) { const float rc = bf2f(pr_[t + 1]), rp = bf2f(pr_[t]), kc = bf2f(pk_[t + 1]), kp0 = bf2f(pk_[t]);
        rv[t] = rc + (rp - rc) * mur; kv[t] = kc + (kp0 - kc) * muk; const float kx = kv[t] * kkc; kkn[t] = kx; }
#pragma unroll
    for (int t = 0; t < 16; ++t) { float ss = rsum16(kkn[t] * kkn[t]);
        { const int si_ = __builtin_bit_cast(int, ss);
          ss = __builtin_bit_cast(float, __builtin_amdgcn_readlane(si_, 0)) + __builtin_bit_cast(float, __builtin_amdgcn_readlane(si_, 16)) + __builtin_bit_cast(float, __builtin_amdgcn_readlane(si_, 32)) + __builtin_bit_cast(float, __builtin_amdgcn_readlane(si_, 48)); }
        kkn[t] *= 1.0f / fmaxf(sqrtf(ss), 1e-12f); }
    float lp[16]; { float acc = 0.f;
#pragma unroll
        for (int t = 0; t < 16; ++t) { acc += lw[t]; lp[t] = acc; } }
    const float lpc = lp[15];
    float At[16], Bh[16], Kh[16];
    const float rkh = rkp[h * 64 + lane], kah = kap[h * 64 + lane];
#pragma unroll
    for (int t = 0; t < 16; ++t) {
        const float P = __expf(lp[t]), Pm1 = __expf(lp[t] - lw[t]), iP = __expf(-lp[t]), PcP = __expf(lpc - lp[t]);
        const float kkf = kkn[t], af_ = bf2f(a_[t]), bvf = kkf * af_, kpf = kv[t] * (1.0f + (af_ - 1.0f) * kah), rf = rv[t];
        At[t] = -kkf * Pm1; Bh[t] = bvf * PcP; Kh[t] = kpf * PcP;
        *(LAS unsigned short*)(wl + S1_XA + t * 144 + lane * 2) = f2bf1(At[t]);
        *(LAS unsigned short*)(wl + S1_XB + t * 144 + lane * 2) = f2bf1(bvf * iP);
        *(LAS unsigned short*)(wl + S1_XK + t * 144 + lane * 2) = f2bf1(kpf * iP);
        *(LAS unsigned short*)(wl + S1_XR + t * 144 + lane * 2) = f2bf1(rf * P);
        *(LAS unsigned short*)(wl + S1_AHL + t * 144 + lane * 2) = f2bf1(rf * P * rkh);
    }
    const int m = lane & 15, q = lane >> 4;
    bf16x8 fa[2], fb[2], fk[2], fr[2];
#pragma unroll
    for (int ks = 0; ks < 2; ++ks) { const int o = m * 144 + (8 * q + 32 * ks) * 2;
        fa[ks] = *(LAS const bf16x8*)(wl + S1_XA + o); fb[ks] = *(LAS const bf16x8*)(wl + S1_XB + o);
        fk[ks] = *(LAS const bf16x8*)(wl + S1_XK + o); fr[ks] = *(LAS const bf16x8*)(wl + S1_XR + o); }
    const f32x4 z4 = (f32x4){0.f, 0.f, 0.f, 0.f};
    f32x4 nab = MFMA16(fb[0], fa[0], z4); nab = MFMA16(fb[1], fa[1], nab);
    f32x4 nak = MFMA16(fk[0], fa[0], z4); nak = MFMA16(fk[1], fa[1], nak);
    f32x4 nbr = MFMA16(fb[0], fr[0], z4); nbr = MFMA16(fb[1], fr[1], nbr);
    f32x4 nkr = MFMA16(fk[0], fr[0], z4); nkr = MFMA16(fk[1], fr[1], nkr);
    {
        bf16x8 frk0 = *(LAS const bf16x8*)(wl + S1_AHL + m * 144 + (8 * q) * 2), frk1 = *(LAS const bf16x8*)(wl + S1_AHL + m * 144 + (8 * q + 32) * 2);
        f32x4 cb = MFMA16(fk[0], frk0, z4); cb = MFMA16(fk[1], frk1, cb);
        const float cd = (m & 3) == 0 ? cb[0] : ((m & 3) == 1 ? cb[1] : ((m & 3) == 2 ? cb[2] : cb[3]));
        if (q == (m >> 2)) ((float*)(outb + OUT_PC))[(size_t)ci * 256 + 64 + m] = cd;
        asm volatile("s_waitcnt lgkmcnt(0)" ::: "memory");
    }
#pragma unroll
    for (int i = 0; i < 4; ++i) { const int s = 4 * q + i;
        nab[i] = (s < m) ? nab[i] : 0.f; nak[i] = (s < m) ? nak[i] : 0.f; nbr[i] = (s <= m) ? nbr[i] : 0.f; nkr[i] = (s <= m) ? nkr[i] : 0.f; }
    *(u32x4*)((bf16*)(ws + WS_NN) + (size_t)ci * 512 + lane * 8) = (u32x4){pk2(nbr[0], nbr[1]), pk2(nbr[2], nbr[3]), pk2(nkr[0], nkr[1]), pk2(nkr[2], nkr[3])};
    *(LAS f32x4*)(wl + S1_NABT + m * 64 + q * 16) = nab;
#pragma unroll
    for (int i = 0; i < 4; ++i) *(LAS float*)(wl + S1_NAK + (4 * q + i) * 64 + m * 4) = nak[i];
    float Tr[16];
#pragma unroll
    for (int t = 0; t < 16; ++t) {
        float acc = (m == t) ? 1.f : 0.f;
#pragma unroll
        for (int j4 = 0; j4 < (t + 3) / 4; ++j4) { const f32x4 nv = *(LAS const f32x4*)(wl + S1_NABT + t * 64 + j4 * 16);
#pragma unroll
            for (int jj = 0; jj < 4; ++jj) if (4 * j4 + jj < t) acc += Tr[4 * j4 + jj] * nv[jj]; }
        Tr[t] = acc;
        *(LAS float*)(wl + S1_TT + t * 80 + m * 4) = acc;
    }
#pragma unroll
    for (int t = 0; t < 16; ++t) {
        float acc = 0.f;
#pragma unroll
        for (int s4 = 0; s4 < t / 4 + 1; ++s4) { const f32x4 tv = *(LAS const f32x4*)(wl + S1_TT + t * 80 + s4 * 16);
#pragma unroll
            for (int ss = 0; ss < 4; ++ss) if (4 * s4 + ss <= t) acc += tv[ss] * At[4 * s4 + ss]; }
        *(LAS unsigned short*)(wl + S1_AHL + t * 144 + lane * 2) = f2bf1(acc);
    }
    {
        f32x4 tt[4];
#pragma unroll
        for (int s4 = 0; s4 < 4; ++s4) tt[s4] = *(LAS const f32x4*)(wl + S1_TT + m * 80 + s4 * 16);
        float mak[4];
#pragma unroll
        for (int i = 0; i < 4; ++i) { float acc = 0.f;
#pragma unroll
            for (int s4 = 0; s4 < 4; ++s4) { const f32x4 nv = *(LAS const f32x4*)(wl + S1_NAK + (4 * q + i) * 64 + s4 * 16);
                acc += tt[s4][0] * nv[0] + tt[s4][1] * nv[1] + tt[s4][2] * nv[2] + tt[s4][3] * nv[3]; }
            mak[i] = acc; }
        *(u32x4*)((bf16*)(ws + WS_MA) + (size_t)ci * 512 + lane * 8) = (u32x4){0u, 0u, pk2(mak[0], mak[1]), pk2(mak[2], mak[3])};
    }
#pragma unroll
    for (int hh = 0; hh < 2; ++hh) {
        const int o = m * 144 + (32 * hh + 4 * q) * 2;
        const u32x2 alo = *(LAS const u32x2*)(wl + S1_AHL + o), ahi = *(LAS const u32x2*)(wl + S1_AHL + o + 32);
        const u32x2 rlo = *(LAS const u32x2*)(wl + S1_XR + o), rhi = *(LAS const u32x2*)(wl + S1_XR + o + 32);
        *(u32x4*)((bf16*)(ws + WS_AH) + (size_t)ci * 1024 + (hh * 64 + lane) * 8) = (u32x4){alo.x, alo.y, ahi.x, ahi.y};
        *(u32x4*)((bf16*)(outb + OUT_RT) + (size_t)ci * 1024 + (hh * 64 + lane) * 8) = (u32x4){rlo.x, rlo.y, rhi.x, rhi.y};
    }
    {
        bf16* BKg = (bf16*)(outb + OUT_BK) + (size_t)ci * 2048; const int kt = lane >> 4, mm = lane & 15;
#pragma unroll
        for (int qq = 0; qq < 4; ++qq)
            *(u32x4*)(BKg + (kt * 64 + mm + 16 * qq) * 8) = (u32x4){pk2(Bh[4 * qq], Bh[4 * qq + 1]), pk2(Bh[4 * qq + 2], Bh[4 * qq + 3]), pk2(Kh[4 * qq], Kh[4 * qq + 1]), pk2(Kh[4 * qq + 2], Kh[4 * qq + 3])};
        ((float*)(outb + OUT_PC))[(size_t)ci * 256 + lane] = __expf(lpc);
    }
    asm volatile("s_waitcnt lgkmcnt(0)" ::: "memory");
}

constexpr int S2_SLOT = 15360, S2_D = 5, S2_NS = S2_D + 2;
constexpr int SO_AH = 0, SO_RT = 2048, SO_MA = 4096, SO_NN = 5120, SO_BK = 6144, SO_V = 10240, SO_PC = 12288, SO_G = 13312;
static_assert(S2_NS * S2_SLOT <= 131072, "S2 ring");
struct S2Ops { bf16x8 ah0, ah1, rt0, rt1, ma, nn, bk0, bk1, bk2, bk3; f32x4 pc0, pc1, pc2, pc3; unsigned vm01, vm23; };
#define S2_DMA(gptr, loff) __builtin_amdgcn_global_load_lds((const unsigned*)(gptr), (LAS unsigned*)(slot_ + (loff)), 16, 0, 2)
#ifndef S2_POST
#define S2_POST 1
#endif
constexpr int S2_YB = S2_NS * S2_SLOT;
static_assert(S2_YB + 8192 <= 131072, "S2 LDS");
__device__ __forceinline__ void s2_phase(unsigned char* ws, unsigned char* outb, const float* rk_, const float* lg_, const float* lb_, LAS unsigned char* lds, int tid, int lane, int wid) {
    const bf16* AHg = (const bf16*)(ws + WS_AH); const bf16* RTg = (const bf16*)(outb + OUT_RT); const bf16* MAg = (const bf16*)(ws + WS_MA); const bf16* NNg = (const bf16*)(ws + WS_NN);
    const bf16* BKg = (const bf16*)(outb + OUT_BK); const float* PCg = (const float*)(outb + OUT_PC); const bf16* VLg = (const bf16*)(ws + WS_VL);
    const bf16* GGg = (const bf16*)(ws + WS_G);
    for (int bh = blockIdx.x; bh < 64; bh += gridDim.x) {
        const int b = bh >> 3, h = bh & 7; const size_t rowbase = (size_t)b * SEQ;
        const int q = lane >> 4, n = lane & 15;
        if (wid == 4 || wid == 5) {
            const int lw = wid - 4;
#define S2_ISSUE(cc) do { LAS unsigned char* slot_ = lds + ((cc) % S2_NS) * S2_SLOT; const size_t ci_ = (size_t)bh * 512 + (cc); \
                if (lw == 0) { S2_DMA(AHg + ci_ * 1024 + lane * 8, SO_AH); S2_DMA(AHg + ci_ * 1024 + 512 + lane * 8, SO_AH + 1024); \
                    S2_DMA(RTg + ci_ * 1024 + lane * 8, SO_RT); S2_DMA(RTg + ci_ * 1024 + 512 + lane * 8, SO_RT + 1024); \
                    S2_DMA(MAg + ci_ * 512 + lane * 8, SO_MA); S2_DMA(NNg + ci_ * 512 + lane * 8, SO_NN); \
                    S2_DMA(GGg + (rowbase + (size_t)(cc) * 16 + (lane >> 3)) * RW + h * 64 + (lane & 7) * 8, SO_G); \
                    S2_DMA(GGg + (rowbase + (size_t)(cc) * 16 + 8 + (lane >> 3)) * RW + h * 64 + (lane & 7) * 8, SO_G + 1024); } \
                else { S2_DMA(BKg + ci_ * 2048 + lane * 8, SO_BK); S2_DMA(BKg + ci_ * 2048 + 512 + lane * 8, SO_BK + 1024); \
                    S2_DMA(BKg + ci_ * 2048 + 1024 + lane * 8, SO_BK + 2048); S2_DMA(BKg + ci_ * 2048 + 1536 + lane * 8, SO_BK + 3072); \
                    S2_DMA(VLg + (rowbase + (size_t)(cc) * 16 + (lane >> 3)) * RW + h * 64 + (lane & 7) * 8, SO_V); \
                    S2_DMA(VLg + (rowbase + (size_t)(cc) * 16 + 8 + (lane >> 3)) * RW + h * 64 + (lane & 7) * 8, SO_V + 1024); \
                    S2_DMA(PCg + ci_ * 256 + lane * 4, SO_PC); } } while (0)
#define S2_WAIT() do { if (lw == 1) asm volatile("s_waitcnt vmcnt(21)" ::: "memory"); else asm volatile("s_waitcnt vmcnt(24)" ::: "memory"); } while (0)
#pragma unroll 1
            for (int cc = 0; cc < S2_D; ++cc) S2_ISSUE(cc);
            S2_WAIT(); __builtin_amdgcn_s_barrier(); asm volatile("" ::: "memory");
#pragma unroll 1
            for (int i = 0; i < 512; ++i) {
                if (i + S2_D < 512) { S2_ISSUE(i + S2_D); S2_WAIT(); } else asm volatile("s_waitcnt vmcnt(0)" ::: "memory");
                __builtin_amdgcn_s_barrier(); asm volatile("" ::: "memory");
            }
#undef S2_ISSUE
#undef S2_WAIT
        } else if (wid >= 6) {
            const int L = (wid - 6) * 64 + lane, pt = L >> 3, c8 = (L & 7) * 8;
            bf16* MIXg = (bf16*)(ws + WS_MIX);
            float lg[8], lb[8]; ld8f(lg_ + h * 64 + c8, lg); ld8f(lb_ + h * 64 + c8, lb);
#define S2P_PROC(cc) do { LAS const unsigned char* yb_ = lds + S2_YB + ((cc) & 1) * 4096 + pt * 256 + c8 * 4; LAS const unsigned char* sl_ = lds + ((cc) % S2_NS) * S2_SLOT; \
                const f32x4 ya_ = *(LAS const f32x4*)yb_, yb2_ = *(LAS const f32x4*)(yb_ + 16); \
                const u32x4 vw_ = *(LAS const u32x4*)(sl_ + SO_V + pt * 128 + c8 * 2); const u32x4 gw__ = *(LAS const u32x4*)(sl_ + SO_G + pt * 128 + c8 * 2); \
                const float bs_ = *(LAS const float*)(sl_ + SO_PC + (64 + pt) * 4); \
                float y_[8] = {ya_.x, ya_.y, ya_.z, ya_.w, yb2_.x, yb2_.y, yb2_.z, yb2_.w}, v_[8], g_[8], o_[8]; \
                unpack8(vw_, v_); unpack8(gw__, g_); \
                float s_ = 0.f; \
                _Pragma("unroll") for (int i_ = 0; i_ < 8; ++i_) s_ += y_[i_]; \
                s_ = dpp_add<0xB1>(s_); s_ = dpp_add<0x4E>(s_); s_ = dpp_add<0x141>(s_); \
                const float mean_ = s_ * (1.f / 64.f); float q_ = 0.f; \
                _Pragma("unroll") for (int i_ = 0; i_ < 8; ++i_) { y_[i_] -= mean_; q_ += y_[i_] * y_[i_]; } \
                q_ = dpp_add<0xB1>(q_); q_ = dpp_add<0x4E>(q_); q_ = dpp_add<0x141>(q_); \
                const float rstd_ = rsqrtf(q_ * (1.f / 64.f) + 64e-5f); \
                _Pragma("unroll") for (int i_ = 0; i_ < 8; ++i_) o_[i_] = (y_[i_] * rstd_ * lg[i_] + lb[i_] + bs_ * v_[i_]) * g_[i_]; \
                *(u32x4*)(MIXg + (rowbase + (size_t)(cc) * 16 + pt) * D + 512 + h * 64 + c8) = pack8(o_); } while (0)
            __builtin_amdgcn_s_barrier(); asm volatile("" ::: "memory");
#pragma unroll 1
            for (int jj = 0; jj < 512; ++jj) {
                if (jj >= 1) S2P_PROC(jj - 1);
                asm volatile("s_waitcnt lgkmcnt(0)" ::: "memory"); __builtin_amdgcn_s_barrier(); asm volatile("" ::: "memory");
            }
            S2P_PROC(511);
#undef S2P_PROC
        } else {
            const int vq = wid;
            __builtin_amdgcn_s_setprio(3);
            f32x4 ST0 = (f32x4){0.f, 0.f, 0.f, 0.f}, ST1 = ST0, ST2 = ST0, ST3 = ST0;
            const f32x4 z4 = ST0;
            S2Ops A_, B_;
#define S2_LOAD(O, cc) do { LAS const unsigned char* sb_ = lds + ((cc) % S2_NS) * S2_SLOT; \
                O.ah0 = *(LAS const bf16x8*)(sb_ + SO_AH + lane * 16); O.ah1 = *(LAS const bf16x8*)(sb_ + SO_AH + 1024 + lane * 16); \
                O.rt0 = *(LAS const bf16x8*)(sb_ + SO_RT + lane * 16); O.rt1 = *(LAS const bf16x8*)(sb_ + SO_RT + 1024 + lane * 16); \
                O.ma = *(LAS const bf16x8*)(sb_ + SO_MA + lane * 16); O.nn = *(LAS const bf16x8*)(sb_ + SO_NN + lane * 16); \
                O.bk0 = *(LAS const bf16x8*)(sb_ + SO_BK + lane * 16); O.bk1 = *(LAS const bf16x8*)(sb_ + SO_BK + 1024 + lane * 16); \
                O.bk2 = *(LAS const bf16x8*)(sb_ + SO_BK + 2048 + lane * 16); O.bk3 = *(LAS const bf16x8*)(sb_ + SO_BK + 3072 + lane * 16); \
                O.pc0 = *(LAS const f32x4*)(sb_ + SO_PC + (0 + 4 * q) * 4); O.pc1 = *(LAS const f32x4*)(sb_ + SO_PC + (16 + 4 * q) * 4); \
                O.pc2 = *(LAS const f32x4*)(sb_ + SO_PC + (32 + 4 * q) * 4); O.pc3 = *(LAS const f32x4*)(sb_ + SO_PC + (48 + 4 * q) * 4); \
                { const LAS unsigned short* vp_ = (const LAS unsigned short*)(sb_ + SO_V + (4 * q) * 128 + (16 * vq + n) * 2); \
                  O.vm01 = (unsigned)vp_[0] | ((unsigned)vp_[64] << 16); O.vm23 = (unsigned)vp_[128] | ((unsigned)vp_[192] << 16); } } while (0)
#define S2_STEP(O, cc) do { \
                const bf16x8 bs0_ = mk8(pk2(ST0[0], ST0[1]), pk2(ST0[2], ST0[3]), pk2(ST1[0], ST1[1]), pk2(ST1[2], ST1[3])); \
                const bf16x8 bs1_ = mk8(pk2(ST2[0], ST2[1]), pk2(ST2[2], ST2[3]), pk2(ST3[0], ST3[1]), pk2(ST3[2], ST3[3])); \
                const bf16x8 vb_ = mk8(0u, 0u, O.vm01, O.vm23); \
                f32x4 ut_ = MFMA16(O.ma, vb_, z4); ut_ = MFMA16(O.ah0, bs0_, ut_); ut_ = MFMA16(O.ah1, bs1_, ut_);     \
                const bf16x8 uv_ = mk8(pk2(ut_[0], ut_[1]), pk2(ut_[2], ut_[3]), O.vm01, O.vm23); \
                f32x4 yt_ = MFMA16(O.rt0, bs0_, z4); yt_ = MFMA16(O.rt1, bs1_, yt_); yt_ = MFMA16(O.nn, uv_, yt_); \
                ST0 = MFMA16(O.bk0, uv_, O.pc0 * ST0); ST1 = MFMA16(O.bk1, uv_, O.pc1 * ST1); ST2 = MFMA16(O.bk2, uv_, O.pc2 * ST2); ST3 = MFMA16(O.bk3, uv_, O.pc3 * ST3); \
                LAS float* yp_ = (LAS float*)(lds + S2_YB + ((cc) & 1) * 4096 + (4 * q) * 256 + (16 * vq + n) * 4); \
                yp_[0] = yt_[0]; yp_[64] = yt_[1]; yp_[128] = yt_[2]; yp_[192] = yt_[3]; } while (0)
            __builtin_amdgcn_s_barrier(); asm volatile("" ::: "memory");
            S2_LOAD(A_, 0);
#pragma unroll 1
            for (int i = 0; i < 512; i += 2) {
                S2_LOAD(B_, i + 1); __builtin_amdgcn_sched_barrier(0);
                S2_STEP(A_, i);
                asm volatile("s_waitcnt lgkmcnt(0)" ::: "memory"); __builtin_amdgcn_s_barrier(); asm volatile("" ::: "memory");
                if (i + 2 < 512) S2_LOAD(A_, i + 2);
                __builtin_amdgcn_sched_barrier(0);
                S2_STEP(B_, i + 1);
                asm volatile("s_waitcnt lgkmcnt(0)" ::: "memory"); __builtin_amdgcn_s_barrier(); asm volatile("" ::: "memory");
            }
#undef S2_LOAD
#undef S2_STEP
        }
        __builtin_amdgcn_s_barrier(); asm volatile("" ::: "memory");
    }
}

#ifndef STAGGER
#define STAGGER 0
#endif
__device__ __forceinline__ void stagger_start(unsigned step_ticks) {
#if STAGGER
    const unsigned ticks = ((blockIdx.x >> 3) & 7u) * step_ticks;
    const unsigned long long t0 = __builtin_amdgcn_s_memrealtime();
    while ((unsigned)(__builtin_amdgcn_s_memrealtime() - t0) < ticks) __builtin_amdgcn_s_sleep(16);
#endif
}
__device__ __forceinline__ void shadow_work(const Args& A, LAS unsigned char* lds, int w0, int nw, int lane, int wave) {
    unsigned char* ws = A.ws;
    LAS float* scr = (LAS float*)(lds + wave * 16384);
    constexpr int I_OUT = (D / 64) * (D / 32), I_UP = (D / 64) * (FF / 32), I_DN = (FF / 64) * (D / 32);
    for (int it = w0; it < I_OUT + I_UP + I_DN; it += nw) {
        int r = it;
        if (r < I_OUT) { transpose_item(A.in[17], D, D, (bf16*)(ws + WS_WOUT), scr, r, lane); continue; } r -= I_OUT;
        if (r < I_UP) { transpose_item(A.in[18], D, FF, (bf16*)(ws + WS_WUP), scr, r, lane); continue; } r -= I_UP;
        transpose_item(A.in[19], FF, D, (bf16*)(ws + WS_WDN), scr, r, lane);
    }
    const float* MOD = (const float*)(ws + WS_MOD); const float* wup = A.in[18]; float* B2 = (float*)(ws + WS_BIAS2);
    for (int it = w0; it < 64 * 32; it += nw) {
        const int n = (it >> 5) * 64 + lane, k0 = (it & 31) * 32;
        float acc[8];
#pragma unroll
        for (int b = 0; b < 8; ++b) acc[b] = 0.f;
#pragma unroll 16
        for (int k = k0; k < k0 + 32; ++k) { const float w = wup[(size_t)k * FF + n];
#pragma unroll
            for (int b = 0; b < 8; ++b) acc[b] += MOD[b * NMOD + 3 * D + k] * w; }
#pragma unroll
        for (int b = 0; b < 8; ++b) unsafeAtomicAdd(B2 + b * FF + n, acc[b]);
    }
}
#define XB_TMO      128
#define XB_XCNT(j)  (256  + 64 * (j))
#define XB_XSUB(j)  (1280 + 64 * (j))
#define XB_XGEN(j)  (2304 + 64 * (j))
#define XB_TOP      3328
#define XB_TOPGEN   3392
#define XCD_BAR_WORDS 3456
#define XB_SPIN_CAP (1u << 18)

__device__ __forceinline__ unsigned xb_ld(unsigned* p)              { return __hip_atomic_load(p, __ATOMIC_RELAXED, __HIP_MEMORY_SCOPE_AGENT); }
__device__ __forceinline__ unsigned xb_add(unsigned* p, unsigned v) { return __hip_atomic_fetch_add(p, v, __ATOMIC_RELAXED, __HIP_MEMORY_SCOPE_AGENT); }
__device__ __forceinline__ unsigned xb_xcc_id() { return (unsigned)__builtin_amdgcn_s_getreg((3 << 11) | 20) & 0xFu; }
#define XB_SPIN(cond, bar) do { unsigned _sp = 0; while (cond) { __builtin_amdgcn_s_sleep(1); \
    if ((++_sp & 255u) == 0u) { if (xb_ld(&(bar)[XB_TMO])) break; if (_sp > XB_SPIN_CAP) { atomicAdd(&(bar)[XB_TMO], 1u); break; } } } } while (0)

struct XcdBarrier {
    unsigned* bar; unsigned x;
    volatile LAS unsigned* st;
};

__device__ __forceinline__ XcdBarrier xcd_barrier_post(unsigned* bar, volatile LAS unsigned* st) {
    XcdBarrier b; b.bar = bar; b.x = xb_xcc_id(); b.st = st;
    if (threadIdx.x == 0) (void)xb_add(&bar[XB_XCNT(b.x)], 1u);
    return b;
}
__device__ __forceinline__ void xcd_barrier_complete(unsigned* bar, unsigned x, unsigned& nloc, unsigned& nx) {
    const unsigned G = gridDim.x * gridDim.y * gridDim.z;
    unsigned sum, cnt, mine, sp = 0u;
    for (;;) {
        sum = 0u; cnt = 0u; mine = 0u;
#pragma unroll
        for (unsigned j = 0; j < 16; ++j) { const unsigned c = xb_ld(&bar[XB_XCNT(j)]); sum += c; cnt += (c > 0u) ? 1u : 0u; mine = (j == x) ? c : mine; }
        if (sum == G) break;
        __builtin_amdgcn_s_sleep(1);
        if ((++sp & 255u) == 0u) { if (xb_ld(&bar[XB_TMO])) break; if (sp > XB_SPIN_CAP) { atomicAdd(&bar[XB_TMO], 1u); break; } }
    }
    nloc = mine > 0u ? mine : 1u; nx = cnt > 0u ? cnt : 1u;
}

__device__ __forceinline__ void xcd_barrier(const XcdBarrier& b) {
    asm volatile("s_waitcnt vmcnt(0)" ::: "memory");
    __syncthreads();
    if (threadIdx.x == 0) {
        unsigned* bar = b.bar;
        __builtin_amdgcn_s_waitcnt(0);
        unsigned nloc = b.st[0], nx = b.st[1];
        if (nloc == 0u) { xcd_barrier_complete(bar, b.x, nloc, nx); b.st[0] = nloc; b.st[1] = nx; }
        const unsigned old = xb_add(&bar[XB_XSUB(b.x)], 1u);
        const unsigned gen = old / nloc;
        if (old + 1u == (gen + 1u) * nloc) {
            __builtin_amdgcn_fence(__ATOMIC_RELEASE, "agent");
            asm volatile("s_waitcnt vmcnt(0)" ::: "memory");
            const unsigned og = xb_add(&bar[XB_TOP], 1u);
            const unsigned tg = og / nx;
            if (og + 1u == (tg + 1u) * nx) xb_add(&bar[XB_TOPGEN], 1u);
            else XB_SPIN(xb_ld(&bar[XB_TOPGEN]) == tg, bar);
            __builtin_amdgcn_fence(__ATOMIC_ACQUIRE, "agent");
            xb_add(&bar[XB_XGEN(b.x)], 1u);
            asm volatile("s_waitcnt vmcnt(0)" ::: "memory");
        } else {
            XB_SPIN(xb_ld(&bar[XB_XGEN(b.x)]) == gen, bar);
            __builtin_amdgcn_fence(__ATOMIC_ACQUIRE, "agent");
            asm volatile("s_waitcnt vmcnt(0)" ::: "memory");
        }
    }
    __syncthreads();
}

constexpr size_t WS_BAR = 896 * 1024;
#ifndef STAGGER2
#define STAGGER2 0
#endif
__device__ __forceinline__ void stagger2(unsigned step_ticks) {
#if STAGGER2
    const unsigned ticks = ((blockIdx.x >> 3) & 7u) * step_ticks;
    const unsigned long long t0 = __builtin_amdgcn_s_memrealtime();
    while ((unsigned)(__builtin_amdgcn_s_memrealtime() - t0) < ticks) __builtin_amdgcn_s_sleep(16);
#endif
}
struct Order13 : pg8::StaticOrder {
    __device__ __forceinline__ void init13(int G_, int c_) { init(M, 12 * 256, G_, c_); }
    __device__ __forceinline__ bool next(int i, pg8::Unit& u) const {
        const long L = (long)i * G + c;
        if (L < nwg) return pg8::StaticOrder::next(i, u);
        const int j = (int)(L - nwg); if (j >= 256) return false;
        u.pm = (j % 8) * 32 + j / 8; u.pn = 12; return true;
    }
};
__global__ void __launch_bounds__(NTHR, 2) fwd_megakernel(Args A) {
    extern __shared__ __attribute__((aligned(16))) unsigned char lds_raw[];
    LAS unsigned char* lds = (LAS unsigned char*)lds_raw;
    cg::grid_group grid = cg::this_grid();
    if (threadIdx.x < 4) ((LAS unsigned*)(lds + LDS_MISC + 1024))[threadIdx.x] = 0u;
    __syncthreads();
    if (A.ph_lo < 0) grid.sync();
    (void)xcd_barrier_post((unsigned*)(A.ws + WS_BAR), (volatile LAS unsigned*)(lds + LDS_MISC + 1024));
    const int tid = threadIdx.x, lane = tid & 63, wave = __builtin_amdgcn_readfirstlane(tid >> 6);
    unsigned char* ws = A.ws;
    const int lo = A.ph_lo, hi = A.ph_hi;
    const int gw = blockIdx.x * NWAVES + wave, NGW = gridDim.x * NWAVES;
    float* MOD = (float*)(ws + WS_MOD);
#ifndef PHASE_MASK
#define PHASE_MASK 0xfff
#endif
#define IN(k) (((PHASE_MASK >> (k)) & 1) && lo <= (k) && (k) < hi)
#ifndef USE_XBAR
#define USE_XBAR 1
#endif
#define GSYNC(k) do { if (USE_XBAR) { XcdBarrier xb_; xb_.bar = (unsigned*)(A.ws + WS_BAR); xb_.x = xb_xcc_id(); xb_.st = (volatile LAS unsigned*)(lds + LDS_MISC + 1024); xcd_barrier(xb_); } else grid.sync(); } while (0)
#define SEAM(k) do { if (IN(k) && IN((k) + 1)) GSYNC(k); } while (0)
#ifndef REPEAT_MASK
#define REPEAT_MASK 0
#endif
#define REP(k) for (int rep_ = 0; rep_ < (((REPEAT_MASK >> (k)) & 1) ? 2 : 1); ++rep_, (void)((rep_ < (((REPEAT_MASK >> (k)) & 1) ? 2 : 1)) ? (grid.sync(), 0) : 0))

    if (IN(0)) { p0_prologue(A, lds, tid, lane, wave); } SEAM(0);
#ifdef EXTRA_SYNCS
    for (int e_ = 0; e_ < EXTRA_SYNCS; ++e_) grid.sync();
#endif
    REP(1) if (IN(1)) {
        int m = gw;
        for (; m + 3 * NGW < M; m += 4 * NGW) norm_mod_rows<4>(A.in[0], (bf16*)(ws + WS_XN), MOD, 0, m, NGW, lane);
        for (; m < M; m += NGW) norm_mod_rows<1>(A.in[0], (bf16*)(ws + WS_XN), MOD, 0, m, NGW, lane);
#if FUSED_RES && !(CONV_UNDER_S2 && SHADOW_EXTRA)
        for (int nn = gw; nn < FF; nn += NGW) {
            const bf16* wrow = (const bf16*)(ws + WS_WUP) + (size_t)nn * D; float wa[8], wb[8];
            unpack8(*(const u32x4*)(wrow + lane * 8), wa); unpack8(*(const u32x4*)(wrow + 512 + lane * 8), wb);
#pragma unroll 1
            for (int b = 0; b < BATCH; ++b) { const float* sh = MOD + b * NMOD + 3 * D; float sa[8], sb[8]; ld8f(sh + lane * 8, sa); ld8f(sh + 512 + lane * 8, sb); float acc_ = 0.f;
#pragma unroll
                for (int i = 0; i < 8; ++i) acc_ += sa[i] * wa[i] + sb[i] * wb[i];
                acc_ = wave_sum(acc_);
                if (lane == 0) ((float*)(ws + WS_BIAS2))[b * FF + nn] = acc_; }
        }
#endif
    } SEAM(1);
#ifdef DUP2N
    if (IN(2)) {
        pg8::Gemm g{(const bf16*)(ws + WS_XN), (const bf16*)(ws + WS_WIN), M, PT, D}; pg8::StaticOrder S; S.init(M, PT, gridDim.x, blockIdx.x);
        EpiNull E{(float*)(ws + WS_MOD) + 60000};
        pg8::gemm_phase<EpiNull, pg8::StaticOrder, true, true>(lds, g, S, E);
    } GSYNC(2);
#endif
#ifdef DUP2
    if (IN(2)) {
        pg8::Gemm g{(const bf16*)(ws + WS_XN), (const bf16*)(ws + WS_WIN), M, PT, D}; pg8::StaticOrder S; S.init(M, PT, gridDim.x, blockIdx.x);
        stagger_start(250); EpiBf<0, true> E{(bf16*)(ws + WS_P), PT};
        pg8::gemm_phase<EpiBf<0, true>, pg8::StaticOrder, true, true>(lds, g, S, E);
    } GSYNC(2);
#endif
    REP(2) if (IN(2)) {
        pg8::Gemm g{(const bf16*)(ws + WS_XN), (const bf16*)(ws + WS_WIN), M, PT, D}; Order13 S; S.init13(gridDim.x, blockIdx.x);
        EpiBf<0, true> E{(bf16*)(ws + WS_P), PT};
        pg8::gemm_phase<EpiBf<0, true>, Order13, true, true>(lds, g, S, E);
    } SEAM(2);
    REP(3) if (IN(3)) {
        vl_pass(A, gw, NGW, lane);
#if !(SCAN_CHUNKED && CONV_UNDER_S2)
        conv_pass(A, gw, NGW, lane);
#endif
    } SEAM(3);
    REP(4) if (IN(4)) {
        pg8::Gemm g{(const bf16*)(ws + WS_LA), (const bf16*)(ws + WS_LT), M, LN, LK}; pg8::StaticOrder S; S.init(M, LN, gridDim.x, blockIdx.x);
        stagger_start(100); EpiLora E{A.in[7], A.in[9], A.in[13], (const bf16*)(ws + WS_KL), (const bf16*)(ws + WS_KK), (float*)(ws + WS_DEC), (bf16*)(ws + WS_KP), (bf16*)(ws + WS_BV), (bf16*)(ws + WS_G)};
        pg8::gemm_phase<EpiLora, pg8::StaticOrder, true, true>(lds, g, S, E);
    } SEAM(4);
#if SCAN_CHUNKED
    if (IN(5)) {
        for (int ci = gw; ci < 64 * 512; ci += NGW) s1_item(ws, (unsigned char*)A.out, A.in[14], A.in[13], A.in[6], A.in[12], lds + wave * S1_WAVE, ci, lane);
#ifdef DUPS1
        grid.sync();
#pragma unroll 1
        for (int ci = gw; ci < 64 * 512; ci += NGW) s1_item(ws, (unsigned char*)A.out, A.in[14], A.in[13], A.in[6], A.in[12], lds + wave * S1_WAVE, ci, lane);
#endif
        GSYNC(5);
#ifdef DUPS2
        s2_phase(ws, (unsigned char*)A.out, A.in[14], A.in[15], A.in[16], lds, tid, lane, wave);
        GSYNC(5);
#endif
#ifdef DUPCONV
        if (blockIdx.x >= 64) conv_pass(A, (blockIdx.x - 64) * NWAVES + wave, (gridDim.x - 64) * NWAVES, lane);
        GSYNC(5);
#endif
        s2_phase(ws, (unsigned char*)A.out, A.in[14], A.in[15], A.in[16], lds, tid, lane, wave);
#if CONV_UNDER_S2
        if (gridDim.x > 64) { if (blockIdx.x >= 64) { conv_pass(A, (blockIdx.x - 64) * NWAVES + wave, (gridDim.x - 64) * NWAVES, lane); if (SHADOW_EXTRA) shadow_work(A, lds, (blockIdx.x - 64) * NWAVES + wave, (gridDim.x - 64) * NWAVES, lane, wave); } }
        else { conv_pass(A, gw, NGW, lane); if (SHADOW_EXTRA) shadow_work(A, lds, gw, NGW, lane, wave); }
#endif
    } SEAM(5);
#else
    REP(5) if (IN(5)) { scan_phase(ws, lds, tid, lane, wave); } SEAM(5);
#endif
#if !(SCAN_CHUNKED && S2_POST)
    REP(6) if (IN(6)) { int m = gw; for (; m + 3 * NGW < M; m += 4 * NGW) post_rows<4>(A, m, NGW, lane); for (; m < M; m += NGW) post_rows<1>(A, m, NGW, lane); } SEAM(6);
#endif
    REP(7) if (IN(7)) {
        pg8::Gemm g{(const bf16*)(ws + WS_MIX), (const bf16*)(ws + WS_WOUT), M, D, D}; pg8::StaticOrder S; S.init(M, D, gridDim.x, blockIdx.x);
#if FUSED_RES
        EpiRes7 E{A.in[0], (bf16*)(ws + WS_X1B), (bf16*)(ws + WS_XN), MOD, (float*)(ws + WS_RS2)};
        pg8::gemm_phase<EpiRes7, pg8::StaticOrder, true, true>(lds, g, S, E);
#else
        stagger_start(500); EpiRes E{A.in[0], A.out, MOD + 2 * D};
        pg8::gemm_phase<EpiRes, pg8::StaticOrder, true, true>(lds, g, S, E);
#endif
    } SEAM(7);
#if !FUSED_RES
    REP(8) if (IN(8)) {
        int m = gw;
        for (; m + 3 * NGW < M; m += 4 * NGW) norm_mod_rows<4>(A.out, (bf16*)(ws + WS_XN), MOD, 3, m, NGW, lane);
        for (; m < M; m += NGW) norm_mod_rows<1>(A.out, (bf16*)(ws + WS_XN), MOD, 3, m, NGW, lane);
    } SEAM(8);
#endif
#ifdef DUP9H
    if (IN(9)) {
        pg8::Gemm g{(const bf16*)(ws + WS_XN), (const bf16*)(ws + WS_WUP), M, FF / 2, D}; pg8::StaticOrder S; S.init(M, FF / 2, gridDim.x, blockIdx.x);
        EpiNull E{(float*)(ws + WS_MOD) + 60000};
        pg8::gemm_phase<EpiNull, pg8::StaticOrder, true, true>(lds, g, S, E);
    } GSYNC(9);
#endif
#ifdef DUP9N
    if (IN(9)) {
        pg8::Gemm g{(const bf16*)(ws + WS_XN), (const bf16*)(ws + WS_WUP), M, FF, D}; pg8::StaticOrder S; S.init(M, FF, gridDim.x, blockIdx.x);
        EpiNull E{(float*)(ws + WS_MOD) + 60000};
        pg8::gemm_phase<EpiNull, pg8::StaticOrder, true, true>(lds, g, S, E);
    } GSYNC(9);
#endif
#ifdef DUP9
    if (IN(9)) {
        pg8::Gemm g{(const bf16*)(ws + WS_XN), (const bf16*)(ws + WS_WUP), M, FF, D}; pg8::StaticOrder S; S.init(M, FF, gridDim.x, blockIdx.x);
        stagger_start(250); EpiBf<1> E{(bf16*)(ws + WS_H), FF};
        pg8::gemm_phase<EpiBf<1>, pg8::StaticOrder, true, true>(lds, g, S, E);
    } grid.sync();
#endif
    REP(9) if (IN(9)) {
        pg8::Gemm g{(const bf16*)(ws + WS_XN), (const bf16*)(ws + WS_WUP), M, FF, D}; pg8::StaticOrder S; S.init(M, FF, gridDim.x, blockIdx.x);
#if FUSED_RES
        stagger2(275); EpiUp2 E{(bf16*)(ws + WS_H), (const float*)(ws + WS_RS2), (const float*)(ws + WS_BIAS2)};
        pg8::gemm_phase<EpiUp2, pg8::StaticOrder, true, true>(lds, g, S, E);
#else
        stagger_start(250); EpiBf<1> E{(bf16*)(ws + WS_H), FF};
        pg8::gemm_phase<EpiBf<1>, pg8::StaticOrder, true, true>(lds, g, S, E);
#endif
    } SEAM(9);
    if (IN(10)) {
        pg8::Gemm g{(const bf16*)(ws + WS_H), (const bf16*)(ws + WS_WDN), M, D, FF}; pg8::StaticOrder S; S.init(M, D, gridDim.x, blockIdx.x);
#if FUSED_RES && FUSED_FINAL
        EpiDownF E{(const bf16*)(ws + WS_X1B), A.out, MOD, A.in[20], (float*)(ws + WS_RS3), (unsigned*)(ws + WS_CNT)};
        pg8::gemm_phase<EpiDownF, pg8::StaticOrder, true, true>(lds, g, S, E);
#elif FUSED_RES
        EpiDown2 E{(const bf16*)(ws + WS_X1B), (bf16*)(ws + WS_X2B), MOD, (float*)(ws + WS_RS3)};
        pg8::gemm_phase<EpiDown2, pg8::StaticOrder, true, true>(lds, g, S, E);
#else
        stagger_start(600); EpiRes E{A.out, A.out, MOD + 5 * D};
        pg8::gemm_phase<EpiRes, pg8::StaticOrder, true, true>(lds, g, S, E);
#endif
    }
#if FUSED_RES && FUSED_FINAL
#elif FUSED_RES
    SEAM(10);
    if (IN(11)) { int m = gw; for (; m + 3 * NGW < M; m += 4 * NGW) final_rows2<4>((const bf16*)(ws + WS_X2B), (const float*)(ws + WS_RS3), A.out, A.in[20], m, NGW, lane);
        for (; m < M; m += NGW) final_rows2<1>((const bf16*)(ws + WS_X2B), (const float*)(ws + WS_RS3), A.out, A.in[20], m, NGW, lane); }
#else
    if (IN(11)) { int m = gw; for (; m + 3 * NGW < M; m += 4 * NGW) final_rows<4>(A.out, A.in[20], m, NGW, lane); for (; m < M; m += NGW) final_rows<1>(A.out, A.in[20], m, NGW, lane); }
#endif
#undef IN
#undef SEAM
}

extern "C" void kernel_launch(void* const* d_in, const int* in_sizes, int n_in, void* d_out, int out_size, void* d_ws, size_t ws_size, hipStream_t stream) {
    static int grid_blocks = 0;
    if (grid_blocks == 0) {
        if (n_in != 21 || out_size != M * D || ws_size < WS_END) { fprintf(stderr, "kernel_launch: unexpected shapes (n_in %d out %d ws %zu)\n", n_in, out_size, ws_size); grid_blocks = -1; return; }
        int dev = 0, cus = 0, per_cu = 0;
        hipGetDevice(&dev);
        hipDeviceGetAttribute(&cus, hipDeviceAttributeMultiprocessorCount, dev);
        if (hipFuncSetAttribute((const void*)fwd_megakernel, hipFuncAttributeMaxDynamicSharedMemorySize, LDS_BYTES) != hipSuccess) { fprintf(stderr, "kernel_launch: hipFuncSetAttribute failed\n"); grid_blocks = -1; return; }
        if (hipOccupancyMaxActiveBlocksPerMultiprocessor(&per_cu, (const void*)fwd_megakernel, NTHR, LDS_BYTES) != hipSuccess || per_cu < 1) { fprintf(stderr, "kernel_launch: occupancy query failed (%d)\n", per_cu); grid_blocks = -1; return; }
        grid_blocks = cus * per_cu;
    }
    if (grid_blocks < 0) return;
    hipMemsetAsync((char*)d_ws + WS_MOD, 0, CTL_ZERO_BYTES, stream);
    Args a{};
    for (int i = 0; i < 21; ++i) a.in[i] = (const float*)d_in[i];
    a.out = (float*)d_out; a.ws = (unsigned char*)d_ws;
#if MK_SPLIT
    for (int ph = 0; ph < NPHASE; ++ph) {
        a.ph_lo = ph; a.ph_hi = ph + 1;
#else
    {
        a.ph_lo = 0; a.ph_hi = NPHASE;
#endif
        void* args[] = {&a};
        hipError_t e = hipLaunchCooperativeKernel((const void*)fwd_megakernel, dim3(grid_blocks), dim3(NTHR), args, LDS_BYTES, stream);
        if (e != hipSuccess) fprintf(stderr, "kernel_launch: cooperative launch failed: %s (grid %d)\n", hipGetErrorString(e), grid_blocks);
    }
}
```

```cpp
#include <hip/hip_runtime.h>
#include <hip/hip_cooperative_groups.h>
#include <cstdio>
#include <cstdint>
namespace cg = cooperative_groups;
namespace pg8 {
#define PG8_LAS __attribute__((address_space(3)))
typedef unsigned short bf16_t;
typedef short bf16x8 __attribute__((ext_vector_type(8)));
typedef float f32x4 __attribute__((ext_vector_type(4)));
typedef unsigned u32x4 __attribute__((ext_vector_type(4)));
constexpr int BM = 256, BK = 64, HALF = 128, HTB = HALF * BK * 2  , STAGE_BYTES = 8 * HTB, NXCD = 8, WGM = 8;

__host__ __device__ __forceinline__ int lds_byte(int r, int c) { const int st = (r >> 4) * 2 + (c >> 5), rr = r & 15, cc = c & 31, ob = rr * 64 + cc * 2; return st * 1024 + (ob ^ (((ob >> 9) & 1) << 5)); }
__host__ __device__ __forceinline__ void stage_rc(int b, int& R, int& C) { const int st = b / 1024, sb = b % 1024, swz = sb ^ (((sb >> 9) & 1) << 5); R = (st >> 1) * 16 + swz / 64; C = (st & 1) * 32 + (swz % 64) / 2; }
__host__ __device__ __forceinline__ int perm32(int rho) { const int n = rho >> 4, i = rho & 15; return 8 * (i >> 2) + 4 * n + (i & 3); }

struct Unit { int pm, pn; };
struct Gemm { const bf16_t* A; const bf16_t* Bt; int M, N, K; };

struct StaticOrder {
    int nM, nN, nwg, G, c;
    __host__ __device__ void init(int M, int N, int G_, int c_) { nM = M / BM; nN = N / BM; nwg = nM * nN; G = G_; c = c_; }
    __host__ __device__ bool next(int i, Unit& u) const {
        const long L = (long)i * G + c; if (L >= nwg) return false;
        int wgid = (int)L; { const int q = nwg / NXCD, r = nwg % NXCD, xcd = wgid % NXCD, off = wgid / NXCD; wgid = (xcd < r ? xcd * (q + 1) : r * (q + 1) + (xcd - r) * q) + off; }
        const int nig = WGM * nN, gid = wgid / nig, fm = gid * WGM, gsz = (nM - fm) < WGM ? (nM - fm) : WGM;
        u.pm = fm + ((wgid % nig) % gsz); u.pn = (wgid % nig) / gsz; return true;
    }
    __device__ __forceinline__ void a_ready(const Unit&) const {}
    __device__ __forceinline__ void done(const Unit&) const {}
};
__device__ __forceinline__ unsigned cvt_pk_bf16(float lo, float hi) { unsigned r; asm volatile("v_cvt_pk_bf16_f32 %0, %1, %2" : "=v"(r) : "v"(lo), "v"(hi)); return r; }
template <class Epi, class Sched, bool ALIGN_EPI = false, bool SP2 = false>
__device__ __forceinline__ void gemm_phase(PG8_LAS unsigned char* lds, const Gemm g, const Sched& S, const Epi& E) {
    const int tid = threadIdx.x, wid = __builtin_amdgcn_readfirstlane(tid >> 6), lane = tid & 63, wr = wid >> 2, wc = wid & 3, fr = lane & 15, fq = lane >> 4;
    const int K = g.K, nt = K / BK;
    unsigned voffA[2], voffB[2];
#pragma unroll
    for (int i = 0; i < 2; ++i) { int R, C; stage_rc(tid * 16 + i * 8192, R, C); const int Rb = Epi::PERM ? ((R & ~31) + perm32(R & 31)) : R;
        voffA[i] = (unsigned)(R * K + C) * 2u; voffB[i] = (unsigned)(Rb * K + C) * 2u; }
    const size_t kstep = (size_t)(BK * 2);
    const size_t hstep = (size_t)HALF * K * 2;
    const size_t tstep = 2 * hstep;
    const unsigned ldsw = (unsigned)wid * 1024u;
    const int aoff = lds_byte(wr * 64 + fr, fq * 8), boff = lds_byte(wc * 32 + fr, fq * 8);
#define PG8_SA(b, h) (((b) * 2 + (h)) * HTB)
#define PG8_SB(b, h) ((4 + (b) * 2 + (h)) * HTB)
#define PG8_STAGE(bufoff, gbase, voff) do { _Pragma("unroll") for (int _i = 0; _i < 2; ++_i) \
        __builtin_amdgcn_global_load_lds((const unsigned*)((const char*)(gbase) + (voff)[_i]), (PG8_LAS unsigned*)(lds + (bufoff) + ldsw + _i * 8192), 16, 0, 0); } while (0)
#define PG8_LDA(dst, b, h) do { _Pragma("unroll") for (int m = 0; m < 4; ++m) _Pragma("unroll") for (int k = 0; k < 2; ++k) dst[m][k] = *(const PG8_LAS bf16x8*)(lds + PG8_SA(b, h) + aoff + m * 2048 + k * 1024); } while (0)
#define PG8_LDB(dst, b, h) do { _Pragma("unroll") for (int n = 0; n < 2; ++n) _Pragma("unroll") for (int k = 0; k < 2; ++k) dst[n][k] = *(const PG8_LAS bf16x8*)(lds + PG8_SB(b, h) + boff + n * 2048 + k * 1024); } while (0)
#define PG8_MMA(ai, bj, At, Bt) do { __builtin_amdgcn_s_setprio(1); _Pragma("unroll") for (int m = 0; m < 4; ++m) _Pragma("unroll") for (int n = 0; n < 2; ++n) _Pragma("unroll") for (int k = 0; k < 2; ++k) \
        acc[ai][bj][m][n] = __builtin_amdgcn_mfma_f32_16x16x32_bf16(Bt[n][k], At[m][k], acc[ai][bj][m][n], 0, 0, 0); __builtin_amdgcn_s_setprio(0); } while (0)
#define PG8_WAIT_V(n) asm volatile("s_waitcnt vmcnt(" #n ")" ::: "memory")
#define PG8_WAIT_L(n) asm volatile("s_waitcnt lgkmcnt(" #n ")" ::: "memory")
#define PG8_BAR __builtin_amdgcn_s_barrier()
#define PG8_SCHED __builtin_amdgcn_sched_barrier(0)
    Unit cur, nxt; int ui = 0;
    if (!S.next(0, cur)) return;
    f32x4 acc[2][2][4][2];
#pragma unroll
    for (int a = 0; a < 2; ++a)
#pragma unroll
        for (int b = 0; b < 2; ++b)
#pragma unroll
            for (int m = 0; m < 4; ++m)
#pragma unroll
                for (int n = 0; n < 2; ++n) acc[a][b][m][n] = (f32x4){0.f, 0.f, 0.f, 0.f};
    bf16x8 At[4][2], B0[2][2], B1[2][2];
    const char* cA = (const char*)g.A + (size_t)cur.pm * tstep; const char* cB = (const char*)g.Bt + (size_t)cur.pn * tstep;
    S.a_ready(cur);
    if constexpr (SP2) {
        PG8_STAGE(PG8_SB(0, 0), cB, voffB); PG8_STAGE(PG8_SB(0, 1), cB + hstep, voffB); PG8_STAGE(PG8_SA(0, 0), cA, voffA); PG8_STAGE(PG8_SA(0, 1), cA + hstep, voffA);
        if (wr == 1) PG8_BAR;
        PG8_WAIT_V(2); PG8_BAR;
        PG8_STAGE(PG8_SB(1, 0), cB + kstep, voffB); PG8_STAGE(PG8_SA(1, 0), cA + kstep, voffA); PG8_STAGE(PG8_SB(1, 1), cB + hstep + kstep, voffB);
        PG8_WAIT_V(6); PG8_BAR;
    } else {
        PG8_STAGE(PG8_SB(0, 0), cB, voffB); PG8_STAGE(PG8_SA(0, 0), cA, voffA); PG8_STAGE(PG8_SB(0, 1), cB + hstep, voffB); PG8_STAGE(PG8_SA(0, 1), cA + hstep, voffA);
        if (wr == 1) PG8_BAR;
        PG8_WAIT_V(4); PG8_BAR;
        PG8_STAGE(PG8_SB(1, 0), cB + kstep, voffB); PG8_STAGE(PG8_SA(1, 0), cA + kstep, voffA); PG8_STAGE(PG8_SB(1, 1), cB + hstep + kstep, voffB);
        PG8_WAIT_V(6); PG8_BAR;
    }
    for (;;) {
        const bool has_next = S.next(ui + 1, nxt);
        const char* nA = has_next ? (const char*)g.A + (size_t)nxt.pm * tstep : cA; const char* nB = has_next ? (const char*)g.Bt + (size_t)nxt.pn * tstep : cB;
#pragma unroll 1
        for (int t = 0; t < nt; t += 2) {
            const bool last = (t == nt - 2);
            const char* a1 = cA + (size_t)(t + 1) * kstep;
            const char* a2 = last ? nA : cA + (size_t)(t + 2) * kstep; const char* b2 = last ? nB : cB + (size_t)(t + 2) * kstep;
            const char* a3 = a2 + kstep; const char* b3 = b2 + kstep;
            if (last && has_next) S.a_ready(nxt);
            if constexpr (SP2) {
            PG8_LDB(B0, 0, 0); PG8_LDB(B1, 0, 1); PG8_SCHED; PG8_LDA(At, 0, 0); PG8_STAGE(PG8_SA(1, 1), a1 + hstep, voffA);
            PG8_WAIT_V(8); PG8_WAIT_L(0); PG8_BAR; PG8_MMA(0, 0, At, B0); PG8_MMA(0, 1, At, B1); PG8_BAR; PG8_SCHED;
            PG8_LDA(At, 0, 1); PG8_STAGE(PG8_SB(0, 0), b2, voffB); PG8_STAGE(PG8_SB(0, 1), b2 + hstep, voffB); PG8_STAGE(PG8_SA(0, 0), a2, voffA);
            PG8_WAIT_V(8); PG8_WAIT_L(0); PG8_BAR; PG8_MMA(1, 0, At, B0); PG8_MMA(1, 1, At, B1); PG8_BAR; PG8_SCHED;
            PG8_LDB(B0, 1, 0); PG8_LDB(B1, 1, 1); PG8_SCHED; PG8_LDA(At, 1, 0); PG8_STAGE(PG8_SA(0, 1), a2 + hstep, voffA);
            PG8_WAIT_V(8); PG8_WAIT_L(0); PG8_BAR; PG8_MMA(0, 0, At, B0); PG8_MMA(0, 1, At, B1); PG8_BAR; PG8_SCHED;
            PG8_LDA(At, 1, 1); PG8_STAGE(PG8_SB(1, 0), b3, voffB); PG8_STAGE(PG8_SB(1, 1), b3 + hstep, voffB); PG8_STAGE(PG8_SA(1, 0), a3, voffA);
            PG8_WAIT_V(8); PG8_WAIT_L(0); PG8_BAR; PG8_MMA(1, 0, At, B0); PG8_MMA(1, 1, At, B1); PG8_BAR; PG8_SCHED;
            } else {
            PG8_LDB(B0, 0, 0); PG8_SCHED; PG8_LDA(At, 0, 0); PG8_STAGE(PG8_SA(1, 1), a1 + hstep, voffA);
            PG8_WAIT_L(8); PG8_BAR; PG8_WAIT_L(0); PG8_MMA(0, 0, At, B0); PG8_BAR; PG8_SCHED;
            PG8_LDB(B1, 0, 1); PG8_STAGE(PG8_SB(0, 0), b2, voffB);
            PG8_BAR; PG8_WAIT_L(0); PG8_MMA(0, 1, At, B1); PG8_BAR;
            PG8_LDA(At, 0, 1); PG8_STAGE(PG8_SA(0, 0), a2, voffA);
            PG8_BAR; PG8_WAIT_L(0); PG8_MMA(1, 0, At, B0); PG8_BAR; PG8_SCHED;
            PG8_STAGE(PG8_SB(0, 1), b2 + hstep, voffB);
            PG8_WAIT_V(6); PG8_BAR; PG8_MMA(1, 1, At, B1); PG8_BAR;
            PG8_LDB(B0, 1, 0); PG8_SCHED; PG8_LDA(At, 1, 0); PG8_STAGE(PG8_SA(0, 1), a2 + hstep, voffA);
            PG8_WAIT_L(8); PG8_BAR; PG8_WAIT_L(0); PG8_MMA(0, 0, At, B0); PG8_BAR; PG8_SCHED;
            PG8_LDB(B1, 1, 1); PG8_STAGE(PG8_SB(1, 0), b3, voffB);
            PG8_BAR; PG8_WAIT_L(0); PG8_MMA(0, 1, At, B1); PG8_BAR;
            PG8_LDA(At, 1, 1); PG8_STAGE(PG8_SA(1, 0), a3, voffA);
            PG8_BAR; PG8_WAIT_L(0); PG8_MMA(1, 0, At, B0); PG8_BAR; PG8_SCHED;
            PG8_STAGE(PG8_SB(1, 1), b3 + hstep, voffB);
            PG8_WAIT_V(6); PG8_BAR; PG8_MMA(1, 1, At, B1); PG8_BAR;
            }
        }
        if constexpr (ALIGN_EPI) { if (wr == 0) PG8_BAR; }
        if constexpr (!Epi::AFTER_DRAIN) { E(acc, cur, wr, wc, fr, fq); S.done(cur); }
        if (!has_next) break;
#pragma unroll
        for (int a = 0; a < 2; ++a)
#pragma unroll
            for (int b = 0; b < 2; ++b)
#pragma unroll
                for (int m = 0; m < 4; ++m)
#pragma unroll
                    for (int n = 0; n < 2; ++n) acc[a][b][m][n] = (f32x4){0.f, 0.f, 0.f, 0.f};
        cur = nxt; cA = nA; cB = nB; ++ui;
        if constexpr (ALIGN_EPI) { if (wr == 1) PG8_BAR; }
    }
    PG8_WAIT_V(0);
    if constexpr (!ALIGN_EPI) { if (wr == 0) PG8_BAR; }
    PG8_BAR;
    if constexpr (Epi::AFTER_DRAIN) { E.fused(acc, cur, wr, wc, fr, fq, lds, wid, lane); S.done(cur); }
#undef PG8_SA
#undef PG8_SB
#undef PG8_STAGE
#undef PG8_LDA
#undef PG8_LDB
#undef PG8_MMA
#undef PG8_WAIT_V
#undef PG8_WAIT_L
#undef PG8_BAR
#undef PG8_SCHED
}
}

#ifndef CONV_UNDER_S2
#define CONV_UNDER_S2 1
#endif
#ifndef SHADOW_EXTRA
#define SHADOW_EXTRA 1
#endif
#ifndef MK_SPLIT
#define MK_SPLIT 0
#endif
constexpr int NWAVES = 8, NTHR = 512;
constexpr int BATCH = 8, SEQ = 8192, D = 1024, M = BATCH * SEQ;
constexpr int PCONV = 1536, PT = 3328, FF = 4096, RW = 512;
constexpr int LK = 256, LN = 1536;
constexpr int NMOD = 6 * D;
constexpr int NPHASE = 12;
constexpr size_t MiB = 1u << 20;
constexpr size_t WS_MOD = 0, WS_RS2 = 256 * 1024, WS_RS3 = 512 * 1024, WS_BIAS2 = 768 * 1024, CTL_ZERO_BYTES = 1024 * 1024;
constexpr size_t WS_X1B = 704ull << 20, WS_X2B = 864ull << 20;
constexpr size_t WS_WIN = 1 * MiB, WS_WOUT = 8 * MiB, WS_WUP = 10 * MiB, WS_WDN = 18 * MiB, WS_LT = 26 * MiB;
constexpr size_t WS_XN = 32 * MiB;
constexpr size_t WS_Y = 32 * MiB;
constexpr size_t WS_P = 160 * MiB;
constexpr size_t WS_DEC = 32 * MiB  , WS_KP = 576 * MiB  , WS_BV = 352 * MiB  , WS_G = 640 * MiB  ;
constexpr size_t WS_H = 160 * MiB;
constexpr size_t WS_RL = 576 * MiB, WS_KL = 640 * MiB, WS_VL = 704 * MiB, WS_KK = 768 * MiB;
constexpr size_t WS_LA = 832 * MiB;
constexpr size_t WS_MIX = 864 * MiB;
constexpr size_t WS_END = 1024 * MiB;
constexpr int LDS_MISC = 131072, LDS_BYTES = 131072 + 2048;

typedef unsigned short bf16;
typedef float f32x4 __attribute__((ext_vector_type(4)));
typedef float f32x2 __attribute__((ext_vector_type(2)));
typedef unsigned u32x4 __attribute__((ext_vector_type(4)));
typedef unsigned u32x2 __attribute__((ext_vector_type(2)));
#define LAS __attribute__((address_space(3)))

typedef __bf16 bf16v2_t __attribute__((ext_vector_type(2)));
__device__ __forceinline__ unsigned pk2(float lo, float hi) { return __builtin_bit_cast(unsigned, __builtin_convertvector((f32x2){lo, hi}, bf16v2_t)); }
__device__ __forceinline__ float bflo(unsigned w) { return __uint_as_float(w << 16); }
__device__ __forceinline__ float bfhi(unsigned w) { return __uint_as_float(w & 0xffff0000u); }
__device__ __forceinline__ void unpack8(const u32x4 w, float (&f)[8]) {
    f[0] = bflo(w.x); f[1] = bfhi(w.x); f[2] = bflo(w.y); f[3] = bfhi(w.y); f[4] = bflo(w.z); f[5] = bfhi(w.z); f[6] = bflo(w.w); f[7] = bfhi(w.w);
}
__device__ __forceinline__ u32x4 pack8(const float (&f)[8]) { u32x4 w; w.x = pk2(f[0], f[1]); w.y = pk2(f[2], f[3]); w.z = pk2(f[4], f[5]); w.w = pk2(f[6], f[7]); return w; }
__device__ __forceinline__ void ld8f(const float* p, float (&f)[8]) { const f32x4 a = *(const f32x4*)p, b = *(const f32x4*)(p + 4); f[0] = a.x; f[1] = a.y; f[2] = a.z; f[3] = a.w; f[4] = b.x; f[5] = b.y; f[6] = b.z; f[7] = b.w; }
__device__ __forceinline__ float wave_sum(float v) {
#pragma unroll
    for (int o = 1; o < 64; o <<= 1) v += __shfl_xor(v, o);
    return v;
}
__device__ __forceinline__ float sum8(float v) { v += __shfl_xor(v, 1); v += __shfl_xor(v, 2); v += __shfl_xor(v, 4); return v; }
__device__ __forceinline__ float sigmoidf_(float x) { return 1.0f / (1.0f + __expf(-x)); }

struct Args { const float* in[21]; float* out; unsigned char* ws; int ph_lo, ph_hi; };

template <int ACT  , bool TILED = false> struct EpiBf {
    static constexpr bool PERM = true, AFTER_DRAIN = false;
    bf16* O; int ldc;
    __device__ __forceinline__ void operator()(const pg8::f32x4 (&acc)[2][2][4][2], const pg8::Unit& u, int wr, int wc, int fr, int fq) const {
        const int row0 = u.pm * 256 + wr * 64 + fr, col0 = u.pn * 256 + wc * 32 + 8 * fq;
        unsigned long long rp = (unsigned long long)(TILED ? O + ((size_t)(u.pm * 13 + u.pn) << 16) + (size_t)(wr * 64 + fr) * 256 + wc * 32 + 8 * fq : O + (size_t)row0 * ldc + col0);
        const unsigned long long rstep = (unsigned long long)(TILED ? 256 : ldc) * 2ull;
#pragma unroll
        for (int ai = 0; ai < 2; ++ai)
#pragma unroll
            for (int m = 0; m < 4; ++m) { bf16* rowp = (bf16*)rp;
#pragma unroll
                for (int bj = 0; bj < 2; ++bj) { pg8::f32x4 v0 = acc[ai][bj][m][0], v1 = acc[ai][bj][m][1];
                    if (ACT == 1) {
#pragma unroll
                        for (int j = 0; j < 4; ++j) { const float a = fmaxf(v0[j], 0.f), b = fmaxf(v1[j], 0.f); v0[j] = a * a; v1[j] = b * b; } }
                    u32x4 w; w.x = pk2(v0[0], v0[1]); w.y = pk2(v0[2], v0[3]); w.z = pk2(v1[0], v1[1]); w.w = pk2(v1[2], v1[3]);
                    *(u32x4*)(rowp + bj * 128) = w; }
                rp += (m == 3 ? 80ull : 16ull) * rstep;
                asm volatile("" : "+v"(rp) :: "memory"); }
    }
};
struct EpiNull { static constexpr bool PERM = true, AFTER_DRAIN = false; float* sink;
    __device__ __forceinline__ void operator()(const pg8::f32x4 (&acc)[2][2][4][2], const pg8::Unit& u, int wr, int wc, int fr, int fq) const {
        float s = 0.f;
#pragma unroll
        for (int ai = 0; ai < 2; ++ai)
#pragma unroll
            for (int bj = 0; bj < 2; ++bj)
#pragma unroll
                for (int m = 0; m < 4; ++m)
#pragma unroll
                    for (int n = 0; n < 2; ++n) s += acc[ai][bj][m][n][0] + acc[ai][bj][m][n][1] + acc[ai][bj][m][n][2] + acc[ai][bj][m][n][3];
        if (s == 123.456f) sink[0] = s; } };
struct EpiRes {
    static constexpr bool PERM = false, AFTER_DRAIN = false;
    const float* X; float* O; const float* gate;
    __device__ __forceinline__ void operator()(const pg8::f32x4 (&acc)[2][2][4][2], const pg8::Unit& u, int wr, int wc, int fr, int fq) const {
        const int row0 = u.pm * 256 + wr * 64 + fr, col0 = u.pn * 256 + wc * 32 + 4 * fq, b = u.pm >> 5;
        f32x4 gv[2][2];
#pragma unroll
        for (int bj = 0; bj < 2; ++bj)
#pragma unroll
            for (int n = 0; n < 2; ++n) gv[bj][n] = *(const f32x4*)(gate + (size_t)b * NMOD + col0 + bj * 128 + n * 16);
#pragma unroll
        for (int ai = 0; ai < 2; ++ai)
#pragma unroll
            for (int m = 0; m < 4; ++m) { const size_t off = (size_t)(row0 + ai * 128 + m * 16) * D + col0;
#pragma unroll
                for (int bj = 0; bj < 2; ++bj)
#pragma unroll
                    for (int n = 0; n < 2; ++n) { const f32x4 xv = *(const f32x4*)(X + off + bj * 128 + n * 16);
                        *(f32x4*)(O + off + bj * 128 + n * 16) = xv + gv[bj][n] * acc[ai][bj][m][n]; }
                asm volatile("" ::: "memory"); }
    }
};
#ifndef LK0
#define LK0 1
#endif
#ifndef LK1
#define LK1 1
#endif
#ifndef LK2
#define LK2 1
#endif
#ifndef SCAN_CHUNKED
#define SCAN_CHUNKED 1
#endif
#define LORA_LOGW SCAN_CHUNKED
struct EpiLora {
    static constexpr bool PERM = true, AFTER_DRAIN = false;
    const float *w0, *a0, *k_a; const bf16 *KL, *KK; float* DEC; bf16 *KP, *BV, *G;
    __device__ __forceinline__ void operator()(const pg8::f32x4 (&acc)[2][2][4][2], const pg8::Unit& u, int wr, int wc, int fr, int fq) const {
        const int kind = u.pn >> 1, row0 = u.pm * 256 + wr * 64 + fr, cb = (u.pn & 1) * 256 + wc * 32 + 8 * fq;
#pragma unroll
        for (int bj = 0; bj < 2; ++bj) {
            const int c = cb + bj * 128;
            if (LK0 && kind == 0) {
                float wv[8]; ld8f(w0 + c, wv);
#pragma unroll
                for (int ai = 0; ai < 2; ++ai)
#pragma unroll
                    for (int m = 0; m < 4; ++m) { const size_t off = (size_t)(row0 + ai * 128 + m * 16) * RW + c; float o8[8];
#pragma unroll
                        for (int n = 0; n < 2; ++n)
#pragma unroll
                            for (int j = 0; j < 4; ++j) { const float pre = acc[ai][bj][m][n][j] + wv[4 * n + j];
                                o8[4 * n + j] = -0.6065306597f * sigmoidf_(pre); }
                        *(u32x4*)((bf16*)DEC + off) = pack8(o8); asm volatile("" ::: "memory"); }
            } else if (LK1 && kind == 1) {
                float av[8]; ld8f(a0 + c, av);
#pragma unroll
                for (int ai = 0; ai < 2; ++ai)
#pragma unroll
                    for (int m = 0; m < 4; ++m) { const size_t off = (size_t)(row0 + ai * 128 + m * 16) * RW + c; float a8[8];
#pragma unroll
                        for (int n = 0; n < 2; ++n)
#pragma unroll
                            for (int j = 0; j < 4; ++j) a8[4 * n + j] = sigmoidf_(acc[ai][bj][m][n][j] + av[4 * n + j]);
                        *(u32x4*)(KP + off) = pack8(a8); }
            } else if (LK2) {
#pragma unroll
                for (int ai = 0; ai < 2; ++ai)
#pragma unroll
                    for (int m = 0; m < 4; ++m) { const size_t off = (size_t)(row0 + ai * 128 + m * 16) * RW + c;
                        const pg8::f32x4 v0 = acc[ai][bj][m][0], v1 = acc[ai][bj][m][1];
                        u32x4 w; w.x = pk2(v0[0], v0[1]); w.y = pk2(v0[2], v0[3]); w.z = pk2(v1[0], v1[1]); w.w = pk2(v1[2], v1[3]);
                        *(u32x4*)(G + off) = w; }
            }
        }
    }
};


#ifndef FUSED_RES
#define FUSED_RES 1
#endif
#ifndef CONV_UNDER_S2
#define CONV_UNDER_S2 1
#endif
struct EpiRes7 {
    static constexpr bool PERM = true, AFTER_DRAIN = false;
    const float* X; bf16* X1B; bf16* A2; const float* MODp; float* RS;
    __device__ __forceinline__ void operator()(const pg8::f32x4 (&acc)[2][2][4][2], const pg8::Unit& u, int wr, int wc, int fr, int fq) const {
        const int row0 = u.pm * 256 + wr * 64 + fr, col0 = u.pn * 256 + wc * 32 + 8 * fq, b = u.pm >> 5;
        float gv[2][8], sv[2][8];
#pragma unroll
        for (int bj = 0; bj < 2; ++bj) { ld8f(MODp + (size_t)b * NMOD + 2 * D + col0 + bj * 128, gv[bj]); ld8f(MODp + (size_t)b * NMOD + 4 * D + col0 + bj * 128, sv[bj]); }
#pragma unroll
        for (int ai = 0; ai < 2; ++ai)
#pragma unroll
            for (int m = 0; m < 4; ++m) { const int row = row0 + ai * 128 + m * 16; const size_t off = (size_t)row * D + col0; float ss = 0.f;
#pragma unroll
                for (int bj = 0; bj < 2; ++bj) { float xv[8], x1[8], a2[8]; { const f32x4 xa_ = __builtin_nontemporal_load((const f32x4*)(X + off + bj * 128)), xb_ = __builtin_nontemporal_load((const f32x4*)(X + off + bj * 128 + 4)); xv[0] = xa_.x; xv[1] = xa_.y; xv[2] = xa_.z; xv[3] = xa_.w; xv[4] = xb_.x; xv[5] = xb_.y; xv[6] = xb_.z; xv[7] = xb_.w; }
#pragma unroll
                    for (int i = 0; i < 8; ++i) { x1[i] = xv[i] + gv[bj][i] * acc[ai][bj][m][i >> 2][i & 3]; ss += x1[i] * x1[i]; a2[i] = x1[i] * (1.0f + sv[bj][i]); }
                    *(u32x4*)(X1B + off + bj * 128) = pack8(x1); *(u32x4*)(A2 + off + bj * 128) = pack8(a2); }
                ss += __shfl_xor(ss, 16); ss += __shfl_xor(ss, 32);
                if (fq == 0) unsafeAtomicAdd(RS + row, ss);
                asm volatile("" ::: "memory"); }
    }
};
struct EpiUp2 {
    static constexpr bool PERM = true, AFTER_DRAIN = false;
    bf16* O; const float* RS; const float* BIAS;
    __device__ __forceinline__ void operator()(const pg8::f32x4 (&acc)[2][2][4][2], const pg8::Unit& u, int wr, int wc, int fr, int fq) const {
        const int row0 = u.pm * 256 + wr * 64 + fr, col0 = u.pn * 256 + wc * 32 + 8 * fq, b = u.pm >> 5;
        float bv[2][8];
#pragma unroll
        for (int bj = 0; bj < 2; ++bj) ld8f(BIAS + (size_t)b * FF + col0 + bj * 128, bv[bj]);
#pragma unroll
        for (int ai = 0; ai < 2; ++ai)
#pragma unroll
            for (int m = 0; m < 4; ++m) { const int row = row0 + ai * 128 + m * 16; const float rstd = rsqrtf(RS[row] * (1.f / D) + 1e-6f);
                bf16* rowp = O + (size_t)row * FF + col0;
#pragma unroll
                for (int bj = 0; bj < 2; ++bj) { float hv[8];
#pragma unroll
                    for (int i = 0; i < 8; ++i) { const float v = fmaxf(acc[ai][bj][m][i >> 2][i & 3] * rstd + bv[bj][i], 0.f); hv[i] = v * v; }
                    *(u32x4*)(rowp + bj * 128) = pack8(hv); } }
    }
};
struct EpiDown2 {
    static constexpr bool PERM = true, AFTER_DRAIN = false;
    const bf16* X1B; bf16* X2B; const float* MODp; float* RS;
    __device__ __forceinline__ void operator()(const pg8::f32x4 (&acc)[2][2][4][2], const pg8::Unit& u, int wr, int wc, int fr, int fq) const {
        const int row0 = u.pm * 256 + wr * 64 + fr, col0 = u.pn * 256 + wc * 32 + 8 * fq, b = u.pm >> 5;
        float gv[2][8];
#pragma unroll
        for (int bj = 0; bj < 2; ++bj) ld8f(MODp + (size_t)b * NMOD + 5 * D + col0 + bj * 128, gv[bj]);
#pragma unroll
        for (int ai = 0; ai < 2; ++ai)
#pragma unroll
            for (int m = 0; m < 4; ++m) { const int row = row0 + ai * 128 + m * 16; const size_t off = (size_t)row * D + col0; float ss = 0.f;
#pragma unroll
                for (int bj = 0; bj < 2; ++bj) { float xv[8], x2[8]; unpack8(*(const u32x4*)(X1B + off + bj * 128), xv);
#pragma unroll
                    for (int i = 0; i < 8; ++i) { x2[i] = xv[i] + gv[bj][i] * acc[ai][bj][m][i >> 2][i & 3]; ss += x2[i] * x2[i]; }
                    *(u32x4*)(X2B + off + bj * 128) = pack8(x2); }
                ss += __shfl_xor(ss, 16); ss += __shfl_xor(ss, 32);
                if (fq == 0) unsafeAtomicAdd(RS + row, ss);
                asm volatile("" ::: "memory"); }
    }
};

#ifndef FUSED_FINAL
#define FUSED_FINAL 1
#endif
constexpr size_t WS_CNT = 928 * 1024;
struct EpiDownF {
    static constexpr bool PERM = true, AFTER_DRAIN = false;
    const bf16* X1B; float* OUT; const float* MODp; const float* G; float* RS; unsigned* CNT;
    __device__ __forceinline__ void operator()(const pg8::f32x4 (&acc_)[2][2][4][2], const pg8::Unit& u, int wr, int wc, int fr, int fq) const {
        pg8::f32x4 (&acc)[2][2][4][2] = const_cast<pg8::f32x4 (&)[2][2][4][2]>(acc_);
        const int row0 = u.pm * 256 + wr * 64 + fr, col0 = u.pn * 256 + wc * 32 + 8 * fq, b = u.pm >> 5;
        {
            float gv[2][8];
#pragma unroll
            for (int bj = 0; bj < 2; ++bj) ld8f(MODp + (size_t)b * NMOD + 5 * D + col0 + bj * 128, gv[bj]);
#pragma unroll
            for (int ai = 0; ai < 2; ++ai)
#pragma unroll
                for (int m = 0; m < 4; ++m) { const int row = row0 + ai * 128 + m * 16; const size_t off = (size_t)row * D + col0; float ss = 0.f;
#pragma unroll
                    for (int bj = 0; bj < 2; ++bj) { float xv[8]; unpack8(*(const u32x4*)(X1B + off + bj * 128), xv);
#pragma unroll
                        for (int i = 0; i < 8; ++i) { const float x2 = xv[i] + gv[bj][i] * acc[ai][bj][m][i >> 2][i & 3]; acc[ai][bj][m][i >> 2][i & 3] = x2; ss += x2 * x2; } }
                    ss += __shfl_xor(ss, 16); ss += __shfl_xor(ss, 32);
                    if (fq == 0) unsafeAtomicAdd(RS + row, ss);
                    asm volatile("" ::: "memory"); }
        }
        asm volatile("s_waitcnt vmcnt(0)" ::: "memory");
        unsigned* cnt = CNT + 64 * u.pm;
        if ((threadIdx.x & 63) == 0) __hip_atomic_fetch_add(cnt, 1u, __ATOMIC_RELAXED, __HIP_MEMORY_SCOPE_AGENT);
        { unsigned sp = 0;
          while ((unsigned)__builtin_amdgcn_readfirstlane(__hip_atomic_load(cnt, __ATOMIC_RELAXED, __HIP_MEMORY_SCOPE_AGENT)) < 32u) { __builtin_amdgcn_s_sleep(2); if (++sp > (1u << 20)) break; } }
        float rstd[2][4];
#pragma unroll
        for (int ai = 0; ai < 2; ++ai)
#pragma unroll
            for (int m = 0; m < 4; ++m) rstd[ai][m] = rsqrtf(__hip_atomic_load(RS + row0 + ai * 128 + m * 16, __ATOMIC_RELAXED, __HIP_MEMORY_SCOPE_AGENT) * (1.f / D) + 1e-6f);
#pragma unroll
        for (int bj = 0; bj < 2; ++bj) {
            float g8[8]; ld8f(G + col0 + bj * 128, g8);
#pragma unroll
            for (int ai = 0; ai < 2; ++ai)
#pragma unroll
                for (int m = 0; m < 4; ++m) { float* op = OUT + (size_t)(row0 + ai * 128 + m * 16) * D + col0 + bj * 128; const float r_ = rstd[ai][m];
                    const pg8::f32x4 a0 = acc[ai][bj][m][0], a1 = acc[ai][bj][m][1];
                    *(f32x4*)(op) = (f32x4){a0[0] * r_ * g8[0], a0[1] * r_ * g8[1], a0[2] * r_ * g8[2], a0[3] * r_ * g8[3]};
                    *(f32x4*)(op + 4) = (f32x4){a1[0] * r_ * g8[4], a1[1] * r_ * g8[5], a1[2] * r_ * g8[6], a1[3] * r_ * g8[7]}; }
        }
    }
};
template <int R> __device__ __forceinline__ void final_rows2(const bf16* X2B, const float* RS, float* OUT, const float* g, int m0, int stride, int lane) {
    u32x4 w0[R], w1[R]; float rs[R];
#pragma unroll
    for (int r = 0; r < R; ++r) { const size_t off = (size_t)(m0 + r * stride) * D + lane * 8; w0[r] = *(const u32x4*)(X2B + off); w1[r] = *(const u32x4*)(X2B + off + 512); rs[r] = RS[m0 + r * stride]; }
    float g0[8], g1[8]; ld8f(g + lane * 8, g0); ld8f(g + 512 + lane * 8, g1);
#pragma unroll
    for (int r = 0; r < R; ++r) { const float rstd = rsqrtf(rs[r] * (1.f / D) + 1e-6f); float a[8], c[8]; unpack8(w0[r], a); unpack8(w1[r], c);
        float* op = OUT + (size_t)(m0 + r * stride) * D + lane * 8;
        *(f32x4*)(op) = (f32x4){a[0] * rstd * g0[0], a[1] * rstd * g0[1], a[2] * rstd * g0[2], a[3] * rstd * g0[3]};
        *(f32x4*)(op + 4) = (f32x4){a[4] * rstd * g0[4], a[5] * rstd * g0[5], a[6] * rstd * g0[6], a[7] * rstd * g0[7]};
        *(f32x4*)(op + 512) = (f32x4){c[0] * rstd * g1[0], c[1] * rstd * g1[1], c[2] * rstd * g1[2], c[3] * rstd * g1[3]};
        *(f32x4*)(op + 516) = (f32x4){c[4] * rstd * g1[4], c[5] * rstd * g1[5], c[6] * rstd * g1[6], c[7] * rstd * g1[7]}; }
}
__device__ __forceinline__ void transpose_item(const float* W, int K, int N, bf16* WT, LAS float* scr, int item, int lane) {
    const int nblk = N / 32, kb = item / nblk, nb = item % nblk, k0 = 64 * kb, n0 = 32 * nb;
#pragma unroll 8
    for (int i = 0; i < 32; ++i) { const int kk = 2 * i + (lane >> 5); scr[kk * 33 + (lane & 31)] = W[(size_t)(k0 + kk) * N + n0 + (lane & 31)]; }
    asm volatile("s_waitcnt lgkmcnt(0)" ::: "memory");
    const int c = lane & 7;
#pragma unroll
    for (int j = 0; j < 4; ++j) { const int n = (lane >> 3) + 8 * j; const LAS float* s = scr + (8 * c) * 33 + n;
        u32x4 o; o.x = pk2(s[0 * 33], s[1 * 33]); o.y = pk2(s[2 * 33], s[3 * 33]); o.z = pk2(s[4 * 33], s[5 * 33]); o.w = pk2(s[6 * 33], s[7 * 33]);
        *(u32x4*)(WT + (size_t)(n0 + n) * K + k0 + 8 * c) = o; }
    asm volatile("s_waitcnt lgkmcnt(0)" ::: "memory");
}
__device__ __forceinline__ void p0_prologue(const Args& A, LAS unsigned char* lds, int tid, int lane, int wave) {
    unsigned char* ws = A.ws;
    {
        const float* c = A.in[1]; const float* w_ada = A.in[2]; const float* b_ada = A.in[3]; float* MOD = (float*)(ws + WS_MOD);
        LAS float* cs = (LAS float*)(lds + LDS_MISC);
        for (int item = blockIdx.x; item < 384; item += gridDim.x) {
            const int kc = item / 12, cb = item % 12;
            __syncthreads();
            if (tid < 256) { const float cv = c[(tid >> 5) * D + kc * 32 + (tid & 31)]; cs[tid] = cv * sigmoidf_(cv); }
            __syncthreads();
            const int col = cb * 512 + tid;
            float acc[8];
#pragma unroll
            for (int b = 0; b < 8; ++b) acc[b] = 0.f;
#pragma unroll 4
            for (int kk = 0; kk < 32; ++kk) { const float w = w_ada[(size_t)(kc * 32 + kk) * NMOD + col];
#pragma unroll
                for (int b = 0; b < 8; ++b) acc[b] += cs[b * 32 + kk] * w; }
            const float bias = (kc == 0) ? b_ada[col] : 0.f;
#pragma unroll
            for (int b = 0; b < 8; ++b) unsafeAtomicAdd(MOD + b * NMOD + col, acc[b] + bias);
        }
        __syncthreads();
    }
    {
        LAS float* scr = (LAS float*)(lds + wave * 16384);
        const int gw = blockIdx.x * NWAVES + wave, NGW = gridDim.x * NWAVES;
        constexpr int I_IN = (D / 64) * (PT / 32), I_OUT = (D / 64) * (D / 32), I_UP = (D / 64) * (FF / 32), I_DN = (FF / 64) * (D / 32);
        for (int it = gw; it < ((CONV_UNDER_S2 && SHADOW_EXTRA) ? I_IN : I_IN + I_OUT + I_UP + I_DN); it += NGW) {
            int r = it;
            if (r < I_IN) { transpose_item(A.in[4], D, PT, (bf16*)(ws + WS_WIN), scr, r, lane); continue; } r -= I_IN;
            if (r < I_OUT) { transpose_item(A.in[17], D, D, (bf16*)(ws + WS_WOUT), scr, r, lane); continue; } r -= I_OUT;
            if (r < I_UP) { transpose_item(A.in[18], D, FF, (bf16*)(ws + WS_WUP), scr, r, lane); continue; } r -= I_UP;
            transpose_item(A.in[19], FF, D, (bf16*)(ws + WS_WDN), scr, r, lane);
        }
    }
    {
        const float* w2 = A.in[8]; const float* a2 = A.in[10]; const float* g2 = A.in[11]; bf16* LT = (bf16*)(ws + WS_LT);
        for (int idx = blockIdx.x * NTHR + tid; idx < LN * LK; idx += gridDim.x * NTHR) {
            const int n = idx >> 8, k = idx & 255; float v = 0.f;
            if (n < 512) { if (k < 64) v = w2[k * 512 + n]; }
            else if (n < 1024) { if (k >= 64 && k < 128) v = a2[(k - 64) * 512 + (n - 512)]; }
            else { if (k >= 128) v = g2[(k - 128) * 512 + (n - 1024)]; }
            LT[idx] = (bf16)(pk2(v, 0.f) & 0xffffu);
        }
    }
}

template <int R> __device__ __forceinline__ void norm_mod_rows(const float* X, bf16* O, const float* MOD, int sh_chunk, int m0, int stride, int lane) {
    f32x4 v[R][4];
#pragma unroll
    for (int r = 0; r < R; ++r) { const f32x4* xr = (const f32x4*)(X + (size_t)(m0 + r * stride) * D) + lane;
#pragma unroll
        for (int j = 0; j < 4; ++j) v[r][j] = __builtin_nontemporal_load(&xr[64 * j]); }
#pragma unroll
    for (int r = 0; r < R; ++r) { const int m = m0 + r * stride; const float* sh = MOD + (m >> 13) * NMOD + sh_chunk * D; const float* sc = sh + D;
        float s = 0.f;
#pragma unroll
        for (int j = 0; j < 4; ++j) s += (v[r][j].x * v[r][j].x + v[r][j].y * v[r][j].y) + (v[r][j].z * v[r][j].z + v[r][j].w * v[r][j].w);
        const float rstd = rsqrtf(wave_sum(s) * (1.f / D) + 1e-6f);
        bf16* orow = O + (size_t)m * D;
#pragma unroll
        for (int j = 0; j < 4; ++j) { const f32x4 a = ((const f32x4*)sc)[lane + 64 * j], b = ((const f32x4*)sh)[lane + 64 * j];
            const f32x4 h = v[r][j] * rstd * (1.f + a) + b;
            ((u32x2*)orow)[lane + 64 * j] = (u32x2){pk2(h.x, h.y), pk2(h.z, h.w)}; } }
}
template <int R> __device__ __forceinline__ void final_rows(float* X, const float* g, int m0, int stride, int lane) {
    f32x4 v[R][4];
#pragma unroll
    for (int r = 0; r < R; ++r) { const f32x4* xr = (const f32x4*)(X + (size_t)(m0 + r * stride) * D) + lane;
#pragma unroll
        for (int j = 0; j < 4; ++j) v[r][j] = xr[64 * j]; }
    f32x4 gv[4];
#pragma unroll
    for (int j = 0; j < 4; ++j) gv[j] = ((const f32x4*)g)[lane + 64 * j];
#pragma unroll
    for (int r = 0; r < R; ++r) { f32x4* xr = (f32x4*)(X + (size_t)(m0 + r * stride) * D) + lane; float s = 0.f;
#pragma unroll
        for (int j = 0; j < 4; ++j) s += (v[r][j].x * v[r][j].x + v[r][j].y * v[r][j].y) + (v[r][j].z * v[r][j].z + v[r][j].w * v[r][j].w);
        const float rstd = rsqrtf(wave_sum(s) * (1.f / D) + 1e-6f);
#pragma unroll
        for (int j = 0; j < 4; ++j) xr[64 * j] = v[r][j] * rstd * gv[j]; }
}
__device__ __forceinline__ size_t pidx(int m, int col) { return ((size_t)((m >> 8) * 13 + (col >> 8)) << 16) + (size_t)(((m & 255) << 8) + (col & 255)); }
#define PAT(mm, cc) (P + pidx((mm), (cc)))
struct ConvRegs { u32x4 bg, c0, u0, c1, u1, c2, u2; };
struct VlRegs { u32x4 vc, vp; u32x2 lc, lp; };
__device__ __forceinline__ void conv_load(ConvRegs& R, const bf16* P, int m, int lane) {
    const int tt = m & (SEQ - 1); const bool has1 = tt >= 1, has2 = tt >= 2;
    const u32x4 zero4 = (u32x4){0u, 0u, 0u, 0u}; const int ch = 8 * lane;
    R.bg = *(const u32x4*)PAT(m, ch); R.c0 = *(const u32x4*)PAT(m, 512 + ch); R.u0 = *(const u32x4*)PAT(m, 1024 + ch);
    R.c1 = has1 ? *(const u32x4*)PAT(m - 1, 512 + ch) : zero4; R.u1 = has1 ? *(const u32x4*)PAT(m - 1, 1024 + ch) : zero4;
    R.c2 = has2 ? *(const u32x4*)PAT(m - 2, 512 + ch) : zero4; R.u2 = has2 ? *(const u32x4*)PAT(m - 2, 1024 + ch) : zero4;
}
__device__ __forceinline__ void conv_compute(const Args& A, const ConvRegs& R, int m, int lane) {
    const int ch = 8 * lane; const float* cw = A.in[5];
    float bg[8], c0[8], u0[8], c1[8], u1[8], c2[8], u2[8], w0[8], w1[8], w2[8], y[8];
    unpack8(R.bg, bg); unpack8(R.c0, c0); unpack8(R.u0, u0); unpack8(R.c1, c1); unpack8(R.u1, u1); unpack8(R.c2, c2); unpack8(R.u2, u2);
    ld8f(cw + ch, w0); ld8f(cw + 512 + ch, w1); ld8f(cw + 1024 + ch, w2);
#pragma unroll
    for (int i = 0; i < 8; ++i) y[i] = bg[i] * (w0[i] * (c2[i] * u2[i]) + w1[i] * (c1[i] * u1[i]) + w2[i] * (c0[i] * u0[i]));
    *(u32x4*)((bf16*)(A.ws + WS_MIX) + (size_t)m * D + ch) = pack8(y);
}
__device__ __forceinline__ void vl_load(VlRegs& R, const bf16* P, int m, int lane) {
    const int tt = m & (SEQ - 1); const bool has1 = tt >= 1;
    const u32x4 zero4 = (u32x4){0u, 0u, 0u, 0u}; const int ch = 8 * lane, c4 = 4 * lane;
    R.vc = *(const u32x4*)PAT(m, PCONV + 1024 + ch); R.lc = *(const u32x2*)PAT(m, PCONV + 1536 + c4);
    R.vp = has1 ? *(const u32x4*)PAT(m - 1, PCONV + 1024 + ch) : zero4; R.lp = has1 ? *(const u32x2*)PAT(m - 1, PCONV + 1536 + c4) : (u32x2){0u, 0u};
}
__device__ __forceinline__ void vl_compute(const Args& A, const VlRegs& R, int m, int lane) {
    unsigned char* ws = A.ws; const int ch = 8 * lane; const float* mu = A.in[6];
    {
        float cur[8], prv[8], mv[8], o[8];
        unpack8(R.vc, cur); unpack8(R.vp, prv); ld8f(mu + 1024 + ch, mv);
#pragma unroll
        for (int i = 0; i < 8; ++i) o[i] = cur[i] + (prv[i] - cur[i]) * mv[i];
        *(u32x4*)((bf16*)(ws + WS_VL) + (size_t)m * RW + ch) = pack8(o);
    }
    {
        const int c4 = 4 * lane;
        const u32x2 cw = R.lc, pw = R.lp;
        const f32x4 mv = *(const f32x4*)(mu + 1536 + c4);
        float cur[4] = {bflo(cw.x), bfhi(cw.x), bflo(cw.y), bfhi(cw.y)}, prv[4] = {bflo(pw.x), bfhi(pw.x), bflo(pw.y), bfhi(pw.y)}, o[4];
#pragma unroll
        for (int i = 0; i < 4; ++i) { const float xl = cur[i] + (prv[i] - cur[i]) * mv[i];
            const float sg = sigmoidf_(lane < 16 ? 2.0f * xl : xl);
            o[i] = lane < 16 ? (2.0f * sg - 1.0f) : (lane < 32 ? xl : sg); }
        *(u32x2*)((bf16*)(ws + WS_LA) + (size_t)m * LK + c4) = (u32x2){pk2(o[0], o[1]), pk2(o[2], o[3])};
    }
}
__device__ __forceinline__ void conv_pass(const Args& A, int w0, int nw, int lane) {
    const bf16* Pp = (const bf16*)(A.ws + WS_P); ConvRegs Ra, Rb; int m = w0;
    if (m < M) conv_load(Ra, Pp, m, lane);
    for (; m < M; m += 2 * nw) { const bool hb = m + nw < M;
        if (hb) conv_load(Rb, Pp, m + nw, lane);
        conv_compute(A, Ra, m, lane);
        if (m + 2 * nw < M) conv_load(Ra, Pp, m + 2 * nw, lane);
        if (hb) conv_compute(A, Rb, m + nw, lane); }
}
__device__ __forceinline__ void vl_pass(const Args& A, int w0, int nw, int lane) {
    const bf16* Pp = (const bf16*)(A.ws + WS_P); VlRegs Ra, Rb; int m = w0;
    if (m < M) vl_load(Ra, Pp, m, lane);
    for (; m < M; m += 2 * nw) { const bool hb = m + nw < M;
        if (hb) vl_load(Rb, Pp, m + nw, lane);
        vl_compute(A, Ra, m, lane);
        if (m + 2 * nw < M) vl_load(Ra, Pp, m + 2 * nw, lane);
        if (hb) vl_compute(A, Rb, m + nw, lane); }
}
template <int R> __device__ __forceinline__ void post_rows(const Args& A, int m0, int stride, int lane) {
    unsigned char* ws = A.ws;
    const int ch = 8 * lane;
    f32x4 y0[R], y1[R]; u32x4 rw[R], kw[R], vw[R], gw_[R];
#pragma unroll
    for (int r = 0; r < R; ++r) { const size_t off = (size_t)(m0 + r * stride) * RW + ch;
        y0[r] = *(const f32x4*)((const float*)(ws + WS_Y) + off); y1[r] = *(const f32x4*)((const float*)(ws + WS_Y) + off + 4);
        rw[r] = *(const u32x4*)((const bf16*)(ws + WS_RL) + off); kw[r] = *(const u32x4*)((const bf16*)(ws + WS_KP) + off);
        vw[r] = *(const u32x4*)((const bf16*)(ws + WS_VL) + off); gw_[r] = *(const u32x4*)((const bf16*)(ws + WS_G) + off); }
    float rk[8], lg[8], lb[8];
    ld8f(A.in[14] + ch, rk); ld8f(A.in[15] + ch, lg); ld8f(A.in[16] + ch, lb);
#pragma unroll
    for (int r = 0; r < R; ++r) {
        float y[8] = {y0[r].x, y0[r].y, y0[r].z, y0[r].w, y1[r].x, y1[r].y, y1[r].z, y1[r].w}, rr[8], kp[8], v[8], g[8], o[8];
        unpack8(rw[r], rr); unpack8(kw[r], kp); unpack8(vw[r], v); unpack8(gw_[r], g);
        float s = 0.f, bs = 0.f;
#pragma unroll
        for (int i = 0; i < 8; ++i) { s += y[i]; bs += rr[i] * kp[i] * rk[i]; }
        s = sum8(s); bs = sum8(bs);
        const float mean = s * (1.f / 64.f); float q = 0.f;
#pragma unroll
        for (int i = 0; i < 8; ++i) { y[i] -= mean; q += y[i] * y[i]; }
        q = sum8(q);
        const float rstd = rsqrtf(q * (1.f / 64.f) + 64e-5f);
#pragma unroll
        for (int i = 0; i < 8; ++i) o[i] = (y[i] * rstd * lg[i] + lb[i] + bs * v[i]) * g[i];
        *(u32x4*)((bf16*)(ws + WS_MIX) + (size_t)(m0 + r * stride) * D + 512 + ch) = pack8(o); }
}

constexpr int TC = 32, NCH = SEQ / TC;
constexpr int OPB = 5 * TC * 256 + TC * 64;
constexpr int YB_OFF = 2 * OPB, DUMP_OFF = YB_OFF + 4096;
static_assert(DUMP_OFF + 4608 <= 131072, "scan LDS");
#define SCAN_BAR() do { asm volatile("s_waitcnt lgkmcnt(0)" ::: "memory"); __builtin_amdgcn_s_barrier(); asm volatile("" ::: "memory"); } while (0)
template <int CTRL> __device__ __forceinline__ float dpp_add(float x) {
    return x + __builtin_bit_cast(float, __builtin_amdgcn_update_dpp(0, __builtin_bit_cast(int, x), CTRL, 0xf, 0xf, false));
}
__device__ __forceinline__ float rsum16(float x) { x = dpp_add<0x128>(x); x = dpp_add<0x124>(x); x = dpp_add<0x122>(x); x = dpp_add<0x121>(x); return x; }
struct ScanRegs { u32x4 rl, kp, kk, bv, vv; f32x4 d0, d1; };
__device__ __forceinline__ void st8(LAS unsigned char* p, const u32x4 w) {
    *(LAS f32x4*)p = (f32x4){bflo(w.x), bfhi(w.x), bflo(w.y), bfhi(w.y)}; *(LAS f32x4*)(p + 16) = (f32x4){bflo(w.z), bfhi(w.z), bflo(w.w), bfhi(w.w)};
}
__device__ __forceinline__ void scan_phase(unsigned char* ws, LAS unsigned char* lds, int tid, int lane, int wid) {
    const bf16* RL = (const bf16*)(ws + WS_RL); const bf16* KP = (const bf16*)(ws + WS_KP); const bf16* KK = (const bf16*)(ws + WS_KK);
    const bf16* BV = (const bf16*)(ws + WS_BV); const bf16* VL = (const bf16*)(ws + WS_VL); const float* DEC = (const float*)(ws + WS_DEC);
    float* Y = (float*)(ws + WS_Y);
    for (int item = blockIdx.x; item < 256; item += gridDim.x) {
        const int xcd = item & 7, slot = item >> 3, bh = xcd * 8 + (slot >> 2), q = slot & 3, b = bh >> 3, h = bh & 7;
        const size_t rowbase = (size_t)b * SEQ;
        const bool loader = wid >= 4;
        const int L = tid - 256;
        const int lt = L >> 3, lc = (L & 7) * 8;
        ScanRegs R;
#define SCAN_ISSUE(cc) do { const size_t o_ = (rowbase + (size_t)(cc) * TC + lt) * RW + h * 64 + lc; \
            R.rl = *(const u32x4*)(RL + o_); R.kp = *(const u32x4*)(KP + o_); R.kk = *(const u32x4*)(KK + o_); R.bv = *(const u32x4*)(BV + o_); \
            R.d0 = *(const f32x4*)(DEC + o_); R.d1 = *(const f32x4*)(DEC + o_ + 4); \
            if (wid == 4) R.vv = *(const u32x4*)(VL + (rowbase + (size_t)(cc) * TC + (lane >> 1)) * RW + h * 64 + q * 16 + (lane & 1) * 8); } while (0)
#define SCAN_WRITE(buf) do { LAS unsigned char* ob_ = lds + (buf) * OPB + lt * 256 + lc * 4; \
            st8(ob_ + 0 * TC * 256, R.rl); *(LAS f32x4*)(ob_ + 1 * TC * 256) = R.d0; *(LAS f32x4*)(ob_ + 1 * TC * 256 + 16) = R.d1; \
            st8(ob_ + 2 * TC * 256, R.kp); st8(ob_ + 3 * TC * 256, R.kk); st8(ob_ + 4 * TC * 256, R.bv); \
            if (wid == 4) st8(lds + (buf) * OPB + 5 * TC * 256 + (lane >> 1) * 64 + (lane & 1) * 32, R.vv); } while (0)
#define SCAN_FLUSH(cc) do { if (L < 128) { const f32x4 yv_ = *(LAS const f32x4*)(lds + YB_OFF + ((cc) & 1) * 2048 + (L >> 2) * 64 + (L & 3) * 16); \
            *(f32x4*)(Y + (rowbase + (size_t)(cc) * TC + (L >> 2)) * RW + h * 64 + q * 16 + (L & 3) * 4) = yv_; } } while (0)
        const int rg = lane >> 4, cl = lane & 15, rb = (wid & 3) * 4 + rg;
        f32x2 S01 = (f32x2){0.f, 0.f}, S23 = (f32x2){0.f, 0.f};
        const unsigned opoff = cl * 16, voff = 5 * TC * 256 + rb * 4;
        const unsigned ybase = (cl == 0) ? (unsigned)(YB_OFF + rb * 4) : (unsigned)(DUMP_OFF + lane * 4);
        if (loader) { SCAN_ISSUE(0); SCAN_WRITE(0); SCAN_ISSUE(1); }
        SCAN_BAR();
        for (int c = 0; c < NCH; ++c) {
            if (!loader) {
                LAS const unsigned char* ob = lds + (c & 1) * OPB;
                LAS unsigned char* yb = lds + ybase + (c & 1) * 2048;
                f32x4 r_[3], w_[3], k_[3], a_[3], b_[3]; float v_[3];
#define SCAN_LD(st, tt) do { r_[st] = *(LAS const f32x4*)(ob + opoff + (0 * TC + (tt)) * 256); w_[st] = *(LAS const f32x4*)(ob + opoff + (1 * TC + (tt)) * 256); \
                    k_[st] = *(LAS const f32x4*)(ob + opoff + (2 * TC + (tt)) * 256); a_[st] = *(LAS const f32x4*)(ob + opoff + (3 * TC + (tt)) * 256); \
                    b_[st] = *(LAS const f32x4*)(ob + opoff + (4 * TC + (tt)) * 256); v_[st] = *(LAS const float*)(ob + voff + (tt) * 64); } while (0)
                SCAN_LD(0, 0); SCAN_LD(1, 1);
#pragma unroll
                for (int t = 0; t < TC; ++t) {
                    const int st = t % 3;
                    if (t + 2 < TC) SCAN_LD((t + 2) % 3, t + 2);
                    const f32x4 r = r_[st], w = w_[st], k = k_[st], a = a_[st], bb = b_[st]; const float v = v_[st];
                    const f32x2 sp2 = S01 * (f32x2){a.x, a.y} + S23 * (f32x2){a.z, a.w};
                    const float sa = rsum16(sp2.x + sp2.y);
                    const f32x2 vv = (f32x2){v, v}, nsa = (f32x2){-sa, -sa};
                    const f32x2 t01 = vv * (f32x2){k.x, k.y} + nsa * (f32x2){bb.x, bb.y};
                    const f32x2 t23 = vv * (f32x2){k.z, k.w} + nsa * (f32x2){bb.z, bb.w};
                    S01 = S01 * (f32x2){w.x, w.y} + t01;
                    S23 = S23 * (f32x2){w.z, w.w} + t23;
                    const f32x2 yp2 = S01 * (f32x2){r.x, r.y} + S23 * (f32x2){r.z, r.w};
                    const float yv = rsum16(yp2.x + yp2.y);
                    *(LAS float*)(yb + t * 64) = yv;
                }
#undef SCAN_LD
            } else {
                if (c + 1 < NCH) SCAN_WRITE((c + 1) & 1);
                if (c + 2 < NCH) SCAN_ISSUE(c + 2);
                if (c >= 1) SCAN_FLUSH(c - 1);
            }
            SCAN_BAR();
        }
        if (loader) SCAN_FLUSH(NCH - 1);
        SCAN_BAR();
#undef SCAN_ISSUE
#undef SCAN_WRITE
#undef SCAN_FLUSH
    }
}

#ifndef SCAN_CHUNKED
#define SCAN_CHUNKED 1
#endif
constexpr size_t WS_AH = 768 * MiB  , WS_NN = 992 * MiB, WS_MA = 832 * MiB;
constexpr size_t OUT_BK = 0, OUT_PC = 128 * MiB, OUT_RT = 160 * MiB;
constexpr int S1_XA = 0, S1_XB = 2304, S1_XK = 4608, S1_XR = 6912, S1_AHL = 9216, S1_NABT = 11520, S1_TT = 12544, S1_NAK = 13824, S1_WAVE = 15360;
typedef short bf16x8 __attribute__((ext_vector_type(8)));
__device__ __forceinline__ float bf2f(unsigned short v) { return __uint_as_float(((unsigned)v) << 16); }
__device__ __forceinline__ unsigned short f2bf1(float f) { return (unsigned short)(pk2(f, 0.f) & 0xffffu); }
__device__ __forceinline__ bf16x8 mk8(unsigned a, unsigned b, unsigned c, unsigned d) { return __builtin_bit_cast(bf16x8, (u32x4){a, b, c, d}); }
#define MFMA16(a, b, c) __builtin_amdgcn_mfma_f32_16x16x32_bf16((a), (b), (c), 0, 0, 0)

__device__ __forceinline__ void s1_item(unsigned char* ws, unsigned char* outb, const float* rkp, const float* kap, const float* mup, const float* kkp, LAS unsigned char* wl, int ci, int lane) {
    const int bh = ci >> 9, c = ci & 511, b = bh >> 3, h = bh & 7;
    const size_t goff = ((size_t)b * SEQ + (size_t)c * 16) * RW + h * 64 + lane;
    const bf16* LW = (const bf16*)(ws + WS_DEC); const bf16* AVg = (const bf16*)(ws + WS_KP); const bf16* Pg = (const bf16*)(ws + WS_P);
    const int m0 = b * SEQ + c * 16, colr = PCONV + h * 64 + lane, colk = colr + 512;
    float lw[16]; unsigned short a_[16], pr_[17], pk_[17];
#pragma unroll
    for (int t = 0; t < 16; ++t) { const size_t o = goff + (size_t)t * RW; lw[t] = bf2f(LW[o]); a_[t] = AVg[o]; pr_[t + 1] = Pg[pidx(m0 + t, colr)]; pk_[t + 1] = Pg[pidx(m0 + t, colk)]; }
    if (c > 0) { pr_[0] = Pg[pidx(m0 - 1, colr)]; pk_[0] = Pg[pidx(m0 - 1, colk)]; } else { pr_[0] = 0; pk_[0] = 0; }
    const float mur = mup[h * 64 + lane], muk = mup[512 + h * 64 + lane], kkc = kkp[h * 64 + lane];
    float rv[16], kv[16], kkn[16];
#pragma unroll
    for (int t = 0; t < 16; ++t) { const float rc = bf2f(pr_[t + 1]), rp = bf2f(pr_[t]), kc = bf2f(pk_[t + 1]), kp0 = bf2f(pk_[t]);
        rv[t] = rc + (rp - rc) * mur; kv[t] = kc + (kp0 - kc) * muk; const float kx = kv[t] * kkc; kkn[t] = kx; }
#pragma unroll
    for (int t = 0; t < 16; ++t) { float ss = rsum16(kkn[t] * kkn[t]);
        { const int si_ = __builtin_bit_cast(int, ss);
          ss = __builtin_bit_cast(float, __builtin_amdgcn_readlane(si_, 0)) + __builtin_bit_cast(float, __builtin_amdgcn_readlane(si_, 16)) + __builtin_bit_cast(float, __builtin_amdgcn_readlane(si_, 32)) + __builtin_bit_cast(float, __builtin_amdgcn_readlane(si_, 48)); }
        kkn[t] *= 1.0f / fmaxf(sqrtf(ss), 1e-12f); }
    float lp[16]; { float acc = 0.f;
#pragma unroll
        for (int t = 0; t < 16; ++t) { acc += lw[t]; lp[t] = acc; } }
    const float lpc = lp[15];
    float At[16], Bh[16], Kh[16];
    const float rkh = rkp[h * 64 + lane], kah = kap[h * 64 + lane];
#pragma unroll
    for (int t = 0; t < 16; ++t) {
        const float P = __expf(lp[t]), Pm1 = __expf(lp[t] - lw[t]), iP = __expf(-lp[t]), PcP = __expf(lpc - lp[t]);
        const float kkf = kkn[t], af_ = bf2f(a_[t]), bvf = kkf * af_, kpf = kv[t] * (1.0f + (af_ - 1.0f) * kah), rf = rv[t];
        At[t] = -kkf * Pm1; Bh[t] = bvf * PcP; Kh[t] = kpf * PcP;
        *(LAS unsigned short*)(wl + S1_XA + t * 144 + lane * 2) = f2bf1(At[t]);
        *(LAS unsigned short*)(wl + S1_XB + t * 144 + lane * 2) = f2bf1(bvf * iP);
        *(LAS unsigned short*)(wl + S1_XK + t * 144 + lane * 2) = f2bf1(kpf * iP);
        *(LAS unsigned short*)(wl + S1_XR + t * 144 + lane * 2) = f2bf1(rf * P);
        *(LAS unsigned short*)(wl + S1_AHL + t * 144 + lane * 2) = f2bf1(rf * P * rkh);
    }
    const int m = lane & 15, q = lane >> 4;
    bf16x8 fa[2], fb[2], fk[2], fr[2];
#pragma unroll
    for (int ks = 0; ks < 2; ++ks) { const int o = m * 144 + (8 * q + 32 * ks) * 2;
        fa[ks] = *(LAS const bf16x8*)(wl + S1_XA + o); fb[ks] = *(LAS const bf16x8*)(wl + S1_XB + o);
        fk[ks] = *(LAS const bf16x8*)(wl + S1_XK + o); fr[ks] = *(LAS const bf16x8*)(wl + S1_XR + o); }
    const f32x4 z4 = (f32x4){0.f, 0.f, 0.f, 0.f};
    f32x4 nab = MFMA16(fb[0], fa[0], z4); nab = MFMA16(fb[1], fa[1], nab);
    f32x4 nak = MFMA16(fk[0], fa[0], z4); nak = MFMA16(fk[1], fa[1], nak);
    f32x4 nbr = MFMA16(fb[0], fr[0], z4); nbr = MFMA16(fb[1], fr[1], nbr);
    f32x4 nkr = MFMA16(fk[0], fr[0], z4); nkr = MFMA16(fk[1], fr[1], nkr);
    {
        bf16x8 frk0 = *(LAS const bf16x8*)(wl + S1_AHL + m * 144 + (8 * q) * 2), frk1 = *(LAS const bf16x8*)(wl + S1_AHL + m * 144 + (8 * q + 32) * 2);
        f32x4 cb = MFMA16(fk[0], frk0, z4); cb = MFMA16(fk[1], frk1, cb);
        const float cd = (m & 3) == 0 ? cb[0] : ((m & 3) == 1 ? cb[1] : ((m & 3) == 2 ? cb[2] : cb[3]));
        if (q == (m >> 2)) ((float*)(outb + OUT_PC))[(size_t)ci * 256 + 64 + m] = cd;
        asm volatile("s_waitcnt lgkmcnt(0)" ::: "memory");
    }
#pragma unroll
    for (int i = 0; i < 4; ++i) { const int s = 4 * q + i;
        nab[i] = (s < m) ? nab[i] : 0.f; nak[i] = (s < m) ? nak[i] : 0.f; nbr[i] = (s <= m) ? nbr[i] : 0.f; nkr[i] = (s <= m) ? nkr[i] : 0.f; }
    __builtin_nontemporal_store((u32x4){pk2(nbr[0], nbr[1]), pk2(nbr[2], nbr[3]), pk2(nkr[0], nkr[1]), pk2(nkr[2], nkr[3])}, (u32x4*)((bf16*)(ws + WS_NN) + (size_t)ci * 512 + lane * 8));
    *(LAS f32x4*)(wl + S1_NABT + m * 64 + q * 16) = nab;
#pragma unroll
    for (int i = 0; i < 4; ++i) *(LAS float*)(wl + S1_NAK + (4 * q + i) * 64 + m * 4) = nak[i];
    float Tr[16];
#pragma unroll
    for (int t = 0; t < 16; ++t) {
        float acc = (m == t) ? 1.f : 0.f;
#pragma unroll
        for (int j4 = 0; j4 < (t + 3) / 4; ++j4) { const f32x4 nv = *(LAS const f32x4*)(wl + S1_NABT + t * 64 + j4 * 16);
#pragma unroll
            for (int jj = 0; jj < 4; ++jj) if (4 * j4 + jj < t) acc += Tr[4 * j4 + jj] * nv[jj]; }
        Tr[t] = acc;
        *(LAS float*)(wl + S1_TT + t * 80 + m * 4) = acc;
    }
#pragma unroll
    for (int t = 0; t < 16; ++t) {
        float acc = 0.f;
#pragma unroll
        for (int s4 = 0; s4 < t / 4 + 1; ++s4) { const f32x4 tv = *(LAS const f32x4*)(wl + S1_TT + t * 80 + s4 * 16);
#pragma unroll
            for (int ss = 0; ss < 4; ++ss) if (4 * s4 + ss <= t) acc += tv[ss] * At[4 * s4 + ss]; }
        *(LAS unsigned short*)(wl + S1_AHL + t * 144 + lane * 2) = f2bf1(acc);
    }
    {
        f32x4 tt[4];
#pragma unroll
        for (int s4 = 0; s4 < 4; ++s4) tt[s4] = *(LAS const f32x4*)(wl + S1_TT + m * 80 + s4 * 16);
        float mak[4];
#pragma unroll
        for (int i = 0; i < 4; ++i) { float acc = 0.f;
#pragma unroll
            for (int s4 = 0; s4 < 4; ++s4) { const f32x4 nv = *(LAS const f32x4*)(wl + S1_NAK + (4 * q + i) * 64 + s4 * 16);
                acc += tt[s4][0] * nv[0] + tt[s4][1] * nv[1] + tt[s4][2] * nv[2] + tt[s4][3] * nv[3]; }
            mak[i] = acc; }
        __builtin_nontemporal_store((u32x4){0u, 0u, pk2(mak[0], mak[1]), pk2(mak[2], mak[3])}, (u32x4*)((bf16*)(ws + WS_MA) + (size_t)ci * 512 + lane * 8));
    }
#pragma unroll
    for (int hh = 0; hh < 2; ++hh) {
        const int o = m * 144 + (32 * hh + 4 * q) * 2;
        const u32x2 alo = *(LAS const u32x2*)(wl + S1_AHL + o), ahi = *(LAS const u32x2*)(wl + S1_AHL + o + 32);
        const u32x2 rlo = *(LAS const u32x2*)(wl + S1_XR + o), rhi = *(LAS const u32x2*)(wl + S1_XR + o + 32);
        __builtin_nontemporal_store((u32x4){alo.x, alo.y, ahi.x, ahi.y}, (u32x4*)((bf16*)(ws + WS_AH) + (size_t)ci * 1024 + (hh * 64 + lane) * 8));
        __builtin_nontemporal_store((u32x4){rlo.x, rlo.y, rhi.x, rhi.y}, (u32x4*)((bf16*)(outb + OUT_RT) + (size_t)ci * 1024 + (hh * 64 + lane) * 8));
    }
    {
        bf16* BKg = (bf16*)(outb + OUT_BK) + (size_t)ci * 2048; const int kt = lane >> 4, mm = lane & 15;
#pragma unroll
        for (int qq = 0; qq < 4; ++qq)
            __builtin_nontemporal_store((u32x4){pk2(Bh[4 * qq], Bh[4 * qq + 1]), pk2(Bh[4 * qq + 2], Bh[4 * qq + 3]), pk2(Kh[4 * qq], Kh[4 * qq + 1]), pk2(Kh[4 * qq + 2], Kh[4 * qq + 3])}, (u32x4*)(BKg + (kt * 64 + mm + 16 * qq) * 8));
        ((float*)(outb + OUT_PC))[(size_t)ci * 256 + lane] = __expf(lpc);
    }
    asm volatile("s_waitcnt lgkmcnt(0)" ::: "memory");
}

constexpr int S2_SLOT = 15360, S2_D = 5, S2_NS = S2_D + 2;
constexpr int SO_AH = 0, SO_RT = 2048, SO_MA = 4096, SO_NN = 5120, SO_BK = 6144, SO_V = 10240, SO_PC = 12288, SO_G = 13312;
static_assert(S2_NS * S2_SLOT <= 131072, "S2 ring");
struct S2Ops { bf16x8 ah0, ah1, rt0, rt1, ma, nn, bk0, bk1, bk2, bk3; f32x4 pc0, pc1, pc2, pc3; unsigned vm01, vm23; };
#define S2_DMA(gptr, loff) __builtin_amdgcn_global_load_lds((const unsigned*)(gptr), (LAS unsigned*)(slot_ + (loff)), 16, 0, 2)
#ifndef S2_POST
#define S2_POST 1
#endif
constexpr int S2_YB = S2_NS * S2_SLOT;
static_assert(S2_YB + 8192 <= 131072, "S2 LDS");
__device__ __forceinline__ void s2_phase(unsigned char* ws, unsigned char* outb, const float* rk_, const float* lg_, const float* lb_, LAS unsigned char* lds, int tid, int lane, int wid) {
    const bf16* AHg = (const bf16*)(ws + WS_AH); const bf16* RTg = (const bf16*)(outb + OUT_RT); const bf16* MAg = (const bf16*)(ws + WS_MA); const bf16* NNg = (const bf16*)(ws + WS_NN);
    const bf16* BKg = (const bf16*)(outb + OUT_BK); const float* PCg = (const float*)(outb + OUT_PC); const bf16* VLg = (const bf16*)(ws + WS_VL);
    const bf16* GGg = (const bf16*)(ws + WS_G);
    for (int bh = blockIdx.x; bh < 64; bh += gridDim.x) {
        const int b = bh >> 3, h = bh & 7; const size_t rowbase = (size_t)b * SEQ;
        const int q = lane >> 4, n = lane & 15;
        if (wid == 4 || wid == 5) {
            const int lw = wid - 4;
#define S2_ISSUE(cc) do { LAS unsigned char* slot_ = lds + ((cc) % S2_NS) * S2_SLOT; const size_t ci_ = (size_t)bh * 512 + (cc); \
                if (lw == 0) { S2_DMA(AHg + ci_ * 1024 + lane * 8, SO_AH); S2_DMA(AHg + ci_ * 1024 + 512 + lane * 8, SO_AH + 1024); \
                    S2_DMA(RTg + ci_ * 1024 + lane * 8, SO_RT); S2_DMA(RTg + ci_ * 1024 + 512 + lane * 8, SO_RT + 1024); \
                    S2_DMA(MAg + ci_ * 512 + lane * 8, SO_MA); S2_DMA(NNg + ci_ * 512 + lane * 8, SO_NN); \
                    S2_DMA(GGg + (rowbase + (size_t)(cc) * 16 + (lane >> 3)) * RW + h * 64 + (lane & 7) * 8, SO_G); \
                    S2_DMA(GGg + (rowbase + (size_t)(cc) * 16 + 8 + (lane >> 3)) * RW + h * 64 + (lane & 7) * 8, SO_G + 1024); } \
                else { S2_DMA(BKg + ci_ * 2048 + lane * 8, SO_BK); S2_DMA(BKg + ci_ * 2048 + 512 + lane * 8, SO_BK + 1024); \
                    S2_DMA(BKg + ci_ * 2048 + 1024 + lane * 8, SO_BK + 2048); S2_DMA(BKg + ci_ * 2048 + 1536 + lane * 8, SO_BK + 3072); \
                    S2_DMA(VLg + (rowbase + (size_t)(cc) * 16 + (lane >> 3)) * RW + h * 64 + (lane & 7) * 8, SO_V); \
                    S2_DMA(VLg + (rowbase + (size_t)(cc) * 16 + 8 + (lane >> 3)) * RW + h * 64 + (lane & 7) * 8, SO_V + 1024); \
                    S2_DMA(PCg + ci_ * 256 + lane * 4, SO_PC); } } while (0)
#define S2_WAIT() do { if (lw == 1) asm volatile("s_waitcnt vmcnt(21)" ::: "memory"); else asm volatile("s_waitcnt vmcnt(24)" ::: "memory"); } while (0)
#pragma unroll 1
            for (int cc = 0; cc < S2_D; ++cc) S2_ISSUE(cc);
            S2_WAIT(); __builtin_amdgcn_s_barrier(); asm volatile("" ::: "memory");
#pragma unroll 1
            for (int i = 0; i < 512; ++i) {
                if (i + S2_D < 512) { S2_ISSUE(i + S2_D); S2_WAIT(); } else asm volatile("s_waitcnt vmcnt(0)" ::: "memory");
                __builtin_amdgcn_s_barrier(); asm volatile("" ::: "memory");
            }
#undef S2_ISSUE
#undef S2_WAIT
        } else if (wid >= 6) {
            const int L = (wid - 6) * 64 + lane, pt = L >> 3, c8 = (L & 7) * 8;
            bf16* MIXg = (bf16*)(ws + WS_MIX);
            float lg[8], lb[8]; ld8f(lg_ + h * 64 + c8, lg); ld8f(lb_ + h * 64 + c8, lb);
#define S2P_PROC(cc) do { LAS const unsigned char* yb_ = lds + S2_YB + ((cc) & 1) * 4096 + pt * 256 + c8 * 4; LAS const unsigned char* sl_ = lds + ((cc) % S2_NS) * S2_SLOT; \
                const f32x4 ya_ = *(LAS const f32x4*)yb_, yb2_ = *(LAS const f32x4*)(yb_ + 16); \
                const u32x4 vw_ = *(LAS const u32x4*)(sl_ + SO_V + pt * 128 + c8 * 2); const u32x4 gw__ = *(LAS const u32x4*)(sl_ + SO_G + pt * 128 + c8 * 2); \
                const float bs_ = *(LAS const float*)(sl_ + SO_PC + (64 + pt) * 4); \
                float y_[8] = {ya_.x, ya_.y, ya_.z, ya_.w, yb2_.x, yb2_.y, yb2_.z, yb2_.w}, v_[8], g_[8], o_[8]; \
                unpack8(vw_, v_); unpack8(gw__, g_); \
                float s_ = 0.f; \
                _Pragma("unroll") for (int i_ = 0; i_ < 8; ++i_) s_ += y_[i_]; \
                s_ = dpp_add<0xB1>(s_); s_ = dpp_add<0x4E>(s_); s_ = dpp_add<0x141>(s_); \
                const float mean_ = s_ * (1.f / 64.f); float q_ = 0.f; \
                _Pragma("unroll") for (int i_ = 0; i_ < 8; ++i_) { y_[i_] -= mean_; q_ += y_[i_] * y_[i_]; } \
                q_ = dpp_add<0xB1>(q_); q_ = dpp_add<0x4E>(q_); q_ = dpp_add<0x141>(q_); \
                const float rstd_ = rsqrtf(q_ * (1.f / 64.f) + 64e-5f); \
                _Pragma("unroll") for (int i_ = 0; i_ < 8; ++i_) o_[i_] = (y_[i_] * rstd_ * lg[i_] + lb[i_] + bs_ * v_[i_]) * g_[i_]; \
                *(u32x4*)(MIXg + (rowbase + (size_t)(cc) * 16 + pt) * D + 512 + h * 64 + c8) = pack8(o_); } while (0)
            __builtin_amdgcn_s_barrier(); asm volatile("" ::: "memory");
#pragma unroll 1
            for (int jj = 0; jj < 512; ++jj) {
                if (jj >= 1) S2P_PROC(jj - 1);
                asm volatile("s_waitcnt lgkmcnt(0)" ::: "memory"); __builtin_amdgcn_s_barrier(); asm volatile("" ::: "memory");
            }
            S2P_PROC(511);
#undef S2P_PROC
        } else {
            const int vq = wid;
            __builtin_amdgcn_s_setprio(3);
            f32x4 ST0 = (f32x4){0.f, 0.f, 0.f, 0.f}, ST1 = ST0, ST2 = ST0, ST3 = ST0;
            const f32x4 z4 = ST0;
            S2Ops A_, B_;
#define S2_LOAD(O, cc) do { LAS const unsigned char* sb_ = lds + ((cc) % S2_NS) * S2_SLOT; \
                O.ah0 = *(LAS const bf16x8*)(sb_ + SO_AH + lane * 16); O.ah1 = *(LAS const bf16x8*)(sb_ + SO_AH + 1024 + lane * 16); \
                O.rt0 = *(LAS const bf16x8*)(sb_ + SO_RT + lane * 16); O.rt1 = *(LAS const bf16x8*)(sb_ + SO_RT + 1024 + lane * 16); \
                O.ma = *(LAS const bf16x8*)(sb_ + SO_MA + lane * 16); O.nn = *(LAS const bf16x8*)(sb_ + SO_NN + lane * 16); \
                O.bk0 = *(LAS const bf16x8*)(sb_ + SO_BK + lane * 16); O.bk1 = *(LAS const bf16x8*)(sb_ + SO_BK + 1024 + lane * 16); \
                O.bk2 = *(LAS const bf16x8*)(sb_ + SO_BK + 2048 + lane * 16); O.bk3 = *(LAS const bf16x8*)(sb_ + SO_BK + 3072 + lane * 16); \
                O.pc0 = *(LAS const f32x4*)(sb_ + SO_PC + (0 + 4 * q) * 4); O.pc1 = *(LAS const f32x4*)(sb_ + SO_PC + (16 + 4 * q) * 4); \
                O.pc2 = *(LAS const f32x4*)(sb_ + SO_PC + (32 + 4 * q) * 4); O.pc3 = *(LAS const f32x4*)(sb_ + SO_PC + (48 + 4 * q) * 4); \
                { const LAS unsigned short* vp_ = (const LAS unsigned short*)(sb_ + SO_V + (4 * q) * 128 + (16 * vq + n) * 2); \
                  O.vm01 = (unsigned)vp_[0] | ((unsigned)vp_[64] << 16); O.vm23 = (unsigned)vp_[128] | ((unsigned)vp_[192] << 16); } } while (0)
#define S2_STEP(O, cc) do { \
                const bf16x8 bs0_ = mk8(pk2(ST0[0], ST0[1]), pk2(ST0[2], ST0[3]), pk2(ST1[0], ST1[1]), pk2(ST1[2], ST1[3])); \
                const bf16x8 bs1_ = mk8(pk2(ST2[0], ST2[1]), pk2(ST2[2], ST2[3]), pk2(ST3[0], ST3[1]), pk2(ST3[2], ST3[3])); \
                const bf16x8 vb_ = mk8(0u, 0u, O.vm01, O.vm23); \
                f32x4 ut_ = MFMA16(O.ma, vb_, z4); ut_ = MFMA16(O.ah0, bs0_, ut_); ut_ = MFMA16(O.ah1, bs1_, ut_);     \
                const bf16x8 uv_ = mk8(pk2(ut_[0], ut_[1]), pk2(ut_[2], ut_[3]), O.vm01, O.vm23); \
                f32x4 yt_ = MFMA16(O.rt0, bs0_, z4); yt_ = MFMA16(O.rt1, bs1_, yt_); yt_ = MFMA16(O.nn, uv_, yt_); \
                ST0 = MFMA16(O.bk0, uv_, O.pc0 * ST0); ST1 = MFMA16(O.bk1, uv_, O.pc1 * ST1); ST2 = MFMA16(O.bk2, uv_, O.pc2 * ST2); ST3 = MFMA16(O.bk3, uv_, O.pc3 * ST3); \
                LAS float* yp_ = (LAS float*)(lds + S2_YB + ((cc) & 1) * 4096 + (4 * q) * 256 + (16 * vq + n) * 4); \
                yp_[0] = yt_[0]; yp_[64] = yt_[1]; yp_[128] = yt_[2]; yp_[192] = yt_[3]; } while (0)
            __builtin_amdgcn_s_barrier(); asm volatile("" ::: "memory");
            S2_LOAD(A_, 0);
#pragma unroll 1
            for (int i = 0; i < 512; i += 2) {
                S2_LOAD(B_, i + 1); __builtin_amdgcn_sched_barrier(0);
                S2_STEP(A_, i);
                asm volatile("s_waitcnt lgkmcnt(0)" ::: "memory"); __builtin_amdgcn_s_barrier(); asm volatile("" ::: "memory");
                if (i + 2 < 512) S2_LOAD(A_, i + 2);
                __builtin_amdgcn_sched_barrier(0);
                S2_STEP(B_, i + 1);
                asm volatile("s_waitcnt lgkmcnt(0)" ::: "memory"); __builtin_amdgcn_s_barrier(); asm volatile("" ::: "memory");
            }
#undef S2_LOAD
#undef S2_STEP
        }
        __builtin_amdgcn_s_barrier(); asm volatile("" ::: "memory");
    }
}

#ifndef STAGGER
#define STAGGER 0
#endif
__device__ __forceinline__ void stagger_start(unsigned step_ticks) {
#if STAGGER
    const unsigned ticks = ((blockIdx.x >> 3) & 7u) * step_ticks;
    const unsigned long long t0 = __builtin_amdgcn_s_memrealtime();
    while ((unsigned)(__builtin_amdgcn_s_memrealtime() - t0) < ticks) __builtin_amdgcn_s_sleep(16);
#endif
}
__device__ __forceinline__ void shadow_work(const Args& A, LAS unsigned char* lds, int w0, int nw, int lane, int wave) {
    unsigned char* ws = A.ws;
    LAS float* scr = (LAS float*)(lds + wave * 16384);
    constexpr int I_OUT = (D / 64) * (D / 32), I_UP = (D / 64) * (FF / 32), I_DN = (FF / 64) * (D / 32);
    for (int it = w0; it < I_OUT + I_UP + I_DN; it += nw) {
        int r = it;
        if (r < I_OUT) { transpose_item(A.in[17], D, D, (bf16*)(ws + WS_WOUT), scr, r, lane); continue; } r -= I_OUT;
        if (r < I_UP) { transpose_item(A.in[18], D, FF, (bf16*)(ws + WS_WUP), scr, r, lane); continue; } r -= I_UP;
        transpose_item(A.in[19], FF, D, (bf16*)(ws + WS_WDN), scr, r, lane);
    }
    const float* MOD = (const float*)(ws + WS_MOD); const float* wup = A.in[18]; float* B2 = (float*)(ws + WS_BIAS2);
    for (int it = w0; it < 64 * 32; it += nw) {
        const int n = (it >> 5) * 64 + lane, k0 = (it & 31) * 32;
        float acc[8];
#pragma unroll
        for (int b = 0; b < 8; ++b) acc[b] = 0.f;
#pragma unroll 16
        for (int k = k0; k < k0 + 32; ++k) { const float w = wup[(size_t)k * FF + n];
#pragma unroll
            for (int b = 0; b < 8; ++b) acc[b] += MOD[b * NMOD + 3 * D + k] * w; }
#pragma unroll
        for (int b = 0; b < 8; ++b) unsafeAtomicAdd(B2 + b * FF + n, acc[b]);
    }
}
#define XB_TMO      128
#define XB_XCNT(j)  (256  + 64 * (j))
#define XB_XSUB(j)  (1280 + 64 * (j))
#define XB_XGEN(j)  (2304 + 64 * (j))
#define XB_TOP      3328
#define XB_TOPGEN   3392
#define XCD_BAR_WORDS 3456
#define XB_SPIN_CAP (1u << 18)

__device__ __forceinline__ unsigned xb_ld(unsigned* p)              { return __hip_atomic_load(p, __ATOMIC_RELAXED, __HIP_MEMORY_SCOPE_AGENT); }
__device__ __forceinline__ unsigned xb_add(unsigned* p, unsigned v) { return __hip_atomic_fetch_add(p, v, __ATOMIC_RELAXED, __HIP_MEMORY_SCOPE_AGENT); }
__device__ __forceinline__ unsigned xb_xcc_id() { return (unsigned)__builtin_amdgcn_s_getreg((3 << 11) | 20) & 0xFu; }
#define XB_SPIN(cond, bar) do { unsigned _sp = 0; while (cond) { __builtin_amdgcn_s_sleep(1); \
    if ((++_sp & 255u) == 0u) { if (xb_ld(&(bar)[XB_TMO])) break; if (_sp > XB_SPIN_CAP) { atomicAdd(&(bar)[XB_TMO], 1u); break; } } } } while (0)

struct XcdBarrier {
    unsigned* bar; unsigned x;
    volatile LAS unsigned* st;
};

__device__ __forceinline__ XcdBarrier xcd_barrier_post(unsigned* bar, volatile LAS unsigned* st) {
    XcdBarrier b; b.bar = bar; b.x = xb_xcc_id(); b.st = st;
    if (threadIdx.x == 0) (void)xb_add(&bar[XB_XCNT(b.x)], 1u);
    return b;
}
__device__ __forceinline__ void xcd_barrier_complete(unsigned* bar, unsigned x, unsigned& nloc, unsigned& nx) {
    const unsigned G = gridDim.x * gridDim.y * gridDim.z;
    unsigned sum, cnt, mine, sp = 0u;
    for (;;) {
        sum = 0u; cnt = 0u; mine = 0u;
#pragma unroll
        for (unsigned j = 0; j < 16; ++j) { const unsigned c = xb_ld(&bar[XB_XCNT(j)]); sum += c; cnt += (c > 0u) ? 1u : 0u; mine = (j == x) ? c : mine; }
        if (sum == G) break;
        __builtin_amdgcn_s_sleep(1);
        if ((++sp & 255u) == 0u) { if (xb_ld(&bar[XB_TMO])) break; if (sp > XB_SPIN_CAP) { atomicAdd(&bar[XB_TMO], 1u); break; } }
    }
    nloc = mine > 0u ? mine : 1u; nx = cnt > 0u ? cnt : 1u;
}

__device__ __forceinline__ void xcd_barrier(const XcdBarrier& b) {
    asm volatile("s_waitcnt vmcnt(0)" ::: "memory");
    __syncthreads();
    if (threadIdx.x == 0) {
        unsigned* bar = b.bar;
        __builtin_amdgcn_s_waitcnt(0);
        unsigned nloc = b.st[0], nx = b.st[1];
        if (nloc == 0u) { xcd_barrier_complete(bar, b.x, nloc, nx); b.st[0] = nloc; b.st[1] = nx; }
        const unsigned old = xb_add(&bar[XB_XSUB(b.x)], 1u);
        const unsigned gen = old / nloc;
        if (old + 1u == (gen + 1u) * nloc) {
            __builtin_amdgcn_fence(__ATOMIC_RELEASE, "agent");
            asm volatile("s_waitcnt vmcnt(0)" ::: "memory");
            const unsigned og = xb_add(&bar[XB_TOP], 1u);
            const unsigned tg = og / nx;
            if (og + 1u == (tg + 1u) * nx) xb_add(&bar[XB_TOPGEN], 1u);
            else XB_SPIN(xb_ld(&bar[XB_TOPGEN]) == tg, bar);
            __builtin_amdgcn_fence(__ATOMIC_ACQUIRE, "agent");
            xb_add(&bar[XB_XGEN(b.x)], 1u);
            asm volatile("s_waitcnt vmcnt(0)" ::: "memory");
        } else {
            XB_SPIN(xb_ld(&bar[XB_XGEN(b.x)]) == gen, bar);
            __builtin_amdgcn_fence(__ATOMIC_ACQUIRE, "agent");
            asm volatile("s_waitcnt vmcnt(0)" ::: "memory");
        }
    }
    __syncthreads();
}

constexpr size_t WS_BAR = 896 * 1024;
#ifndef STAGGER2
#define STAGGER2 0
#endif
__device__ __forceinline__ void stagger2(unsigned step_ticks) {
#if STAGGER2
    const unsigned ticks = ((blockIdx.x >> 3) & 7u) * step_ticks;
    const unsigned long long t0 = __builtin_amdgcn_s_memrealtime();
    while ((unsigned)(__builtin_amdgcn_s_memrealtime() - t0) < ticks) __builtin_amdgcn_s_sleep(16);
#endif
}
struct Order13 : pg8::StaticOrder {
    __device__ __forceinline__ void init13(int G_, int c_) { init(M, 12 * 256, G_, c_); }
    __device__ __forceinline__ bool next(int i, pg8::Unit& u) const {
        const long L = (long)i * G + c;
        if (L < nwg) return pg8::StaticOrder::next(i, u);
        const int j = (int)(L - nwg); if (j >= 256) return false;
        u.pm = (j % 8) * 32 + j / 8; u.pn = 12; return true;
    }
};
__global__ void __launch_bounds__(NTHR, 2) fwd_megakernel(Args A) {
    extern __shared__ __attribute__((aligned(16))) unsigned char lds_raw[];
    LAS unsigned char* lds = (LAS unsigned char*)lds_raw;
    cg::grid_group grid = cg::this_grid();
    if (threadIdx.x < 4) ((LAS unsigned*)(lds + LDS_MISC + 1024))[threadIdx.x] = 0u;
    __syncthreads();
    if (A.ph_lo < 0) grid.sync();
    (void)xcd_barrier_post((unsigned*)(A.ws + WS_BAR), (volatile LAS unsigned*)(lds + LDS_MISC + 1024));
    const int tid = threadIdx.x, lane = tid & 63, wave = __builtin_amdgcn_readfirstlane(tid >> 6);
    unsigned char* ws = A.ws;
    const int lo = A.ph_lo, hi = A.ph_hi;
    const int gw = blockIdx.x * NWAVES + wave, NGW = gridDim.x * NWAVES;
    float* MOD = (float*)(ws + WS_MOD);
#ifndef PHASE_MASK
#define PHASE_MASK 0xfff
#endif
#define IN(k) (((PHASE_MASK >> (k)) & 1) && lo <= (k) && (k) < hi)
#ifndef USE_XBAR
#define USE_XBAR 1
#endif
#define GSYNC(k) do { if (USE_XBAR) { XcdBarrier xb_; xb_.bar = (unsigned*)(A.ws + WS_BAR); xb_.x = xb_xcc_id(); xb_.st = (volatile LAS unsigned*)(lds + LDS_MISC + 1024); xcd_barrier(xb_); } else grid.sync(); } while (0)
#define SEAM(k) do { if (IN(k) && IN((k) + 1)) GSYNC(k); } while (0)
#ifndef REPEAT_MASK
#define REPEAT_MASK 0
#endif
#define REP(k) for (int rep_ = 0; rep_ < (((REPEAT_MASK >> (k)) & 1) ? 2 : 1); ++rep_, (void)((rep_ < (((REPEAT_MASK >> (k)) & 1) ? 2 : 1)) ? (grid.sync(), 0) : 0))

    if (IN(0)) { p0_prologue(A, lds, tid, lane, wave); } SEAM(0);
#ifdef EXTRA_SYNCS
    for (int e_ = 0; e_ < EXTRA_SYNCS; ++e_) grid.sync();
#endif
    REP(1) if (IN(1)) {
        int m = gw;
        for (; m + 3 * NGW < M; m += 4 * NGW) norm_mod_rows<4>(A.in[0], (bf16*)(ws + WS_XN), MOD, 0, m, NGW, lane);
        for (; m < M; m += NGW) norm_mod_rows<1>(A.in[0], (bf16*)(ws + WS_XN), MOD, 0, m, NGW, lane);
#if FUSED_RES && !(CONV_UNDER_S2 && SHADOW_EXTRA)
        for (int nn = gw; nn < FF; nn += NGW) {
            const bf16* wrow = (const bf16*)(ws + WS_WUP) + (size_t)nn * D; float wa[8], wb[8];
            unpack8(*(const u32x4*)(wrow + lane * 8), wa); unpack8(*(const u32x4*)(wrow + 512 + lane * 8), wb);
#pragma unroll 1
            for (int b = 0; b < BATCH; ++b) { const float* sh = MOD + b * NMOD + 3 * D; float sa[8], sb[8]; ld8f(sh + lane * 8, sa); ld8f(sh + 512 + lane * 8, sb); float acc_ = 0.f;
#pragma unroll
                for (int i = 0; i < 8; ++i) acc_ += sa[i] * wa[i] + sb[i] * wb[i];
                acc_ = wave_sum(acc_);
                if (lane == 0) ((float*)(ws + WS_BIAS2))[b * FF + nn] = acc_; }
        }
#endif
    } SEAM(1);
#ifdef DUP2N
    if (IN(2)) {
        pg8::Gemm g{(const bf16*)(ws + WS_XN), (const bf16*)(ws + WS_WIN), M, PT, D}; pg8::StaticOrder S; S.init(M, PT, gridDim.x, blockIdx.x);
        EpiNull E{(float*)(ws + WS_MOD) + 60000};
        pg8::gemm_phase<EpiNull, pg8::StaticOrder, true, true>(lds, g, S, E);
    } GSYNC(2);
#endif
#ifdef DUP2
    if (IN(2)) {
        pg8::Gemm g{(const bf16*)(ws + WS_XN), (const bf16*)(ws + WS_WIN), M, PT, D}; pg8::StaticOrder S; S.init(M, PT, gridDim.x, blockIdx.x);
        stagger_start(250); EpiBf<0, true> E{(bf16*)(ws + WS_P), PT};
        pg8::gemm_phase<EpiBf<0, true>, pg8::StaticOrder, true, true>(lds, g, S, E);
    } GSYNC(2);
#endif
    REP(2) if (IN(2)) {
        pg8::Gemm g{(const bf16*)(ws + WS_XN), (const bf16*)(ws + WS_WIN), M, PT, D}; Order13 S; S.init13(gridDim.x, blockIdx.x);
        EpiBf<0, true> E{(bf16*)(ws + WS_P), PT};
        pg8::gemm_phase<EpiBf<0, true>, Order13, true, true>(lds, g, S, E);
    } SEAM(2);
    REP(3) if (IN(3)) {
        vl_pass(A, gw, NGW, lane);
#if !(SCAN_CHUNKED && CONV_UNDER_S2)
        conv_pass(A, gw, NGW, lane);
#endif
    } SEAM(3);
    REP(4) if (IN(4)) {
        pg8::Gemm g{(const bf16*)(ws + WS_LA), (const bf16*)(ws + WS_LT), M, LN, LK}; pg8::StaticOrder S; S.init(M, LN, gridDim.x, blockIdx.x);
        stagger_start(100); EpiLora E{A.in[7], A.in[9], A.in[13], (const bf16*)(ws + WS_KL), (const bf16*)(ws + WS_KK), (float*)(ws + WS_DEC), (bf16*)(ws + WS_KP), (bf16*)(ws + WS_BV), (bf16*)(ws + WS_G)};
        pg8::gemm_phase<EpiLora, pg8::StaticOrder, true, true>(lds, g, S, E);
    } SEAM(4);
#if SCAN_CHUNKED
    if (IN(5)) {
        for (int ci = gw; ci < 64 * 512; ci += NGW) s1_item(ws, (unsigned char*)A.out, A.in[14], A.in[13], A.in[6], A.in[12], lds + wave * S1_WAVE, ci, lane);
#ifdef DUPS1
        grid.sync();
#pragma unroll 1
        for (int ci = gw; ci < 64 * 512; ci += NGW) s1_item(ws, (unsigned char*)A.out, A.in[14], A.in[13], A.in[6], A.in[12], lds + wave * S1_WAVE, ci, lane);
#endif
        GSYNC(5);
#ifdef DUPS2
        s2_phase(ws, (unsigned char*)A.out, A.in[14], A.in[15], A.in[16], lds, tid, lane, wave);
        GSYNC(5);
#endif
#ifdef DUPCONV
        if (blockIdx.x >= 64) conv_pass(A, (blockIdx.x - 64) * NWAVES + wave, (gridDim.x - 64) * NWAVES, lane);
        GSYNC(5);
#endif
        s2_phase(ws, (unsigned char*)A.out, A.in[14], A.in[15], A.in[16], lds, tid, lane, wave);
#if CONV_UNDER_S2
        if (gridDim.x > 64) { if (blockIdx.x >= 64) { conv_pass(A, (blockIdx.x - 64) * NWAVES + wave, (gridDim.x - 64) * NWAVES, lane); if (SHADOW_EXTRA) shadow_work(A, lds, (blockIdx.x - 64) * NWAVES + wave, (gridDim.x - 64) * NWAVES, lane, wave); } }
        else { conv_pass(A, gw, NGW, lane); if (SHADOW_EXTRA) shadow_work(A, lds, gw, NGW, lane, wave); }
#endif
    } SEAM(5);
#else
    REP(5) if (IN(5)) { scan_phase(ws, lds, tid, lane, wave); } SEAM(5);
#endif
#if !(SCAN_CHUNKED && S2_POST)
    REP(6) if (IN(6)) { int m = gw; for (; m + 3 * NGW < M; m += 4 * NGW) post_rows<4>(A, m, NGW, lane); for (; m < M; m += NGW) post_rows<1>(A, m, NGW, lane); } SEAM(6);
#endif
    REP(7) if (IN(7)) {
        pg8::Gemm g{(const bf16*)(ws + WS_MIX), (const bf16*)(ws + WS_WOUT), M, D, D}; pg8::StaticOrder S; S.init(M, D, gridDim.x, blockIdx.x);
#if FUSED_RES
        EpiRes7 E{A.in[0], (bf16*)(ws + WS_X1B), (bf16*)(ws + WS_XN), MOD, (float*)(ws + WS_RS2)};
        pg8::gemm_phase<EpiRes7, pg8::StaticOrder, true, true>(lds, g, S, E);
#else
        stagger_start(500); EpiRes E{A.in[0], A.out, MOD + 2 * D};
        pg8::gemm_phase<EpiRes, pg8::StaticOrder, true, true>(lds, g, S, E);
#endif
    } SEAM(7);
#if !FUSED_RES
    REP(8) if (IN(8)) {
        int m = gw;
        for (; m + 3 * NGW < M; m += 4 * NGW) norm_mod_rows<4>(A.out, (bf16*)(ws + WS_XN), MOD, 3, m, NGW, lane);
        for (; m < M; m += NGW) norm_mod_rows<1>(A.out, (bf16*)(ws + WS_XN), MOD, 3, m, NGW, lane);
    } SEAM(8);
#endif
#ifdef DUP9H
    if (IN(9)) {
        pg8::Gemm g{(const bf16*)(ws + WS_XN), (const bf16*)(ws + WS_WUP), M, FF / 2, D}; pg8::StaticOrder S; S.init(M, FF / 2, gridDim.x, blockIdx.x);
        EpiNull E{(float*)(ws + WS_MOD) + 60000};
        pg8::gemm_phase<EpiNull, pg8::StaticOrder, true, true>(lds, g, S, E);
    } GSYNC(9);
#endif
#ifdef DUP9N
    if (IN(9)) {
        pg8::Gemm g{(const bf16*)(ws + WS_XN), (const bf16*)(ws + WS_WUP), M, FF, D}; pg8::StaticOrder S; S.init(M, FF, gridDim.x, blockIdx.x);
        EpiNull E{(float*)(ws + WS_MOD) + 60000};
        pg8::gemm_phase<EpiNull, pg8::StaticOrder, true, true>(lds, g, S, E);
    } GSYNC(9);
#endif
#ifdef DUP9
    if (IN(9)) {
        pg8::Gemm g{(const bf16*)(ws + WS_XN), (const bf16*)(ws + WS_WUP), M, FF, D}; pg8::StaticOrder S; S.init(M, FF, gridDim.x, blockIdx.x);
        stagger_start(250); EpiBf<1> E{(bf16*)(ws + WS_H), FF};
        pg8::gemm_phase<EpiBf<1>, pg8::StaticOrder, true, true>(lds, g, S, E);
    } grid.sync();
#endif
    REP(9) if (IN(9)) {
        pg8::Gemm g{(const bf16*)(ws + WS_XN), (const bf16*)(ws + WS_WUP), M, FF, D}; pg8::StaticOrder S; S.init(M, FF, gridDim.x, blockIdx.x);
#if FUSED_RES
        stagger2(275); EpiUp2 E{(bf16*)(ws + WS_H), (const float*)(ws + WS_RS2), (const float*)(ws + WS_BIAS2)};
        pg8::gemm_phase<EpiUp2, pg8::StaticOrder, true, true>(lds, g, S, E);
#else
        stagger_start(250); EpiBf<1> E{(bf16*)(ws + WS_H), FF};
        pg8::gemm_phase<EpiBf<1>, pg8::StaticOrder, true, true>(lds, g, S, E);
#endif
    } SEAM(9);
    if (IN(10)) {
        pg8::Gemm g{(const bf16*)(ws + WS_H), (const bf16*)(ws + WS_WDN), M, D, FF}; pg8::StaticOrder S; S.init(M, D, gridDim.x, blockIdx.x);
#if FUSED_RES && FUSED_FINAL
        EpiDownF E{(const bf16*)(ws + WS_X1B), A.out, MOD, A.in[20], (float*)(ws + WS_RS3), (unsigned*)(ws + WS_CNT)};
        pg8::gemm_phase<EpiDownF, pg8::StaticOrder, true, true>(lds, g, S, E);
#elif FUSED_RES
        EpiDown2 E{(const bf16*)(ws + WS_X1B), (bf16*)(ws + WS_X2B), MOD, (float*)(ws + WS_RS3)};
        pg8::gemm_phase<EpiDown2, pg8::StaticOrder, true, true>(lds, g, S, E);
#else
        stagger_start(600); EpiRes E{A.out, A.out, MOD + 5 * D};
        pg8::gemm_phase<EpiRes, pg8::StaticOrder, true, true>(lds, g, S, E);
#endif
    }
#if FUSED_RES && FUSED_FINAL
#elif FUSED_RES
    SEAM(10);
    if (IN(11)) { int m = gw; for (; m + 3 * NGW < M; m += 4 * NGW) final_rows2<4>((const bf16*)(ws + WS_X2B), (const float*)(ws + WS_RS3), A.out, A.in[20], m, NGW, lane);
        for (; m < M; m += NGW) final_rows2<1>((const bf16*)(ws + WS_X2B), (const float*)(ws + WS_RS3), A.out, A.in[20], m, NGW, lane); }
#else
    if (IN(11)) { int m = gw; for (; m + 3 * NGW < M; m += 4 * NGW) final_rows<4>(A.out, A.in[20], m, NGW, lane); for (; m < M; m += NGW) final_rows<1>(A.out, A.in[20], m, NGW, lane); }
#endif
#undef IN
#undef SEAM
}

extern "C" void kernel_launch(void* const* d_in, const int* in_sizes, int n_in, void* d_out, int out_size, void* d_ws, size_t ws_size, hipStream_t stream) {
    static int grid_blocks = 0;
    if (grid_blocks == 0) {
        if (n_in != 21 || out_size != M * D || ws_size < WS_END) { fprintf(stderr, "kernel_launch: unexpected shapes (n_in %d out %d ws %zu)\n", n_in, out_size, ws_size); grid_blocks = -1; return; }
        int dev = 0, cus = 0, per_cu = 0;
        hipGetDevice(&dev);
        hipDeviceGetAttribute(&cus, hipDeviceAttributeMultiprocessorCount, dev);
        if (hipFuncSetAttribute((const void*)fwd_megakernel, hipFuncAttributeMaxDynamicSharedMemorySize, LDS_BYTES) != hipSuccess) { fprintf(stderr, "kernel_launch: hipFuncSetAttribute failed\n"); grid_blocks = -1; return; }
        if (hipOccupancyMaxActiveBlocksPerMultiprocessor(&per_cu, (const void*)fwd_megakernel, NTHR, LDS_BYTES) != hipSuccess || per_cu < 1) { fprintf(stderr, "kernel_launch: occupancy query failed (%d)\n", per_cu); grid_blocks = -1; return; }
        grid_blocks = cus * per_cu;
    }
    if (grid_blocks < 0) return;
    hipMemsetAsync((char*)d_ws + WS_MOD, 0, CTL_ZERO_BYTES, stream);
    Args a{};
    for (int i = 0; i < 21; ++i) a.in[i] = (const float*)d_in[i];
    a.out = (float*)d_out; a.ws = (unsigned char*)d_ws;
#if MK_SPLIT
    for (int ph = 0; ph < NPHASE; ++ph) {
        a.ph_lo = ph; a.ph_hi = ph + 1;
#else
    {
        a.ph_lo = 0; a.ph_hi = NPHASE;
#endif
        void* args[] = {&a};
        hipError_t e = hipLaunchCooperativeKernel((const void*)fwd_megakernel, dim3(grid_blocks), dim3(NTHR), args, LDS_BYTES, stream);
        if (e != hipSuccess) fprintf(stderr, "kernel_launch: cooperative launch failed: %s (grid %d)\n", hipGetErrorString(e), grid_blocks);
    }
}
```

```cpp
#include <hip/hip_runtime.h>
#include <hip/hip_cooperative_groups.h>
#include <cstdio>
#include <cstdint>
namespace cg = cooperative_groups;
namespace pg8 {
#define PG8_LAS __attribute__((address_space(3)))
typedef unsigned short bf16_t;
typedef short bf16x8 __attribute__((ext_vector_type(8)));
typedef float f32x4 __attribute__((ext_vector_type(4)));
typedef unsigned u32x4 __attribute__((ext_vector_type(4)));
constexpr int BM = 256, BK = 64, HALF = 128, HTB = HALF * BK * 2  , STAGE_BYTES = 8 * HTB, NXCD = 8, WGM = 8;

__host__ __device__ __forceinline__ int lds_byte(int r, int c) { const int st = (r >> 4) * 2 + (c >> 5), rr = r & 15, cc = c & 31, ob = rr * 64 + cc * 2; return st * 1024 + (ob ^ (((ob >> 9) & 1) << 5)); }
__host__ __device__ __forceinline__ void stage_rc(int b, int& R, int& C) { const int st = b / 1024, sb = b % 1024, swz = sb ^ (((sb >> 9) & 1) << 5); R = (st >> 1) * 16 + swz / 64; C = (st & 1) * 32 + (swz % 64) / 2; }
__host__ __device__ __forceinline__ int perm32(int rho) { const int n = rho >> 4, i = rho & 15; return 8 * (i >> 2) + 4 * n + (i & 3); }

struct Unit { int pm, pn; };
struct Gemm { const bf16_t* A; const bf16_t* Bt; int M, N, K; };

struct StaticOrder {
    int nM, nN, nwg, G, c;
    __host__ __device__ void init(int M, int N, int G_, int c_) { nM = M / BM; nN = N / BM; nwg = nM * nN; G = G_; c = c_; }
    __host__ __device__ bool next(int i, Unit& u) const {
        const long L = (long)i * G + c; if (L >= nwg) return false;
        int wgid = (int)L; { const int q = nwg / NXCD, r = nwg % NXCD, xcd = wgid % NXCD, off = wgid / NXCD; wgid = (xcd < r ? xcd * (q + 1) : r * (q + 1) + (xcd - r) * q) + off; }
        const int nig = WGM * nN, gid = wgid / nig, fm = gid * WGM, gsz = (nM - fm) < WGM ? (nM - fm) : WGM;
        u.pm = fm + ((wgid % nig) % gsz); u.pn = (wgid % nig) / gsz; return true;
    }
    __device__ __forceinline__ void a_ready(const Unit&) const {}
    __device__ __forceinline__ void done(const Unit&) const {}
};
__device__ __forceinline__ unsigned cvt_pk_bf16(float lo, float hi) { unsigned r; asm volatile("v_cvt_pk_bf16_f32 %0, %1, %2" : "=v"(r) : "v"(lo), "v"(hi)); return r; }
template <class Epi, class Sched, bool ALIGN_EPI = false, bool SP2 = false>
__device__ __forceinline__ void gemm_phase(PG8_LAS unsigned char* lds, const Gemm g, const Sched& S, const Epi& E) {
    const int tid = threadIdx.x, wid = __builtin_amdgcn_readfirstlane(tid >> 6), lane = tid & 63, wr = wid >> 2, wc = wid & 3, fr = lane & 15, fq = lane >> 4;
    const int K = g.K, nt = K / BK;
    unsigned voffA[2], voffB[2];
#pragma unroll
    for (int i = 0; i < 2; ++i) { int R, C; stage_rc(tid * 16 + i * 8192, R, C); const int Rb = Epi::PERM ? ((R & ~31) + perm32(R & 31)) : R;
        voffA[i] = (unsigned)(R * K + C) * 2u; voffB[i] = (unsigned)(Rb * K + C) * 2u; }
    const size_t kstep = (size_t)(BK * 2);
    const size_t hstep = (size_t)HALF * K * 2;
    const size_t tstep = 2 * hstep;
    const unsigned ldsw = (unsigned)wid * 1024u;
    const int aoff = lds_byte(wr * 64 + fr, fq * 8), boff = lds_byte(wc * 32 + fr, fq * 8);
#define PG8_SA(b, h) (((b) * 2 + (h)) * HTB)
#define PG8_SB(b, h) ((4 + (b) * 2 + (h)) * HTB)
#define PG8_STAGE(bufoff, gbase, voff) do { _Pragma("unroll") for (int _i = 0; _i < 2; ++_i) \
        __builtin_amdgcn_global_load_lds((const unsigned*)((const char*)(gbase) + (voff)[_i]), (PG8_LAS unsigned*)(lds + (bufoff) + ldsw + _i * 8192), 16, 0, 0); } while (0)
#define PG8_LDA(dst, b, h) do { _Pragma("unroll") for (int m = 0; m < 4; ++m) _Pragma("unroll") for (int k = 0; k < 2; ++k) dst[m][k] = *(const PG8_LAS bf16x8*)(lds + PG8_SA(b, h) + aoff + m * 2048 + k * 1024); } while (0)
#define PG8_LDB(dst, b, h) do { _Pragma("unroll") for (int n = 0; n < 2; ++n) _Pragma("unroll") for (int k = 0; k < 2; ++k) dst[n][k] = *(const PG8_LAS bf16x8*)(lds + PG8_SB(b, h) + boff + n * 2048 + k * 1024); } while (0)
#define PG8_MMA(ai, bj, At, Bt) do { __builtin_amdgcn_s_setprio(1); _Pragma("unroll") for (int m = 0; m < 4; ++m) _Pragma("unroll") for (int n = 0; n < 2; ++n) _Pragma("unroll") for (int k = 0; k < 2; ++k) \
        acc[ai][bj][m][n] = __builtin_amdgcn_mfma_f32_16x16x32_bf16(Bt[n][k], At[m][k], acc[ai][bj][m][n], 0, 0, 0); __builtin_amdgcn_s_setprio(0); } while (0)
#define PG8_WAIT_V(n) asm volatile("s_waitcnt vmcnt(" #n ")" ::: "memory")
#define PG8_WAIT_L(n) asm volatile("s_waitcnt lgkmcnt(" #n ")" ::: "memory")
#define PG8_BAR __builtin_amdgcn_s_barrier()
#define PG8_SCHED __builtin_amdgcn_sched_barrier(0)
    Unit cur, nxt; int ui = 0;
    if (!S.next(0, cur)) return;
    f32x4 acc[2][2][4][2];
#pragma unroll
    for (int a = 0; a < 2; ++a)
#pragma unroll
        for (int b = 0; b < 2; ++b)
#pragma unroll
            for (int m = 0; m < 4; ++m)
#pragma unroll
                for (int n = 0; n < 2; ++n) acc[a][b][m][n] = (f32x4){0.f, 0.f, 0.f, 0.f};
    bf16x8 At[4][2], B0[2][2], B1[2][2];
    const char* cA = (const char*)g.A + (size_t)cur.pm * tstep; const char* cB = (const char*)g.Bt + (size_t)cur.pn * tstep;
    S.a_ready(cur);
    if constexpr (SP2) {
        PG8_STAGE(PG8_SB(0, 0), cB, voffB); PG8_STAGE(PG8_SB(0, 1), cB + hstep, voffB); PG8_STAGE(PG8_SA(0, 0), cA, voffA); PG8_STAGE(PG8_SA(0, 1), cA + hstep, voffA);
        if (wr == 1) PG8_BAR;
        PG8_WAIT_V(2); PG8_BAR;
        PG8_STAGE(PG8_SB(1, 0), cB + kstep, voffB); PG8_STAGE(PG8_SA(1, 0), cA + kstep, voffA); PG8_STAGE(PG8_SB(1, 1), cB + hstep + kstep, voffB);
        PG8_WAIT_V(6); PG8_BAR;
    } else {
        PG8_STAGE(PG8_SB(0, 0), cB, voffB); PG8_STAGE(PG8_SA(0, 0), cA, voffA); PG8_STAGE(PG8_SB(0, 1), cB + hstep, voffB); PG8_STAGE(PG8_SA(0, 1), cA + hstep, voffA);
        if (wr == 1) PG8_BAR;
        PG8_WAIT_V(4); PG8_BAR;
        PG8_STAGE(PG8_SB(1, 0), cB + kstep, voffB); PG8_STAGE(PG8_SA(1, 0), cA + kstep, voffA); PG8_STAGE(PG8_SB(1, 1), cB + hstep + kstep, voffB);
        PG8_WAIT_V(6); PG8_BAR;
    }
    for (;;) {
        const bool has_next = S.next(ui + 1, nxt);
        const char* nA = has_next ? (const char*)g.A + (size_t)nxt.pm * tstep : cA; const char* nB = has_next ? (const char*)g.Bt + (size_t)nxt.pn * tstep : cB;
#pragma unroll 1
        for (int t = 0; t < nt; t += 2) {
            const bool last = (t == nt - 2);
            const char* a1 = cA + (size_t)(t + 1) * kstep;
            const char* a2 = last ? nA : cA + (size_t)(t + 2) * kstep; const char* b2 = last ? nB : cB + (size_t)(t + 2) * kstep;
            const char* a3 = a2 + kstep; const char* b3 = b2 + kstep;
            if (last && has_next) S.a_ready(nxt);
            if constexpr (SP2) {
            PG8_LDB(B0, 0, 0); PG8_LDB(B1, 0, 1); PG8_SCHED; PG8_LDA(At, 0, 0); PG8_STAGE(PG8_SA(1, 1), a1 + hstep, voffA);
            PG8_WAIT_V(8); PG8_WAIT_L(0); PG8_BAR; PG8_MMA(0, 0, At, B0); PG8_MMA(0, 1, At, B1); PG8_BAR; PG8_SCHED;
            PG8_LDA(At, 0, 1); PG8_STAGE(PG8_SB(0, 0), b2, voffB); PG8_STAGE(PG8_SB(0, 1), b2 + hstep, voffB); PG8_STAGE(PG8_SA(0, 0), a2, voffA);
            PG8_WAIT_V(8); PG8_WAIT_L(0); PG8_BAR; PG8_MMA(1, 0, At, B0); PG8_MMA(1, 1, At, B1); PG8_BAR; PG8_SCHED;
            PG8_LDB(B0, 1, 0); PG8_LDB(B1, 1, 1); PG8_SCHED; PG8_LDA(At, 1, 0); PG8_STAGE(PG8_SA(0, 1), a2 + hstep, voffA);
            PG8_WAIT_V(8); PG8_WAIT_L(0); PG8_BAR; PG8_MMA(0, 0, At, B0); PG8_MMA(0, 1, At, B1); PG8_BAR; PG8_SCHED;
            PG8_LDA(At, 1, 1); PG8_STAGE(PG8_SB(1, 0), b3, voffB); PG8_STAGE(PG8_SB(1, 1), b3 + hstep, voffB); PG8_STAGE(PG8_SA(1, 0), a3, voffA);
            PG8_WAIT_V(8); PG8_WAIT_L(0); PG8_BAR; PG8_MMA(1, 0, At, B0); PG8_MMA(1, 1, At, B1); PG8_BAR; PG8_SCHED;
            } else {
            PG8_LDB(B0, 0, 0); PG8_SCHED; PG8_LDA(At, 0, 0); PG8_STAGE(PG8_SA(1, 1), a1 + hstep, voffA);
            PG8_WAIT_L(8); PG8_BAR; PG8_WAIT_L(0); PG8_MMA(0, 0, At, B0); PG8_BAR; PG8_SCHED;
            PG8_LDB(B1, 0, 1); PG8_STAGE(PG8_SB(0, 0), b2, voffB);
            PG8_BAR; PG8_WAIT_L(0); PG8_MMA(0, 1, At, B1); PG8_BAR;
            PG8_LDA(At, 0, 1); PG8_STAGE(PG8_SA(0, 0), a2, voffA);
            PG8_BAR; PG8_WAIT_L(0); PG8_MMA(1, 0, At, B0); PG8_BAR; PG8_SCHED;
            PG8_STAGE(PG8_SB(0, 1), b2 + hstep, voffB);
            PG8_WAIT_V(6); PG8_BAR; PG8_MMA(1, 1, At, B1); PG8_BAR;
            PG8_LDB(B0, 1, 0); PG8_SCHED; PG8_LDA(At, 1, 0); PG8_STAGE(PG8_SA(0, 1), a2 + hstep, voffA);
            PG8_WAIT_L(8); PG8_BAR; PG8_WAIT_L(0); PG8_MMA(0, 0, At, B0); PG8_BAR; PG8_SCHED;
            PG8_LDB(B1, 1, 1); PG8_STAGE(PG8_SB(1, 0), b3, voffB);
            PG8_BAR; PG8_WAIT_L(0); PG8_MMA(0, 1, At, B1); PG8_BAR;
            PG8_LDA(At, 1, 1); PG8_STAGE(PG8_SA(1, 0), a3, voffA);
            PG8_BAR; PG8_WAIT_L(0); PG8_MMA(1, 0, At, B0); PG8_BAR; PG8_SCHED;
            PG8_STAGE(PG8_SB(1, 1), b3 + hstep, voffB);
            PG8_WAIT_V(6); PG8_BAR; PG8_MMA(1, 1, At, B1); PG8_BAR;
            }
        }
        if constexpr (ALIGN_EPI) { if (wr == 0) PG8_BAR; }
        if constexpr (!Epi::AFTER_DRAIN) { E(acc, cur, wr, wc, fr, fq); S.done(cur); }
        if (!has_next) break;
#pragma unroll
        for (int a = 0; a < 2; ++a)
#pragma unroll
            for (int b = 0; b < 2; ++b)
#pragma unroll
                for (int m = 0; m < 4; ++m)
#pragma unroll
                    for (int n = 0; n < 2; ++n) acc[a][b][m][n] = (f32x4){0.f, 0.f, 0.f, 0.f};
        cur = nxt; cA = nA; cB = nB; ++ui;
        if constexpr (ALIGN_EPI) { if (wr == 1) PG8_BAR; }
    }
    PG8_WAIT_V(0);
    if constexpr (!ALIGN_EPI) { if (wr == 0) PG8_BAR; }
    PG8_BAR;
    if constexpr (Epi::AFTER_DRAIN) { E.fused(acc, cur, wr, wc, fr, fq, lds, wid, lane); S.done(cur); }
#undef PG8_SA
#undef PG8_SB
#undef PG8_STAGE
#undef PG8_LDA
#undef PG8_LDB
#undef PG8_MMA
#undef PG8_WAIT_V
#undef PG8_WAIT_L
#undef PG8_BAR
#undef PG8_SCHED
}
}

#ifndef CONV_UNDER_S2
#define CONV_UNDER_S2 1
#endif
#ifndef SHADOW_EXTRA
#define SHADOW_EXTRA 1
#endif
#ifndef MK_SPLIT
#define MK_SPLIT 0
#endif
constexpr int NWAVES = 8, NTHR = 512;
constexpr int BATCH = 8, SEQ = 8192, D = 1024, M = BATCH * SEQ;
constexpr int PCONV = 1536, PT = 3328, FF = 4096, RW = 512;
constexpr int LK = 256, LN = 1536;
constexpr int NMOD = 6 * D;
constexpr int NPHASE = 12;
constexpr size_t MiB = 1u << 20;
constexpr size_t WS_MOD = 0, WS_RS2 = 256 * 1024, WS_RS3 = 512 * 1024, WS_BIAS2 = 768 * 1024, CTL_ZERO_BYTES = 1024 * 1024;
constexpr size_t WS_X1B = 704ull << 20, WS_X2B = 864ull << 20;
constexpr size_t WS_WIN = 1 * MiB, WS_WOUT = 8 * MiB, WS_WUP = 10 * MiB, WS_WDN = 18 * MiB, WS_LT = 26 * MiB;
constexpr size_t WS_XN = 32 * MiB;
constexpr size_t WS_Y = 32 * MiB;
constexpr size_t WS_P = 160 * MiB;
constexpr size_t WS_DEC = 32 * MiB  , WS_KP = 576 * MiB  , WS_BV = 352 * MiB  , WS_G = 640 * MiB  ;
constexpr size_t WS_H = 160 * MiB;
constexpr size_t WS_RL = 576 * MiB, WS_KL = 640 * MiB, WS_VL = 704 * MiB, WS_KK = 768 * MiB;
constexpr size_t WS_LA = 832 * MiB;
constexpr size_t WS_MIX = 864 * MiB;
constexpr size_t WS_END = 1024 * MiB;
constexpr int LDS_MISC = 131072, LDS_BYTES = 131072 + 2048;

typedef unsigned short bf16;
typedef float f32x4 __attribute__((ext_vector_type(4)));
typedef float f32x2 __attribute__((ext_vector_type(2)));
typedef unsigned u32x4 __attribute__((ext_vector_type(4)));
typedef unsigned u32x2 __attribute__((ext_vector_type(2)));
#define LAS __attribute__((address_space(3)))

typedef __bf16 bf16v2_t __attribute__((ext_vector_type(2)));
__device__ __forceinline__ unsigned pk2(float lo, float hi) { return __builtin_bit_cast(unsigned, __builtin_convertvector((f32x2){lo, hi}, bf16v2_t)); }
__device__ __forceinline__ float bflo(unsigned w) { return __uint_as_float(w << 16); }
__device__ __forceinline__ float bfhi(unsigned w) { return __uint_as_float(w & 0xffff0000u); }
__device__ __forceinline__ void unpack8(const u32x4 w, float (&f)[8]) {
    f[0] = bflo(w.x); f[1] = bfhi(w.x); f[2] = bflo(w.y); f[3] = bfhi(w.y); f[4] = bflo(w.z); f[5] = bfhi(w.z); f[6] = bflo(w.w); f[7] = bfhi(w.w);
}
__device__ __forceinline__ u32x4 pack8(const float (&f)[8]) { u32x4 w; w.x = pk2(f[0], f[1]); w.y = pk2(f[2], f[3]); w.z = pk2(f[4], f[5]); w.w = pk2(f[6], f[7]); return w; }
__device__ __forceinline__ void ld8f(const float* p, float (&f)[8]) { const f32x4 a = *(const f32x4*)p, b = *(const f32x4*)(p + 4); f[0] = a.x; f[1] = a.y; f[2] = a.z; f[3] = a.w; f[4] = b.x; f[5] = b.y; f[6] = b.z; f[7] = b.w; }
__device__ __forceinline__ float wave_sum(float v) {
#pragma unroll
    for (int o = 1; o < 64; o <<= 1) v += __shfl_xor(v, o);
    return v;
}
__device__ __forceinline__ float sum8(float v) { v += __shfl_xor(v, 1); v += __shfl_xor(v, 2); v += __shfl_xor(v, 4); return v; }
__device__ __forceinline__ float sigmoidf_(float x) { return 1.0f / (1.0f + __expf(-x)); }

struct Args { const float* in[21]; float* out; unsigned char* ws; int ph_lo, ph_hi; };

template <int ACT  , bool TILED = false> struct EpiBf {
    static constexpr bool PERM = true, AFTER_DRAIN = false;
    bf16* O; int ldc;
    __device__ __forceinline__ void operator()(const pg8::f32x4 (&acc)[2][2][4][2], const pg8::Unit& u, int wr, int wc, int fr, int fq) const {
        const int row0 = u.pm * 256 + wr * 64 + fr, col0 = u.pn * 256 + wc * 32 + 8 * fq;
        unsigned long long rp = (unsigned long long)(TILED ? O + ((size_t)(u.pm * 13 + u.pn) << 16) + (size_t)(wr * 64 + fr) * 256 + wc * 32 + 8 * fq : O + (size_t)row0 * ldc + col0);
        const unsigned long long rstep = (unsigned long long)(TILED ? 256 : ldc) * 2ull;
#pragma unroll
        for (int ai = 0; ai < 2; ++ai)
#pragma unroll
            for (int m = 0; m < 4; ++m) { bf16* rowp = (bf16*)rp;
#pragma unroll
                for (int bj = 0; bj < 2; ++bj) { pg8::f32x4 v0 = acc[ai][bj][m][0], v1 = acc[ai][bj][m][1];
                    if (ACT == 1) {
#pragma unroll
                        for (int j = 0; j < 4; ++j) { const float a = fmaxf(v0[j], 0.f), b = fmaxf(v1[j], 0.f); v0[j] = a * a; v1[j] = b * b; } }
                    u32x4 w; w.x = pk2(v0[0], v0[1]); w.y = pk2(v0[2], v0[3]); w.z = pk2(v1[0], v1[1]); w.w = pk2(v1[2], v1[3]);
                    *(u32x4*)(rowp + bj * 128) = w; }
                rp += (m == 3 ? 80ull : 16ull) * rstep;
                asm volatile("" : "+v"(rp) :: "memory"); }
    }
};
struct EpiNull { static constexpr bool PERM = true, AFTER_DRAIN = false; float* sink;
    __device__ __forceinline__ void operator()(const pg8::f32x4 (&acc)[2][2][4][2], const pg8::Unit& u, int wr, int wc, int fr, int fq) const {
        float s = 0.f;
#pragma unroll
        for (int ai = 0; ai < 2; ++ai)
#pragma unroll
            for (int bj = 0; bj < 2; ++bj)
#pragma unroll
                for (int m = 0; m < 4; ++m)
#pragma unroll
                    for (int n = 0; n < 2; ++n) s += acc[ai][bj][m][n][0] + acc[ai][bj][m][n][1] + acc[ai][bj][m][n][2] + acc[ai][bj][m][n][3];
        if (s == 123.456f) sink[0] = s; } };
struct EpiRes {
    static constexpr bool PERM = false, AFTER_DRAIN = false;
    const float* X; float* O; const float* gate;
    __device__ __forceinline__ void operator()(const pg8::f32x4 (&acc)[2][2][4][2], const pg8::Unit& u, int wr, int wc, int fr, int fq) const {
        const int row0 = u.pm * 256 + wr * 64 + fr, col0 = u.pn * 256 + wc * 32 + 4 * fq, b = u.pm >> 5;
        f32x4 gv[2][2];
#pragma unroll
        for (int bj = 0; bj < 2; ++bj)
#pragma unroll
            for (int n = 0; n < 2; ++n) gv[bj][n] = *(const f32x4*)(gate + (size_t)b * NMOD + col0 + bj * 128 + n * 16);
#pragma unroll
        for (int ai = 0; ai < 2; ++ai)
#pragma unroll
            for (int m = 0; m < 4; ++m) { const size_t off = (size_t)(row0 + ai * 128 + m * 16) * D + col0;
#pragma unroll
                for (int bj = 0; bj < 2; ++bj)
#pragma unroll
                    for (int n = 0; n < 2; ++n) { const f32x4 xv = *(const f32x4*)(X + off + bj * 128 + n * 16);
                        *(f32x4*)(O + off + bj * 128 + n * 16) = xv + gv[bj][n] * acc[ai][bj][m][n]; }
                asm volatile("" ::: "memory"); }
    }
};
#ifndef LK0
#define LK0 1
#endif
#ifndef LK1
#define LK1 1
#endif
#ifndef LK2
#define LK2 1
#endif
#ifndef SCAN_CHUNKED
#define SCAN_CHUNKED 1
#endif
#define LORA_LOGW SCAN_CHUNKED
struct EpiLora {
    static constexpr bool PERM = true, AFTER_DRAIN = false;
    const float *w0, *a0, *k_a; const bf16 *KL, *KK; float* DEC; bf16 *KP, *BV, *G;
    __device__ __forceinline__ void operator()(const pg8::f32x4 (&acc)[2][2][4][2], const pg8::Unit& u, int wr, int wc, int fr, int fq) const {
        const int kind = u.pn >> 1, row0 = u.pm * 256 + wr * 64 + fr, cb = (u.pn & 1) * 256 + wc * 32 + 8 * fq;
#pragma unroll
        for (int bj = 0; bj < 2; ++bj) {
            const int c = cb + bj * 128;
            if (LK0 && kind == 0) {
                float wv[8]; ld8f(w0 + c, wv);
#pragma unroll
                for (int ai = 0; ai < 2; ++ai)
#pragma unroll
                    for (int m = 0; m < 4; ++m) { const size_t off = (size_t)(row0 + ai * 128 + m * 16) * RW + c; float o8[8];
#pragma unroll
                        for (int n = 0; n < 2; ++n)
#pragma unroll
                            for (int j = 0; j < 4; ++j) { const float pre = acc[ai][bj][m][n][j] + wv[4 * n + j];
                                o8[4 * n + j] = -0.6065306597f * sigmoidf_(pre); }
                        *(u32x4*)((bf16*)DEC + off) = pack8(o8); asm volatile("" ::: "memory"); }
            } else if (LK1 && kind == 1) {
                float av[8]; ld8f(a0 + c, av);
#pragma unroll
                for (int ai = 0; ai < 2; ++ai)
#pragma unroll
                    for (int m = 0; m < 4; ++m) { const size_t off = (size_t)(row0 + ai * 128 + m * 16) * RW + c; float a8[8];
#pragma unroll
                        for (int n = 0; n < 2; ++n)
#pragma unroll
                            for (int j = 0; j < 4; ++j) a8[4 * n + j] = sigmoidf_(acc[ai][bj][m][n][j] + av[4 * n + j]);
                        *(u32x4*)(KP + off) = pack8(a8); }
            } else if (LK2) {
#pragma unroll
                for (int ai = 0; ai < 2; ++ai)
#pragma unroll
                    for (int m = 0; m < 4; ++m) { const size_t off = (size_t)(row0 + ai * 128 + m * 16) * RW + c;
                        const pg8::f32x4 v0 = acc[ai][bj][m][0], v1 = acc[ai][bj][m][1];
                        u32x4 w; w.x = pk2(v0[0], v0[1]); w.y = pk2(v0[2], v0[3]); w.z = pk2(v1[0], v1[1]); w.w = pk2(v1[2], v1[3]);
                        *(u32x4*)(G + off) = w; }
            }
        }
    }
};


#ifndef FUSED_RES
#define FUSED_RES 1
#endif
#ifndef CONV_UNDER_S2
#define CONV_UNDER_S2 1
#endif
struct EpiRes7 {
    static constexpr bool PERM = true, AFTER_DRAIN = false;
    const float* X; bf16* X1B; bf16* A2; const float* MODp; float* RS;
    __device__ __forceinline__ void operator()(const pg8::f32x4 (&acc)[2][2][4][2], const pg8::Unit& u, int wr, int wc, int fr, int fq) const {
        const int row0 = u.pm * 256 + wr * 64 + fr, col0 = u.pn * 256 + wc * 32 + 8 * fq, b = u.pm >> 5;
        float gv[2][8], sv[2][8];
#pragma unroll
        for (int bj = 0; bj < 2; ++bj) { ld8f(MODp + (size_t)b * NMOD + 2 * D + col0 + bj * 128, gv[bj]); ld8f(MODp + (size_t)b * NMOD + 4 * D + col0 + bj * 128, sv[bj]); }
#pragma unroll
        for (int ai = 0; ai < 2; ++ai)
#pragma unroll
            for (int m = 0; m < 4; ++m) { const int row = row0 + ai * 128 + m * 16; const size_t off = (size_t)row * D + col0; float ss = 0.f;
#pragma unroll
                for (int bj = 0; bj < 2; ++bj) { float xv[8], x1[8], a2[8]; { const f32x4 xa_ = __builtin_nontemporal_load((const f32x4*)(X + off + bj * 128)), xb_ = __builtin_nontemporal_load((const f32x4*)(X + off + bj * 128 + 4)); xv[0] = xa_.x; xv[1] = xa_.y; xv[2] = xa_.z; xv[3] = xa_.w; xv[4] = xb_.x; xv[5] = xb_.y; xv[6] = xb_.z; xv[7] = xb_.w; }
#pragma unroll
                    for (int i = 0; i < 8; ++i) { x1[i] = xv[i] + gv[bj][i] * acc[ai][bj][m][i >> 2][i & 3]; ss += x1[i] * x1[i]; a2[i] = x1[i] * (1.0f + sv[bj][i]); }
                    *(u32x4*)(X1B + off + bj * 128) = pack8(x1); *(u32x4*)(A2 + off + bj * 128) = pack8(a2); }
                ss += __shfl_xor(ss, 16); ss += __shfl_xor(ss, 32);
                if (fq == 0) unsafeAtomicAdd(RS + row, ss);
                asm volatile("" ::: "memory"); }
    }
};
struct EpiUp2 {
    static constexpr bool PERM = true, AFTER_DRAIN = false;
    bf16* O; const float* RS; const float* BIAS;
    __device__ __forceinline__ void operator()(const pg8::f32x4 (&acc)[2][2][4][2], const pg8::Unit& u, int wr, int wc, int fr, int fq) const {
        const int row0 = u.pm * 256 + wr * 64 + fr, col0 = u.pn * 256 + wc * 32 + 8 * fq, b = u.pm >> 5;
        float bv[2][8];
#pragma unroll
        for (int bj = 0; bj < 2; ++bj) ld8f(BIAS + (size_t)b * FF + col0 + bj * 128, bv[bj]);
#pragma unroll
        for (int ai = 0; ai < 2; ++ai)
#pragma unroll
            for (int m = 0; m < 4; ++m) { const int row = row0 + ai * 128 + m * 16; const float rstd = rsqrtf(RS[row] * (1.f / D) + 1e-6f);
                bf16* rowp = O + (size_t)row * FF + col0;
#pragma unroll
                for (int bj = 0; bj < 2; ++bj) { float hv[8];
#pragma unroll
                    for (int i = 0; i < 8; ++i) { const float v = fmaxf(acc[ai][bj][m][i >> 2][i & 3] * rstd + bv[bj][i], 0.f); hv[i] = v * v; }
                    *(u32x4*)(rowp + bj * 128) = pack8(hv); } }
    }
};
struct EpiDown2 {
    static constexpr bool PERM = true, AFTER_DRAIN = false;
    const bf16* X1B; bf16* X2B; const float* MODp; float* RS;
    __device__ __forceinline__ void operator()(const pg8::f32x4 (&acc)[2][2][4][2], const pg8::Unit& u, int wr, int wc, int fr, int fq) const {
        const int row0 = u.pm * 256 + wr * 64 + fr, col0 = u.pn * 256 + wc * 32 + 8 * fq, b = u.pm >> 5;
        float gv[2][8];
#pragma unroll
        for (int bj = 0; bj < 2; ++bj) ld8f(MODp + (size_t)b * NMOD + 5 * D + col0 + bj * 128, gv[bj]);
#pragma unroll
        for (int ai = 0; ai < 2; ++ai)
#pragma unroll
            for (int m = 0; m < 4; ++m) { const int row = row0 + ai * 128 + m * 16; const size_t off = (size_t)row * D + col0; float ss = 0.f;
#pragma unroll
                for (int bj = 0; bj < 2; ++bj) { float xv[8], x2[8]; unpack8(*(const u32x4*)(X1B + off + bj * 128), xv);
#pragma unroll
                    for (int i = 0; i < 8; ++i) { x2[i] = xv[i] + gv[bj][i] * acc[ai][bj][m][i >> 2][i & 3]; ss += x2[i] * x2[i]; }
                    *(u32x4*)(X2B + off + bj * 128) = pack8(x2); }
                ss += __shfl_xor(ss, 16); ss += __shfl_xor(ss, 32);
                if (fq == 0) unsafeAtomicAdd(RS + row, ss);
                asm volatile("" ::: "memory"); }
    }
};

#ifndef FUSED_FINAL
#define FUSED_FINAL 1
#endif
constexpr size_t WS_CNT = 928 * 1024;
struct EpiDownF {
    static constexpr bool PERM = true, AFTER_DRAIN = false;
    const bf16* X1B; float* OUT; const float* MODp; const float* G; float* RS; unsigned* CNT;
    __device__ __forceinline__ void operator()(const pg8::f32x4 (&acc_)[2][2][4][2], const pg8::Unit& u, int wr, int wc, int fr, int fq) const {
        pg8::f32x4 (&acc)[2][2][4][2] = const_cast<pg8::f32x4 (&)[2][2][4][2]>(acc_);
        const int row0 = u.pm * 256 + wr * 64 + fr, col0 = u.pn * 256 + wc * 32 + 8 * fq, b = u.pm >> 5;
        {
            float gv[2][8];
#pragma unroll
            for (int bj = 0; bj < 2; ++bj) ld8f(MODp + (size_t)b * NMOD + 5 * D + col0 + bj * 128, gv[bj]);
#pragma unroll
            for (int ai = 0; ai < 2; ++ai)
#pragma unroll
                for (int m = 0; m < 4; ++m) { const int row = row0 + ai * 128 + m * 16; const size_t off = (size_t)row * D + col0; float ss = 0.f;
#pragma unroll
                    for (int bj = 0; bj < 2; ++bj) { float xv[8]; unpack8(*(const u32x4*)(X1B + off + bj * 128), xv);
#pragma unroll
                        for (int i = 0; i < 8; ++i) { const float x2 = xv[i] + gv[bj][i] * acc[ai][bj][m][i >> 2][i & 3]; acc[ai][bj][m][i >> 2][i & 3] = x2; ss += x2 * x2; } }
                    ss += __shfl_xor(ss, 16); ss += __shfl_xor(ss, 32);
                    if (fq == 0) unsafeAtomicAdd(RS + row, ss);
                    asm volatile("" ::: "memory"); }
        }
        asm volatile("s_waitcnt vmcnt(0)" ::: "memory");
        unsigned* cnt = CNT + 64 * u.pm;
        if ((threadIdx.x & 63) == 0) __hip_atomic_fetch_add(cnt, 1u, __ATOMIC_RELAXED, __HIP_MEMORY_SCOPE_AGENT);
        { unsigned sp = 0;
          while ((unsigned)__builtin_amdgcn_readfirstlane(__hip_atomic_load(cnt, __ATOMIC_RELAXED, __HIP_MEMORY_SCOPE_AGENT)) < 32u) { __builtin_amdgcn_s_sleep(2); if (++sp > (1u << 20)) break; } }
        float rstd[2][4];
#pragma unroll
        for (int ai = 0; ai < 2; ++ai)
#pragma unroll
            for (int m = 0; m < 4; ++m) rstd[ai][m] = rsqrtf(__hip_atomic_load(RS + row0 + ai * 128 + m * 16, __ATOMIC_RELAXED, __HIP_MEMORY_SCOPE_AGENT) * (1.f / D) + 1e-6f);
#pragma unroll
        for (int bj = 0; bj < 2; ++bj) {
            float g8[8]; ld8f(G + col0 + bj * 128, g8);
#pragma unroll
            for (int ai = 0; ai < 2; ++ai)
#pragma unroll
                for (int m = 0; m < 4; ++m) { float* op = OUT + (size_t)(row0 + ai * 128 + m * 16) * D + col0 + bj * 128; const float r_ = rstd[ai][m];
                    const pg8::f32x4 a0 = acc[ai][bj][m][0], a1 = acc[ai][bj][m][1];
                    *(f32x4*)(op) = (f32x4){a0[0] * r_ * g8[0], a0[1] * r_ * g8[1], a0[2] * r_ * g8[2], a0[3] * r_ * g8[3]};
                    *(f32x4*)(op + 4) = (f32x4){a1[0] * r_ * g8[4], a1[1] * r_ * g8[5], a1[2] * r_ * g8[6], a1[3] * r_ * g8[7]}; }
        }
    }
};
template <int R> __device__ __forceinline__ void final_rows2(const bf16* X2B, const float* RS, float* OUT, const float* g, int m0, int stride, int lane) {
    u32x4 w0[R], w1[R]; float rs[R];
#pragma unroll
    for (int r = 0; r < R; ++r) { const size_t off = (size_t)(m0 + r * stride) * D + lane * 8; w0[r] = *(const u32x4*)(X2B + off); w1[r] = *(const u32x4*)(X2B + off + 512); rs[r] = RS[m0 + r * stride]; }
    float g0[8], g1[8]; ld8f(g + lane * 8, g0); ld8f(g + 512 + lane * 8, g1);
#pragma unroll
    for (int r = 0; r < R; ++r) { const float rstd = rsqrtf(rs[r] * (1.f / D) + 1e-6f); float a[8], c[8]; unpack8(w0[r], a); unpack8(w1[r], c);
        float* op = OUT + (size_t)(m0 + r * stride) * D + lane * 8;
        *(f32x4*)(op) = (f32x4){a[0] * rstd * g0[0], a[1] * rstd * g0[1], a[2] * rstd * g0[2], a[3] * rstd * g0[3]};
        *(f32x4*)(op + 4) = (f32x4){a[4] * rstd * g0[4], a[5] * rstd * g0[5], a[6] * rstd * g0[6], a[7] * rstd * g0[7]};
        *(f32x4*)(op + 512) = (f32x4){c[0] * rstd * g1[0], c[1] * rstd * g1[1], c[2] * rstd * g1[2], c[3] * rstd * g1[3]};
        *(f32x4*)(op + 516) = (f32x4){c[4] * rstd * g1[4], c[5] * rstd * g1[5], c[6] * rstd * g1[6], c[7] * rstd * g1[7]}; }
}
__device__ __forceinline__ void transpose_item(const float* W, int K, int N, bf16* WT, LAS float* scr, int item, int lane) {
    const int nblk = N / 32, kb = item / nblk, nb = item % nblk, k0 = 64 * kb, n0 = 32 * nb;
#pragma unroll 8
    for (int i = 0; i < 32; ++i) { const int kk = 2 * i + (lane >> 5); scr[kk * 33 + (lane & 31)] = W[(size_t)(k0 + kk) * N + n0 + (lane & 31)]; }
    asm volatile("s_waitcnt lgkmcnt(0)" ::: "memory");
    const int c = lane & 7;
#pragma unroll
    for (int j = 0; j < 4; ++j) { const int n = (lane >> 3) + 8 * j; const LAS float* s = scr + (8 * c) * 33 + n;
        u32x4 o; o.x = pk2(s[0 * 33], s[1 * 33]); o.y = pk2(s[2 * 33], s[3 * 33]); o.z = pk2(s[4 * 33], s[5 * 33]); o.w = pk2(s[6 * 33], s[7 * 33]);
        *(u32x4*)(WT + (size_t)(n0 + n) * K + k0 + 8 * c) = o; }
    asm volatile("s_waitcnt lgkmcnt(0)" ::: "memory");
}
__device__ __forceinline__ void p0_prologue(const Args& A, LAS unsigned char* lds, int tid, int lane, int wave) {
    unsigned char* ws = A.ws;
    {
        const float* c = A.in[1]; const float* w_ada = A.in[2]; const float* b_ada = A.in[3]; float* MOD = (float*)(ws + WS_MOD);
        LAS float* cs = (LAS float*)(lds + LDS_MISC);
        for (int item = blockIdx.x; item < 384; item += gridDim.x) {
            const int kc = item / 12, cb = item % 12;
            __syncthreads();
            if (tid < 256) { const float cv = c[(tid >> 5) * D + kc * 32 + (tid & 31)]; cs[tid] = cv * sigmoidf_(cv); }
            __syncthreads();
            const int col = cb * 512 + tid;
            float acc[8];
#pragma unroll
            for (int b = 0; b < 8; ++b) acc[b] = 0.f;
#pragma unroll 4
            for (int kk = 0; kk < 32; ++kk) { const float w = w_ada[(size_t)(kc * 32 + kk) * NMOD + col];
#pragma unroll
                for (int b = 0; b < 8; ++b) acc[b] += cs[b * 32 + kk] * w; }
            const float bias = (kc == 0) ? b_ada[col] : 0.f;
#pragma unroll
            for (int b = 0; b < 8; ++b) unsafeAtomicAdd(MOD + b * NMOD + col, acc[b] + bias);
        }
        __syncthreads();
    }
    {
        LAS float* scr = (LAS float*)(lds + wave * 16384);
        const int gw = blockIdx.x * NWAVES + wave, NGW = gridDim.x * NWAVES;
        constexpr int I_IN = (D / 64) * (PT / 32), I_OUT = (D / 64) * (D / 32), I_UP = (D / 64) * (FF / 32), I_DN = (FF / 64) * (D / 32);
        for (int it = gw; it < ((CONV_UNDER_S2 && SHADOW_EXTRA) ? I_IN : I_IN + I_OUT + I_UP + I_DN); it += NGW) {
            int r = it;
            if (r < I_IN) { transpose_item(A.in[4], D, PT, (bf16*)(ws + WS_WIN), scr, r, lane); continue; } r -= I_IN;
            if (r < I_OUT) { transpose_item(A.in[17], D, D, (bf16*)(ws + WS_WOUT), scr, r, lane); continue; } r -= I_OUT;
            if (r < I_UP) { transpose_item(A.in[18], D, FF, (bf16*)(ws + WS_WUP), scr, r, lane); continue; } r -= I_UP;
            transpose_item(A.in[19], FF, D, (bf16*)(ws + WS_WDN), scr, r, lane);
        }
    }
    {
        const float* w2 = A.in[8]; const float* a2 = A.in[10]; const float* g2 = A.in[11]; bf16* LT = (bf16*)(ws + WS_LT);
        for (int idx = blockIdx.x * NTHR + tid; idx < LN * LK; idx += gridDim.x * NTHR) {
            const int n = idx >> 8, k = idx & 255; float v = 0.f;
            if (n < 512) { if (k < 64) v = w2[k * 512 + n]; }
            else if (n < 1024) { if (k >= 64 && k < 128) v = a2[(k - 64) * 512 + (n - 512)]; }
            else { if (k >= 128) v = g2[(k - 128) * 512 + (n - 1024)]; }
            LT[idx] = (bf16)(pk2(v, 0.f) & 0xffffu);
        }
    }
}

template <int R> __device__ __forceinline__ void norm_mod_rows(const float* X, bf16* O, const float* MOD, int sh_chunk, int m0, int stride, int lane) {
    f32x4 v[R][4];
#pragma unroll
    for (int r = 0; r < R; ++r) { const f32x4* xr = (const f32x4*)(X + (size_t)(m0 + r * stride) * D) + lane;
#pragma unroll
        for (int j = 0; j < 4; ++j) v[r][j] = __builtin_nontemporal_load(&xr[64 * j]); }
#pragma unroll
    for (int r = 0; r < R; ++r) { const int m = m0 + r * stride; const float* sh = MOD + (m >> 13) * NMOD + sh_chunk * D; const float* sc = sh + D;
        float s = 0.f;
#pragma unroll
        for (int j = 0; j < 4; ++j) s += (v[r][j].x * v[r][j].x + v[r][j].y * v[r][j].y) + (v[r][j].z * v[r][j].z + v[r][j].w * v[r][j].w);
        const float rstd = rsqrtf(wave_sum(s) * (1.f / D) + 1e-6f);
        bf16* orow = O + (size_t)m * D;
#pragma unroll
        for (int j = 0; j < 4; ++j) { const f32x4 a = ((const f32x4*)sc)[lane + 64 * j], b = ((const f32x4*)sh)[lane + 64 * j];
            const f32x4 h = v[r][j] * rstd * (1.f + a) + b;
            ((u32x2*)orow)[lane + 64 * j] = (u32x2){pk2(h.x, h.y), pk2(h.z, h.w)}; } }
}
template <int R> __device__ __forceinline__ void final_rows(float* X, const float* g, int m0, int stride, int lane) {
    f32x4 v[R][4];
#pragma unroll
    for (int r = 0; r < R; ++r) { const f32x4* xr = (const f32x4*)(X + (size_t)(m0 + r * stride) * D) + lane;
#pragma unroll
        for (int j = 0; j < 4; ++j) v[r][j] = xr[64 * j]; }
    f32x4 gv[4];
#pragma unroll
    for (int j = 0; j < 4; ++j) gv[j] = ((const f32x4*)g)[lane + 64 * j];
#pragma unroll
    for (int r = 0; r < R; ++r) { f32x4* xr = (f32x4*)(X + (size_t)(m0 + r * stride) * D) + lane; float s = 0.f;
#pragma unroll
        for (int j = 0; j < 4; ++j) s += (v[r][j].x * v[r][j].x + v[r][j].y * v[r][j].y) + (v[r][j].z * v[r][j].z + v[r][j].w * v[r][j].w);
        const float rstd = rsqrtf(wave_sum(s) * (1.f / D) + 1e-6f);
#pragma unroll
        for (int j = 0; j < 4; ++j) xr[64 * j] = v[r][j] * rstd * gv[j]; }
}
__device__ __forceinline__ size_t pidx(int m, int col) { return ((size_t)((m >> 8) * 13 + (col >> 8)) << 16) + (size_t)(((m & 255) << 8) + (col & 255)); }
#define PAT(mm, cc) (P + pidx((mm), (cc)))
struct ConvRegs { u32x4 bg, c0, u0, c1, u1, c2, u2; };
struct VlRegs { u32x4 vc, vp; u32x2 lc, lp; };
__device__ __forceinline__ void conv_load(ConvRegs& R, const bf16* P, int m, int lane) {
    const int tt = m & (SEQ - 1); const bool has1 = tt >= 1, has2 = tt >= 2;
    const u32x4 zero4 = (u32x4){0u, 0u, 0u, 0u}; const int ch = 8 * lane;
    R.bg = *(const u32x4*)PAT(m, ch); R.c0 = *(const u32x4*)PAT(m, 512 + ch); R.u0 = *(const u32x4*)PAT(m, 1024 + ch);
    R.c1 = has1 ? *(const u32x4*)PAT(m - 1, 512 + ch) : zero4; R.u1 = has1 ? *(const u32x4*)PAT(m - 1, 1024 + ch) : zero4;
    R.c2 = has2 ? *(const u32x4*)PAT(m - 2, 512 + ch) : zero4; R.u2 = has2 ? *(const u32x4*)PAT(m - 2, 1024 + ch) : zero4;
}
__device__ __forceinline__ void conv_compute(const Args& A, const ConvRegs& R, int m, int lane) {
    const int ch = 8 * lane; const float* cw = A.in[5];
    float bg[8], c0[8], u0[8], c1[8], u1[8], c2[8], u2[8], w0[8], w1[8], w2[8], y[8];
    unpack8(R.bg, bg); unpack8(R.c0, c0); unpack8(R.u0, u0); unpack8(R.c1, c1); unpack8(R.u1, u1); unpack8(R.c2, c2); unpack8(R.u2, u2);
    ld8f(cw + ch, w0); ld8f(cw + 512 + ch, w1); ld8f(cw + 1024 + ch, w2);
#pragma unroll
    for (int i = 0; i < 8; ++i) y[i] = bg[i] * (w0[i] * (c2[i] * u2[i]) + w1[i] * (c1[i] * u1[i]) + w2[i] * (c0[i] * u0[i]));
    __builtin_nontemporal_store(pack8(y), (u32x4*)((bf16*)(A.ws + WS_MIX) + (size_t)m * D + ch));
}
__device__ __forceinline__ void vl_load(VlRegs& R, const bf16* P, int m, int lane) {
    const int tt = m & (SEQ - 1); const bool has1 = tt >= 1;
    const u32x4 zero4 = (u32x4){0u, 0u, 0u, 0u}; const int ch = 8 * lane, c4 = 4 * lane;
    R.vc = *(const u32x4*)PAT(m, PCONV + 1024 + ch); R.lc = *(const u32x2*)PAT(m, PCONV + 1536 + c4);
    R.vp = has1 ? *(const u32x4*)PAT(m - 1, PCONV + 1024 + ch) : zero4; R.lp = has1 ? *(const u32x2*)PAT(m - 1, PCONV + 1536 + c4) : (u32x2){0u, 0u};
}
__device__ __forceinline__ void vl_compute(const Args& A, const VlRegs& R, int m, int lane) {
    unsigned char* ws = A.ws; const int ch = 8 * lane; const float* mu = A.in[6];
    {
        float cur[8], prv[8], mv[8], o[8];
        unpack8(R.vc, cur); unpack8(R.vp, prv); ld8f(mu + 1024 + ch, mv);
#pragma unroll
        for (int i = 0; i < 8; ++i) o[i] = cur[i] + (prv[i] - cur[i]) * mv[i];
        *(u32x4*)((bf16*)(ws + WS_VL) + (size_t)m * RW + ch) = pack8(o);
    }
    {
        const int c4 = 4 * lane;
        const u32x2 cw = R.lc, pw = R.lp;
        const f32x4 mv = *(const f32x4*)(mu + 1536 + c4);
        float cur[4] = {bflo(cw.x), bfhi(cw.x), bflo(cw.y), bfhi(cw.y)}, prv[4] = {bflo(pw.x), bfhi(pw.x), bflo(pw.y), bfhi(pw.y)}, o[4];
#pragma unroll
        for (int i = 0; i < 4; ++i) { const float xl = cur[i] + (prv[i] - cur[i]) * mv[i];
            const float sg = sigmoidf_(lane < 16 ? 2.0f * xl : xl);
            o[i] = lane < 16 ? (2.0f * sg - 1.0f) : (lane < 32 ? xl : sg); }
        *(u32x2*)((bf16*)(ws + WS_LA) + (size_t)m * LK + c4) = (u32x2){pk2(o[0], o[1]), pk2(o[2], o[3])};
    }
}
__device__ __forceinline__ void conv_pass(const Args& A, int w0, int nw, int lane) {
    const bf16* Pp = (const bf16*)(A.ws + WS_P); ConvRegs Ra, Rb; int m = w0;
    if (m < M) conv_load(Ra, Pp, m, lane);
    for (; m < M; m += 2 * nw) { const bool hb = m + nw < M;
        if (hb) conv_load(Rb, Pp, m + nw, lane);
        conv_compute(A, Ra, m, lane);
        if (m + 2 * nw < M) conv_load(Ra, Pp, m + 2 * nw, lane);
        if (hb) conv_compute(A, Rb, m + nw, lane); }
}
__device__ __forceinline__ void vl_pass(const Args& A, int w0, int nw, int lane) {
    const bf16* Pp = (const bf16*)(A.ws + WS_P); VlRegs Ra, Rb; int m = w0;
    if (m < M) vl_load(Ra, Pp, m, lane);
    for (; m < M; m += 2 * nw) { const bool hb = m + nw < M;
        if (hb) vl_load(Rb, Pp, m + nw, lane);
        vl_compute(A, Ra, m, lane);
        if (m + 2 * nw < M) vl_load(Ra, Pp, m + 2 * nw, lane);
        if (hb) vl_compute(A, Rb, m + nw, lane); }
}
template <int R> __device__ __forceinline__ void post_rows(const Args& A, int m0, int stride, int lane) {
    unsigned char* ws = A.ws;
    const int ch = 8 * lane;
    f32x4 y0[R], y1[R]; u32x4 rw[R], kw[R], vw[R], gw_[R];
#pragma unroll
    for (int r = 0; r < R; ++r) { const size_t off = (size_t)(m0 + r * stride) * RW + ch;
        y0[r] = *(const f32x4*)((const float*)(ws + WS_Y) + off); y1[r] = *(const f32x4*)((const float*)(ws + WS_Y) + off + 4);
        rw[r] = *(const u32x4*)((const bf16*)(ws + WS_RL) + off); kw[r] = *(const u32x4*)((const bf16*)(ws + WS_KP) + off);
        vw[r] = *(const u32x4*)((const bf16*)(ws + WS_VL) + off); gw_[r] = *(const u32x4*)((const bf16*)(ws + WS_G) + off); }
    float rk[8], lg[8], lb[8];
    ld8f(A.in[14] + ch, rk); ld8f(A.in[15] + ch, lg); ld8f(A.in[16] + ch, lb);
#pragma unroll
    for (int r = 0; r < R; ++r) {
        float y[8] = {y0[r].x, y0[r].y, y0[r].z, y0[r].w, y1[r].x, y1[r].y, y1[r].z, y1[r].w}, rr[8], kp[8], v[8], g[8], o[8];
        unpack8(rw[r], rr); unpack8(kw[r], kp); unpack8(vw[r], v); unpack8(gw_[r], g);
        float s = 0.f, bs = 0.f;
#pragma unroll
        for (int i = 0; i < 8; ++i) { s += y[i]; bs += rr[i] * kp[i] * rk[i]; }
        s = sum8(s); bs = sum8(bs);
        const float mean = s * (1.f / 64.f); float q = 0.f;
#pragma unroll
        for (int i = 0; i < 8; ++i) { y[i] -= mean; q += y[i] * y[i]; }
        q = sum8(q);
        const float rstd = rsqrtf(q * (1.f / 64.f) + 64e-5f);
#pragma unroll
        for (int i = 0; i < 8; ++i) o[i] = (y[i] * rstd * lg[i] + lb[i] + bs * v[i]) * g[i];
        *(u32x4*)((bf16*)(ws + WS_MIX) + (size_t)(m0 + r * stride) * D + 512 + ch) = pack8(o); }
}

constexpr int TC = 32, NCH = SEQ / TC;
constexpr int OPB = 5 * TC * 256 + TC * 64;
constexpr int YB_OFF = 2 * OPB, DUMP_OFF = YB_OFF + 4096;
static_assert(DUMP_OFF + 4608 <= 131072, "scan LDS");
#define SCAN_BAR() do { asm volatile("s_waitcnt lgkmcnt(0)" ::: "memory"); __builtin_amdgcn_s_barrier(); asm volatile("" ::: "memory"); } while (0)
template <int CTRL> __device__ __forceinline__ float dpp_add(float x) {
    return x + __builtin_bit_cast(float, __builtin_amdgcn_update_dpp(0, __builtin_bit_cast(int, x), CTRL, 0xf, 0xf, false));
}
__device__ __forceinline__ float rsum16(float x) { x = dpp_add<0x128>(x); x = dpp_add<0x124>(x); x = dpp_add<0x122>(x); x = dpp_add<0x121>(x); return x; }
struct ScanRegs { u32x4 rl, kp, kk, bv, vv; f32x4 d0, d1; };
__device__ __forceinline__ void st8(LAS unsigned char* p, const u32x4 w) {
    *(LAS f32x4*)p = (f32x4){bflo(w.x), bfhi(w.x), bflo(w.y), bfhi(w.y)}; *(LAS f32x4*)(p + 16) = (f32x4){bflo(w.z), bfhi(w.z), bflo(w.w), bfhi(w.w)};
}
__device__ __forceinline__ void scan_phase(unsigned char* ws, LAS unsigned char* lds, int tid, int lane, int wid) {
    const bf16* RL = (const bf16*)(ws + WS_RL); const bf16* KP = (const bf16*)(ws + WS_KP); const bf16* KK = (const bf16*)(ws + WS_KK);
    const bf16* BV = (const bf16*)(ws + WS_BV); const bf16* VL = (const bf16*)(ws + WS_VL); const float* DEC = (const float*)(ws + WS_DEC);
    float* Y = (float*)(ws + WS_Y);
    for (int item = blockIdx.x; item < 256; item += gridDim.x) {
        const int xcd = item & 7, slot = item >> 3, bh = xcd * 8 + (slot >> 2), q = slot & 3, b = bh >> 3, h = bh & 7;
        const size_t rowbase = (size_t)b * SEQ;
        const bool loader = wid >= 4;
        const int L = tid - 256;
        const int lt = L >> 3, lc = (L & 7) * 8;
        ScanRegs R;
#define SCAN_ISSUE(cc) do { const size_t o_ = (rowbase + (size_t)(cc) * TC + lt) * RW + h * 64 + lc; \
            R.rl = *(const u32x4*)(RL + o_); R.kp = *(const u32x4*)(KP + o_); R.kk = *(const u32x4*)(KK + o_); R.bv = *(const u32x4*)(BV + o_); \
            R.d0 = *(const f32x4*)(DEC + o_); R.d1 = *(const f32x4*)(DEC + o_ + 4); \
            if (wid == 4) R.vv = *(const u32x4*)(VL + (rowbase + (size_t)(cc) * TC + (lane >> 1)) * RW + h * 64 + q * 16 + (lane & 1) * 8); } while (0)
#define SCAN_WRITE(buf) do { LAS unsigned char* ob_ = lds + (buf) * OPB + lt * 256 + lc * 4; \
            st8(ob_ + 0 * TC * 256, R.rl); *(LAS f32x4*)(ob_ + 1 * TC * 256) = R.d0; *(LAS f32x4*)(ob_ + 1 * TC * 256 + 16) = R.d1; \
            st8(ob_ + 2 * TC * 256, R.kp); st8(ob_ + 3 * TC * 256, R.kk); st8(ob_ + 4 * TC * 256, R.bv); \
            if (wid == 4) st8(lds + (buf) * OPB + 5 * TC * 256 + (lane >> 1) * 64 + (lane & 1) * 32, R.vv); } while (0)
#define SCAN_FLUSH(cc) do { if (L < 128) { const f32x4 yv_ = *(LAS const f32x4*)(lds + YB_OFF + ((cc) & 1) * 2048 + (L >> 2) * 64 + (L & 3) * 16); \
            *(f32x4*)(Y + (rowbase + (size_t)(cc) * TC + (L >> 2)) * RW + h * 64 + q * 16 + (L & 3) * 4) = yv_; } } while (0)
        const int rg = lane >> 4, cl = lane & 15, rb = (wid & 3) * 4 + rg;
        f32x2 S01 = (f32x2){0.f, 0.f}, S23 = (f32x2){0.f, 0.f};
        const unsigned opoff = cl * 16, voff = 5 * TC * 256 + rb * 4;
        const unsigned ybase = (cl == 0) ? (unsigned)(YB_OFF + rb * 4) : (unsigned)(DUMP_OFF + lane * 4);
        if (loader) { SCAN_ISSUE(0); SCAN_WRITE(0); SCAN_ISSUE(1); }
        SCAN_BAR();
        for (int c = 0; c < NCH; ++c) {
            if (!loader) {
                LAS const unsigned char* ob = lds + (c & 1) * OPB;
                LAS unsigned char* yb = lds + ybase + (c & 1) * 2048;
                f32x4 r_[3], w_[3], k_[3], a_[3], b_[3]; float v_[3];
#define SCAN_LD(st, tt) do { r_[st] = *(LAS const f32x4*)(ob + opoff + (0 * TC + (tt)) * 256); w_[st] = *(LAS const f32x4*)(ob + opoff + (1 * TC + (tt)) * 256); \
                    k_[st] = *(LAS const f32x4*)(ob + opoff + (2 * TC + (tt)) * 256); a_[st] = *(LAS const f32x4*)(ob + opoff + (3 * TC + (tt)) * 256); \
                    b_[st] = *(LAS const f32x4*)(ob + opoff + (4 * TC + (tt)) * 256); v_[st] = *(LAS const float*)(ob + voff + (tt) * 64); } while (0)
                SCAN_LD(0, 0); SCAN_LD(1, 1);
#pragma unroll
                for (int t = 0; t < TC; ++t) {
                    const int st = t % 3;
                    if (t + 2 < TC) SCAN_LD((t + 2) % 3, t + 2);
                    const f32x4 r = r_[st], w = w_[st], k = k_[st], a = a_[st], bb = b_[st]; const float v = v_[st];
                    const f32x2 sp2 = S01 * (f32x2){a.x, a.y} + S23 * (f32x2){a.z, a.w};
                    const float sa = rsum16(sp2.x + sp2.y);
                    const f32x2 vv = (f32x2){v, v}, nsa = (f32x2){-sa, -sa};
                    const f32x2 t01 = vv * (f32x2){k.x, k.y} + nsa * (f32x2){bb.x, bb.y};
                    const f32x2 t23 = vv * (f32x2){k.z, k.w} + nsa * (f32x2){bb.z, bb.w};
                    S01 = S01 * (f32x2){w.x, w.y} + t01;
                    S23 = S23 * (f32x2){w.z, w.w} + t23;
                    const f32x2 yp2 = S01 * (f32x2){r.x, r.y} + S23 * (f32x2){r.z, r.w};
                    const float yv = rsum16(yp2.x + yp2.y);
                    *(LAS float*)(yb + t * 64) = yv;
                }
#undef SCAN_LD
            } else {
                if (c + 1 < NCH) SCAN_WRITE((c + 1) & 1);
                if (c + 2 < NCH) SCAN_ISSUE(c + 2);
                if (c >= 1) SCAN_FLUSH(c - 1);
            }
            SCAN_BAR();
        }
        if (loader) SCAN_FLUSH(NCH - 1);
        SCAN_BAR();
#undef SCAN_ISSUE
#undef SCAN_WRITE
#undef SCAN_FLUSH
    }
}

#ifndef SCAN_CHUNKED
#define SCAN_CHUNKED 1
#endif
constexpr size_t WS_AH = 768 * MiB  , WS_NN = 992 * MiB, WS_MA = 832 * MiB;
constexpr size_t OUT_BK = 0, OUT_PC = 128 * MiB, OUT_RT = 160 * MiB;
constexpr int S1_XA = 0, S1_XB = 2304, S1_XK = 4608, S1_XR = 6912, S1_AHL = 9216, S1_NABT = 11520, S1_TT = 12544, S1_NAK = 13824, S1_WAVE = 15360;
typedef short bf16x8 __attribute__((ext_vector_type(8)));
__device__ __forceinline__ float bf2f(unsigned short v) { return __uint_as_float(((unsigned)v) << 16); }
__device__ __forceinline__ unsigned short f2bf1(float f) { return (unsigned short)(pk2(f, 0.f) & 0xffffu); }
__device__ __forceinline__ bf16x8 mk8(unsigned a, unsigned b, unsigned c, unsigned d) { return __builtin_bit_cast(bf16x8, (u32x4){a, b, c, d}); }
#define MFMA16(a, b, c) __builtin_amdgcn_mfma_f32_16x16x32_bf16((a), (b), (c), 0, 0, 0)

__device__ __forceinline__ void s1_item(unsigned char* ws, unsigned char* outb, const float* rkp, const float* kap, const float* mup, const float* kkp, LAS unsigned char* wl, int ci, int lane) {
    const int bh = ci >> 9, c = ci & 511, b = bh >> 3, h = bh & 7;
    const size_t goff = ((size_t)b * SEQ + (size_t)c * 16) * RW + h * 64 + lane;
    const bf16* LW = (const bf16*)(ws + WS_DEC); const bf16* AVg = (const bf16*)(ws + WS_KP); const bf16* Pg = (const bf16*)(ws + WS_P);
    const int m0 = b * SEQ + c * 16, colr = PCONV + h * 64 + lane, colk = colr + 512;
    float lw[16]; unsigned short a_[16], pr_[17], pk_[17];
#pragma unroll
    for (int t = 0; t < 16; ++t) { const size_t o = goff + (size_t)t * RW; lw[t] = bf2f(LW[o]); a_[t] = AVg[o]; pr_[t + 1] = Pg[pidx(m0 + t, colr)]; pk_[t + 1] = Pg[pidx(m0 + t, colk)]; }
    if (c > 0) { pr_[0] = Pg[pidx(m0 - 1, colr)]; pk_[0] = Pg[pidx(m0 - 1, colk)]; } else { pr_[0] = 0; pk_[0] = 0; }
    const float mur = mup[h * 64 + lane], muk = mup[512 + h * 64 + lane], kkc = kkp[h * 64 + lane];
    float rv[16], kv[16], kkn[16];
#pragma unroll
    for (int t = 0; t < 16; ++t) { const float rc = bf2f(pr_[t + 1]), rp = bf2f(pr_[t]), kc = bf2f(pk_[t + 1]), kp0 = bf2f(pk_[t]);
        rv[t] = rc + (rp - rc) * mur; kv[t] = kc + (kp0 - kc) * muk; const float kx = kv[t] * kkc; kkn[t] = kx; }
#pragma unroll
    for (int t = 0; t < 16; ++t) { float ss = rsum16(kkn[t] * kkn[t]);
        { const int si_ = __builtin_bit_cast(int, ss);
          ss = __builtin_bit_cast(float, __builtin_amdgcn_readlane(si_, 0)) + __builtin_bit_cast(float, __builtin_amdgcn_readlane(si_, 16)) + __builtin_bit_cast(float, __builtin_amdgcn_readlane(si_, 32)) + __builtin_bit_cast(float, __builtin_amdgcn_readlane(si_, 48)); }
        kkn[t] *= 1.0f / fmaxf(sqrtf(ss), 1e-12f); }
    float lp[16]; { float acc = 0.f;
#pragma unroll
        for (int t = 0; t < 16; ++t) { acc += lw[t]; lp[t] = acc; } }
    const float lpc = lp[15];
    float At[16], Bh[16], Kh[16];
    const float rkh = rkp[h * 64 + lane], kah = kap[h * 64 + lane];
#pragma unroll
    for (int t = 0; t < 16; ++t) {
        const float P = __expf(lp[t]), Pm1 = __expf(lp[t] - lw[t]), iP = __expf(-lp[t]), PcP = __expf(lpc - lp[t]);
        const float kkf = kkn[t], af_ = bf2f(a_[t]), bvf = kkf * af_, kpf = kv[t] * (1.0f + (af_ - 1.0f) * kah), rf = rv[t];
        At[t] = -kkf * Pm1; Bh[t] = bvf * PcP; Kh[t] = kpf * PcP;
        *(LAS unsigned short*)(wl + S1_XA + t * 144 + lane * 2) = f2bf1(At[t]);
        *(LAS unsigned short*)(wl + S1_XB + t * 144 + lane * 2) = f2bf1(bvf * iP);
        *(LAS unsigned short*)(wl + S1_XK + t * 144 + lane * 2) = f2bf1(kpf * iP);
        *(LAS unsigned short*)(wl + S1_XR + t * 144 + lane * 2) = f2bf1(rf * P);
        *(LAS unsigned short*)(wl + S1_AHL + t * 144 + lane * 2) = f2bf1(rf * P * rkh);
    }
    const int m = lane & 15, q = lane >> 4;
    bf16x8 fa[2], fb[2], fk[2], fr[2];
#pragma unroll
    for (int ks = 0; ks < 2; ++ks) { const int o = m * 144 + (8 * q + 32 * ks) * 2;
        fa[ks] = *(LAS const bf16x8*)(wl + S1_XA + o); fb[ks] = *(LAS const bf16x8*)(wl + S1_XB + o);
        fk[ks] = *(LAS const bf16x8*)(wl + S1_XK + o); fr[ks] = *(LAS const bf16x8*)(wl + S1_XR + o); }
    const f32x4 z4 = (f32x4){0.f, 0.f, 0.f, 0.f};
    f32x4 nab = MFMA16(fb[0], fa[0], z4); nab = MFMA16(fb[1], fa[1], nab);
    f32x4 nak = MFMA16(fk[0], fa[0], z4); nak = MFMA16(fk[1], fa[1], nak);
    f32x4 nbr = MFMA16(fb[0], fr[0], z4); nbr = MFMA16(fb[1], fr[1], nbr);
    f32x4 nkr = MFMA16(fk[0], fr[0], z4); nkr = MFMA16(fk[1], fr[1], nkr);
    {
        bf16x8 frk0 = *(LAS const bf16x8*)(wl + S1_AHL + m * 144 + (8 * q) * 2), frk1 = *(LAS const bf16x8*)(wl + S1_AHL + m * 144 + (8 * q + 32) * 2);
        f32x4 cb = MFMA16(fk[0], frk0, z4); cb = MFMA16(fk[1], frk1, cb);
        const float cd = (m & 3) == 0 ? cb[0] : ((m & 3) == 1 ? cb[1] : ((m & 3) == 2 ? cb[2] : cb[3]));
        if (q == (m >> 2)) ((float*)(outb + OUT_PC))[(size_t)ci * 256 + 64 + m] = cd;
        asm volatile("s_waitcnt lgkmcnt(0)" ::: "memory");
    }
#pragma unroll
    for (int i = 0; i < 4; ++i) { const int s = 4 * q + i;
        nab[i] = (s < m) ? nab[i] : 0.f; nak[i] = (s < m) ? nak[i] : 0.f; nbr[i] = (s <= m) ? nbr[i] : 0.f; nkr[i] = (s <= m) ? nkr[i] : 0.f; }
    __builtin_nontemporal_store((u32x4){pk2(nbr[0], nbr[1]), pk2(nbr[2], nbr[3]), pk2(nkr[0], nkr[1]), pk2(nkr[2], nkr[3])}, (u32x4*)((bf16*)(ws + WS_NN) + (size_t)ci * 512 + lane * 8));
    *(LAS f32x4*)(wl + S1_NABT + m * 64 + q * 16) = nab;
#pragma unroll
    for (int i = 0; i < 4; ++i) *(LAS float*)(wl + S1_NAK + (4 * q + i) * 64 + m * 4) = nak[i];
    float Tr[16];
#pragma unroll
    for (int t = 0; t < 16; ++t) {
        float acc = (m == t) ? 1.f : 0.f;
#pragma unroll
        for (int j4 = 0; j4 < (t + 3) / 4; ++j4) { const f32x4 nv = *(LAS const f32x4*)(wl + S1_NABT + t * 64 + j4 * 16);
#pragma unroll
            for (int jj = 0; jj < 4; ++jj) if (4 * j4 + jj < t) acc += Tr[4 * j4 + jj] * nv[jj]; }
        Tr[t] = acc;
        *(LAS float*)(wl + S1_TT + t * 80 + m * 4) = acc;
    }
#pragma unroll
    for (int t = 0; t < 16; ++t) {
        float acc = 0.f;
#pragma unroll
        for (int s4 = 0; s4 < t / 4 + 1; ++s4) { const f32x4 tv = *(LAS const f32x4*)(wl + S1_TT + t * 80 + s4 * 16);
#pragma unroll
            for (int ss = 0; ss < 4; ++ss) if (4 * s4 + ss <= t) acc += tv[ss] * At[4 * s4 + ss]; }
        *(LAS unsigned short*)(wl + S1_AHL + t * 144 + lane * 2) = f2bf1(acc);
    }
    {
        f32x4 tt[4];
#pragma unroll
        for (int s4 = 0; s4 < 4; ++s4) tt[s4] = *(LAS const f32x4*)(wl + S1_TT + m * 80 + s4 * 16);
        float mak[4];
#pragma unroll
        for (int i = 0; i < 4; ++i) { float acc = 0.f;
#pragma unroll
            for (int s4 = 0; s4 < 4; ++s4) { const f32x4 nv = *(LAS const f32x4*)(wl + S1_NAK + (4 * q + i) * 64 + s4 * 16);
                acc += tt[s4][0] * nv[0] + tt[s4][1] * nv[1] + tt[s4][2] * nv[2] + tt[s4][3] * nv[3]; }
            mak[i] = acc; }
        __builtin_nontemporal_store((u32x4){0u, 0u, pk2(mak[0], mak[1]), pk2(mak[2], mak[3])}, (u32x4*)((bf16*)(ws + WS_MA) + (size_t)ci * 512 + lane * 8));
    }
#pragma unroll
    for (int hh = 0; hh < 2; ++hh) {
        const int o = m * 144 + (32 * hh + 4 * q) * 2;
        const u32x2 alo = *(LAS const u32x2*)(wl + S1_AHL + o), ahi = *(LAS const u32x2*)(wl + S1_AHL + o + 32);
        const u32x2 rlo = *(LAS const u32x2*)(wl + S1_XR + o), rhi = *(LAS const u32x2*)(wl + S1_XR + o + 32);
        __builtin_nontemporal_store((u32x4){alo.x, alo.y, ahi.x, ahi.y}, (u32x4*)((bf16*)(ws + WS_AH) + (size_t)ci * 1024 + (hh * 64 + lane) * 8));
        __builtin_nontemporal_store((u32x4){rlo.x, rlo.y, rhi.x, rhi.y}, (u32x4*)((bf16*)(outb + OUT_RT) + (size_t)ci * 1024 + (hh * 64 + lane) * 8));
    }
    {
        bf16* BKg = (bf16*)(outb + OUT_BK) + (size_t)ci * 2048; const int kt = lane >> 4, mm = lane & 15;
#pragma unroll
        for (int qq = 0; qq < 4; ++qq)
            __builtin_nontemporal_store((u32x4){pk2(Bh[4 * qq], Bh[4 * qq + 1]), pk2(Bh[4 * qq + 2], Bh[4 * qq + 3]), pk2(Kh[4 * qq], Kh[4 * qq + 1]), pk2(Kh[4 * qq + 2], Kh[4 * qq + 3])}, (u32x4*)(BKg + (kt * 64 + mm + 16 * qq) * 8));
        ((float*)(outb + OUT_PC))[(size_t)ci * 256 + lane] = __expf(lpc);
    }
    asm volatile("s_waitcnt lgkmcnt(0)" ::: "memory");
}

constexpr int S2_SLOT = 15360, S2_D = 5, S2_NS = S2_D + 2;
constexpr int SO_AH = 0, SO_RT = 2048, SO_MA = 4096, SO_NN = 5120, SO_BK = 6144, SO_V = 10240, SO_PC = 12288, SO_G = 13312;
static_assert(S2_NS * S2_SLOT <= 131072, "S2 ring");
struct S2Ops { bf16x8 ah0, ah1, rt0, rt1, ma, nn, bk0, bk1, bk2, bk3; f32x4 pc0, pc1, pc2, pc3; unsigned vm01, vm23; };
#define S2_DMA(gptr, loff) __builtin_amdgcn_global_load_lds((const unsigned*)(gptr), (LAS unsigned*)(slot_ + (loff)), 16, 0, 2)
#ifndef S2_POST
#define S2_POST 1
#endif
constexpr int S2_YB = S2_NS * S2_SLOT;
static_assert(S2_YB + 8192 <= 131072, "S2 LDS");
__device__ __forceinline__ void s2_phase(unsigned char* ws, unsigned char* outb, const float* rk_, const float* lg_, const float* lb_, LAS unsigned char* lds, int tid, int lane, int wid) {
    const bf16* AHg = (const bf16*)(ws + WS_AH); const bf16* RTg = (const bf16*)(outb + OUT_RT); const bf16* MAg = (const bf16*)(ws + WS_MA); const bf16* NNg = (const bf16*)(ws + WS_NN);
    const bf16* BKg = (const bf16*)(outb + OUT_BK); const float* PCg = (const float*)(outb + OUT_PC); const bf16* VLg = (const bf16*)(ws + WS_VL);
    const bf16* GGg = (const bf16*)(ws + WS_G);
    for (int bh = blockIdx.x; bh < 64; bh += gridDim.x) {
        const int b = bh >> 3, h = bh & 7; const size_t rowbase = (size_t)b * SEQ;
        const int q = lane >> 4, n = lane & 15;
        if (wid == 4 || wid == 5) {
            const int lw = wid - 4;
            __builtin_amdgcn_s_setprio(2);
#define S2_ISSUE(cc) do { LAS unsigned char* slot_ = lds + ((cc) % S2_NS) * S2_SLOT; const size_t ci_ = (size_t)bh * 512 + (cc); \
                if (lw == 0) { S2_DMA(AHg + ci_ * 1024 + lane * 8, SO_AH); S2_DMA(AHg + ci_ * 1024 + 512 + lane * 8, SO_AH + 1024); \
                    S2_DMA(RTg + ci_ * 1024 + lane * 8, SO_RT); S2_DMA(RTg + ci_ * 1024 + 512 + lane * 8, SO_RT + 1024); \
                    S2_DMA(MAg + ci_ * 512 + lane * 8, SO_MA); S2_DMA(NNg + ci_ * 512 + lane * 8, SO_NN); \
                    S2_DMA(GGg + (rowbase + (size_t)(cc) * 16 + (lane >> 3)) * RW + h * 64 + (lane & 7) * 8, SO_G); \
                    S2_DMA(GGg + (rowbase + (size_t)(cc) * 16 + 8 + (lane >> 3)) * RW + h * 64 + (lane & 7) * 8, SO_G + 1024); } \
                else { S2_DMA(BKg + ci_ * 2048 + lane * 8, SO_BK); S2_DMA(BKg + ci_ * 2048 + 512 + lane * 8, SO_BK + 1024); \
                    S2_DMA(BKg + ci_ * 2048 + 1024 + lane * 8, SO_BK + 2048); S2_DMA(BKg + ci_ * 2048 + 1536 + lane * 8, SO_BK + 3072); \
                    S2_DMA(VLg + (rowbase + (size_t)(cc) * 16 + (lane >> 3)) * RW + h * 64 + (lane & 7) * 8, SO_V); \
                    S2_DMA(VLg + (rowbase + (size_t)(cc) * 16 + 8 + (lane >> 3)) * RW + h * 64 + (lane & 7) * 8, SO_V + 1024); \
                    S2_DMA(PCg + ci_ * 256 + lane * 4, SO_PC); } } while (0)
#define S2_WAIT() do { if (lw == 1) asm volatile("s_waitcnt vmcnt(21)" ::: "memory"); else asm volatile("s_waitcnt vmcnt(24)" ::: "memory"); } while (0)
#pragma unroll 1
            for (int cc = 0; cc < S2_D; ++cc) S2_ISSUE(cc);
            S2_WAIT(); __builtin_amdgcn_s_barrier(); asm volatile("" ::: "memory");
#pragma unroll 1
            for (int i = 0; i < 512; ++i) {
                if (i + S2_D < 512) { S2_ISSUE(i + S2_D); S2_WAIT(); } else asm volatile("s_waitcnt vmcnt(0)" ::: "memory");
                __builtin_amdgcn_s_barrier(); asm volatile("" ::: "memory");
            }
#undef S2_ISSUE
#undef S2_WAIT
        } else if (wid >= 6) {
            const int L = (wid - 6) * 64 + lane, pt = L >> 3, c8 = (L & 7) * 8;
            bf16* MIXg = (bf16*)(ws + WS_MIX);
            float lg[8], lb[8]; ld8f(lg_ + h * 64 + c8, lg); ld8f(lb_ + h * 64 + c8, lb);
#define S2P_PROC(cc) do { LAS const unsigned char* yb_ = lds + S2_YB + ((cc) & 1) * 4096 + pt * 256 + c8 * 4; LAS const unsigned char* sl_ = lds + ((cc) % S2_NS) * S2_SLOT; \
                const f32x4 ya_ = *(LAS const f32x4*)yb_, yb2_ = *(LAS const f32x4*)(yb_ + 16); \
                const u32x4 vw_ = *(LAS const u32x4*)(sl_ + SO_V + pt * 128 + c8 * 2); const u32x4 gw__ = *(LAS const u32x4*)(sl_ + SO_G + pt * 128 + c8 * 2); \
                const float bs_ = *(LAS const float*)(sl_ + SO_PC + (64 + pt) * 4); \
                float y_[8] = {ya_.x, ya_.y, ya_.z, ya_.w, yb2_.x, yb2_.y, yb2_.z, yb2_.w}, v_[8], g_[8], o_[8]; \
                unpack8(vw_, v_); unpack8(gw__, g_); \
                float s_ = 0.f; \
                _Pragma("unroll") for (int i_ = 0; i_ < 8; ++i_) s_ += y_[i_]; \
                s_ = dpp_add<0xB1>(s_); s_ = dpp_add<0x4E>(s_); s_ = dpp_add<0x141>(s_); \
                const float mean_ = s_ * (1.f / 64.f); float q_ = 0.f; \
                _Pragma("unroll") for (int i_ = 0; i_ < 8; ++i_) { y_[i_] -= mean_; q_ += y_[i_] * y_[i_]; } \
                q_ = dpp_add<0xB1>(q_); q_ = dpp_add<0x4E>(q_); q_ = dpp_add<0x141>(q_); \
                const float rstd_ = rsqrtf(q_ * (1.f / 64.f) + 64e-5f); \
                _Pragma("unroll") for (int i_ = 0; i_ < 8; ++i_) o_[i_] = (y_[i_] * rstd_ * lg[i_] + lb[i_] + bs_ * v_[i_]) * g_[i_]; \
                *(u32x4*)(MIXg + (rowbase + (size_t)(cc) * 16 + pt) * D + 512 + h * 64 + c8) = pack8(o_); } while (0)
            __builtin_amdgcn_s_barrier(); asm volatile("" ::: "memory");
#pragma unroll 1
            for (int jj = 0; jj < 512; ++jj) {
                if (jj >= 1) S2P_PROC(jj - 1);
                asm volatile("s_waitcnt lgkmcnt(0)" ::: "memory"); __builtin_amdgcn_s_barrier(); asm volatile("" ::: "memory");
            }
            S2P_PROC(511);
#undef S2P_PROC
        } else {
            const int vq = wid;
            __builtin_amdgcn_s_setprio(3);
            f32x4 ST0 = (f32x4){0.f, 0.f, 0.f, 0.f}, ST1 = ST0, ST2 = ST0, ST3 = ST0;
            const f32x4 z4 = ST0;
            S2Ops A_, B_;
#define S2_LOAD(O, cc) do { LAS const unsigned char* sb_ = lds + ((cc) % S2_NS) * S2_SLOT; \
                O.ah0 = *(LAS const bf16x8*)(sb_ + SO_AH + lane * 16); O.ah1 = *(LAS const bf16x8*)(sb_ + SO_AH + 1024 + lane * 16); \
                O.rt0 = *(LAS const bf16x8*)(sb_ + SO_RT + lane * 16); O.rt1 = *(LAS const bf16x8*)(sb_ + SO_RT + 1024 + lane * 16); \
                O.ma = *(LAS const bf16x8*)(sb_ + SO_MA + lane * 16); O.nn = *(LAS const bf16x8*)(sb_ + SO_NN + lane * 16); \
                O.bk0 = *(LAS const bf16x8*)(sb_ + SO_BK + lane * 16); O.bk1 = *(LAS const bf16x8*)(sb_ + SO_BK + 1024 + lane * 16); \
                O.bk2 = *(LAS const bf16x8*)(sb_ + SO_BK + 2048 + lane * 16); O.bk3 = *(LAS const bf16x8*)(sb_ + SO_BK + 3072 + lane * 16); \
                O.pc0 = *(LAS const f32x4*)(sb_ + SO_PC + (0 + 4 * q) * 4); O.pc1 = *(LAS const f32x4*)(sb_ + SO_PC + (16 + 4 * q) * 4); \
                O.pc2 = *(LAS const f32x4*)(sb_ + SO_PC + (32 + 4 * q) * 4); O.pc3 = *(LAS const f32x4*)(sb_ + SO_PC + (48 + 4 * q) * 4); \
                { const LAS unsigned short* vp_ = (const LAS unsigned short*)(sb_ + SO_V + (4 * q) * 128 + (16 * vq + n) * 2); \
                  O.vm01 = (unsigned)vp_[0] | ((unsigned)vp_[64] << 16); O.vm23 = (unsigned)vp_[128] | ((unsigned)vp_[192] << 16); } } while (0)
#define S2_STEP(O, cc) do { \
                const bf16x8 bs0_ = mk8(pk2(ST0[0], ST0[1]), pk2(ST0[2], ST0[3]), pk2(ST1[0], ST1[1]), pk2(ST1[2], ST1[3])); \
                const bf16x8 bs1_ = mk8(pk2(ST2[0], ST2[1]), pk2(ST2[2], ST2[3]), pk2(ST3[0], ST3[1]), pk2(ST3[2], ST3[3])); \
                const bf16x8 vb_ = mk8(0u, 0u, O.vm01, O.vm23); \
                f32x4 ut_ = MFMA16(O.ma, vb_, z4); ut_ = MFMA16(O.ah0, bs0_, ut_); ut_ = MFMA16(O.ah1, bs1_, ut_);     \
                const bf16x8 uv_ = mk8(pk2(ut_[0], ut_[1]), pk2(ut_[2], ut_[3]), O.vm01, O.vm23); \
                f32x4 yt_ = MFMA16(O.rt0, bs0_, z4); yt_ = MFMA16(O.rt1, bs1_, yt_); yt_ = MFMA16(O.nn, uv_, yt_); \
                ST0 = MFMA16(O.bk0, uv_, O.pc0 * ST0); ST1 = MFMA16(O.bk1, uv_, O.pc1 * ST1); ST2 = MFMA16(O.bk2, uv_, O.pc2 * ST2); ST3 = MFMA16(O.bk3, uv_, O.pc3 * ST3); \
                LAS float* yp_ = (LAS float*)(lds + S2_YB + ((cc) & 1) * 4096 + (4 * q) * 256 + (16 * vq + n) * 4); \
                yp_[0] = yt_[0]; yp_[64] = yt_[1]; yp_[128] = yt_[2]; yp_[192] = yt_[3]; } while (0)
            __builtin_amdgcn_s_barrier(); asm volatile("" ::: "memory");
            S2_LOAD(A_, 0);
#pragma unroll 1
            for (int i = 0; i < 512; i += 2) {
                S2_LOAD(B_, i + 1); __builtin_amdgcn_sched_barrier(0);
                S2_STEP(A_, i);
                asm volatile("s_waitcnt lgkmcnt(0)" ::: "memory"); __builtin_amdgcn_s_barrier(); asm volatile("" ::: "memory");
                if (i + 2 < 512) S2_LOAD(A_, i + 2);
                __builtin_amdgcn_sched_barrier(0);
                S2_STEP(B_, i + 1);
                asm volatile("s_waitcnt lgkmcnt(0)" ::: "memory"); __builtin_amdgcn_s_barrier(); asm volatile("" ::: "memory");
            }
#undef S2_LOAD
#undef S2_STEP
        }
        __builtin_amdgcn_s_barrier(); asm volatile("" ::: "memory");
    }
}

#ifndef STAGGER
#define STAGGER 0
#endif
__device__ __forceinline__ void stagger_start(unsigned step_ticks) {
#if STAGGER
    const unsigned ticks = ((blockIdx.x >> 3) & 7u) * step_ticks;
    const unsigned long long t0 = __builtin_amdgcn_s_memrealtime();
    while ((unsigned)(__builtin_amdgcn_s_memrealtime() - t0) < ticks) __builtin_amdgcn_s_sleep(16);
#endif
}
__device__ __forceinline__ void shadow_work(const Args& A, LAS unsigned char* lds, int w0, int nw, int lane, int wave) {
    unsigned char* ws = A.ws;
    LAS float* scr = (LAS float*)(lds + wave * 16384);
    constexpr int I_OUT = (D / 64) * (D / 32), I_UP = (D / 64) * (FF / 32), I_DN = (FF / 64) * (D / 32);
    for (int it = w0; it < I_OUT + I_UP + I_DN; it += nw) {
        int r = it;
        if (r < I_OUT) { transpose_item(A.in[17], D, D, (bf16*)(ws + WS_WOUT), scr, r, lane); continue; } r -= I_OUT;
        if (r < I_UP) { transpose_item(A.in[18], D, FF, (bf16*)(ws + WS_WUP), scr, r, lane); continue; } r -= I_UP;
        transpose_item(A.in[19], FF, D, (bf16*)(ws + WS_WDN), scr, r, lane);
    }
    const float* MOD = (const float*)(ws + WS_MOD); const float* wup = A.in[18]; float* B2 = (float*)(ws + WS_BIAS2);
    for (int it = w0; it < 64 * 32; it += nw) {
        const int n = (it >> 5) * 64 + lane, k0 = (it & 31) * 32;
        float acc[8];
#pragma unroll
        for (int b = 0; b < 8; ++b) acc[b] = 0.f;
#pragma unroll 16
        for (int k = k0; k < k0 + 32; ++k) { const float w = wup[(size_t)k * FF + n];
#pragma unroll
            for (int b = 0; b < 8; ++b) acc[b] += MOD[b * NMOD + 3 * D + k] * w; }
#pragma unroll
        for (int b = 0; b < 8; ++b) unsafeAtomicAdd(B2 + b * FF + n, acc[b]);
    }
}
#define XB_TMO      128
#define XB_XCNT(j)  (256  + 64 * (j))
#define XB_XSUB(j)  (1280 + 64 * (j))
#define XB_XGEN(j)  (2304 + 64 * (j))
#define XB_TOP      3328
#define XB_TOPGEN   3392
#define XCD_BAR_WORDS 3456
#define XB_SPIN_CAP (1u << 18)

__device__ __forceinline__ unsigned xb_ld(unsigned* p)              { return __hip_atomic_load(p, __ATOMIC_RELAXED, __HIP_MEMORY_SCOPE_AGENT); }
__device__ __forceinline__ unsigned xb_add(unsigned* p, unsigned v) { return __hip_atomic_fetch_add(p, v, __ATOMIC_RELAXED, __HIP_MEMORY_SCOPE_AGENT); }
__device__ __forceinline__ unsigned xb_xcc_id() { return (unsigned)__builtin_amdgcn_s_getreg((3 << 11) | 20) & 0xFu; }
#define XB_SPIN(cond, bar) do { unsigned _sp = 0; while (cond) { __builtin_amdgcn_s_sleep(1); \
    if ((++_sp & 255u) == 0u) { if (xb_ld(&(bar)[XB_TMO])) break; if (_sp > XB_SPIN_CAP) { atomicAdd(&(bar)[XB_TMO], 1u); break; } } } } while (0)

struct XcdBarrier {
    unsigned* bar; unsigned x;
    volatile LAS unsigned* st;
};

__device__ __forceinline__ XcdBarrier xcd_barrier_post(unsigned* bar, volatile LAS unsigned* st) {
    XcdBarrier b; b.bar = bar; b.x = xb_xcc_id(); b.st = st;
    if (threadIdx.x == 0) (void)xb_add(&bar[XB_XCNT(b.x)], 1u);
    return b;
}
__device__ __forceinline__ void xcd_barrier_complete(unsigned* bar, unsigned x, unsigned& nloc, unsigned& nx) {
    const unsigned G = gridDim.x * gridDim.y * gridDim.z;
    unsigned sum, cnt, mine, sp = 0u;
    for (;;) {
        sum = 0u; cnt = 0u; mine = 0u;
#pragma unroll
        for (unsigned j = 0; j < 16; ++j) { const unsigned c = xb_ld(&bar[XB_XCNT(j)]); sum += c; cnt += (c > 0u) ? 1u : 0u; mine = (j == x) ? c : mine; }
        if (sum == G) break;
        __builtin_amdgcn_s_sleep(1);
        if ((++sp & 255u) == 0u) { if (xb_ld(&bar[XB_TMO])) break; if (sp > XB_SPIN_CAP) { atomicAdd(&bar[XB_TMO], 1u); break; } }
    }
    nloc = mine > 0u ? mine : 1u; nx = cnt > 0u ? cnt : 1u;
}

__device__ __forceinline__ void xcd_barrier(const XcdBarrier& b) {
    asm volatile("s_waitcnt vmcnt(0)" ::: "memory");
    __syncthreads();
    if (threadIdx.x == 0) {
        unsigned* bar = b.bar;
        __builtin_amdgcn_s_waitcnt(0);
        unsigned nloc = b.st[0], nx = b.st[1];
        if (nloc == 0u) { xcd_barrier_complete(bar, b.x, nloc, nx); b.st[0] = nloc; b.st[1] = nx; }
        const unsigned old = xb_add(&bar[XB_XSUB(b.x)], 1u);
        const unsigned gen = old / nloc;
        if (old + 1u == (gen + 1u) * nloc) {
            __builtin_amdgcn_fence(__ATOMIC_RELEASE, "agent");
            asm volatile("s_waitcnt vmcnt(0)" ::: "memory");
            const unsigned og = xb_add(&bar[XB_TOP], 1u);
            const unsigned tg = og / nx;
            if (og + 1u == (tg + 1u) * nx) xb_add(&bar[XB_TOPGEN], 1u);
            else XB_SPIN(xb_ld(&bar[XB_TOPGEN]) == tg, bar);
            __builtin_amdgcn_fence(__ATOMIC_ACQUIRE, "agent");
            xb_add(&bar[XB_XGEN(b.x)], 1u);
            asm volatile("s_waitcnt vmcnt(0)" ::: "memory");
        } else {
            XB_SPIN(xb_ld(&bar[XB_XGEN(b.x)]) == gen, bar);
            __builtin_amdgcn_fence(__ATOMIC_ACQUIRE, "agent");
            asm volatile("s_waitcnt vmcnt(0)" ::: "memory");
        }
    }
    __syncthreads();
}

constexpr size_t WS_BAR = 896 * 1024;
#ifndef STAGGER2
#define STAGGER2 0
#endif
__device__ __forceinline__ void stagger2(unsigned step_ticks) {
#if STAGGER2
    const unsigned ticks = ((blockIdx.x >> 3) & 7u) * step_ticks;
    const unsigned long long t0 = __builtin_amdgcn_s_memrealtime();
    while ((unsigned)(__builtin_amdgcn_s_memrealtime() - t0) < ticks) __builtin_amdgcn_s_sleep(16);
#endif
}
struct Order13 : pg8::StaticOrder {
    __device__ __forceinline__ void init13(int G_, int c_) { init(M, 12 * 256, G_, c_); }
    __device__ __forceinline__ bool next(int i, pg8::Unit& u) const {
        const long L = (long)i * G + c;
        if (L < nwg) return pg8::StaticOrder::next(i, u);
        const int j = (int)(L - nwg); if (j >= 256) return false;
        u.pm = (j % 8) * 32 + j / 8; u.pn = 12; return true;
    }
};
__global__ void __launch_bounds__(NTHR, 2) fwd_megakernel(Args A) {
    extern __shared__ __attribute__((aligned(16))) unsigned char lds_raw[];
    LAS unsigned char* lds = (LAS unsigned char*)lds_raw;
    cg::grid_group grid = cg::this_grid();
    if (threadIdx.x < 4) ((LAS unsigned*)(lds + LDS_MISC + 1024))[threadIdx.x] = 0u;
    __syncthreads();
    if (A.ph_lo < 0) grid.sync();
    (void)xcd_barrier_post((unsigned*)(A.ws + WS_BAR), (volatile LAS unsigned*)(lds + LDS_MISC + 1024));
    const int tid = threadIdx.x, lane = tid & 63, wave = __builtin_amdgcn_readfirstlane(tid >> 6);
    unsigned char* ws = A.ws;
    const int lo = A.ph_lo, hi = A.ph_hi;
    const int gw = blockIdx.x * NWAVES + wave, NGW = gridDim.x * NWAVES;
    float* MOD = (float*)(ws + WS_MOD);
#ifndef PHASE_MASK
#define PHASE_MASK 0xfff
#endif
#define IN(k) (((PHASE_MASK >> (k)) & 1) && lo <= (k) && (k) < hi)
#ifndef USE_XBAR
#define USE_XBAR 1
#endif
#define GSYNC(k) do { if (USE_XBAR) { XcdBarrier xb_; xb_.bar = (unsigned*)(A.ws + WS_BAR); xb_.x = xb_xcc_id(); xb_.st = (volatile LAS unsigned*)(lds + LDS_MISC + 1024); xcd_barrier(xb_); } else grid.sync(); } while (0)
#define SEAM(k) do { if (IN(k) && IN((k) + 1)) GSYNC(k); } while (0)
#ifndef REPEAT_MASK
#define REPEAT_MASK 0
#endif
#define REP(k) for (int rep_ = 0; rep_ < (((REPEAT_MASK >> (k)) & 1) ? 2 : 1); ++rep_, (void)((rep_ < (((REPEAT_MASK >> (k)) & 1) ? 2 : 1)) ? (grid.sync(), 0) : 0))

    if (IN(0)) { p0_prologue(A, lds, tid, lane, wave); } SEAM(0);
#ifdef EXTRA_SYNCS
    for (int e_ = 0; e_ < EXTRA_SYNCS; ++e_) grid.sync();
#endif
    REP(1) if (IN(1)) {
        int m = gw;
        for (; m + 3 * NGW < M; m += 4 * NGW) norm_mod_rows<4>(A.in[0], (bf16*)(ws + WS_XN), MOD, 0, m, NGW, lane);
        for (; m < M; m += NGW) norm_mod_rows<1>(A.in[0], (bf16*)(ws + WS_XN), MOD, 0, m, NGW, lane);
#if FUSED_RES && !(CONV_UNDER_S2 && SHADOW_EXTRA)
        for (int nn = gw; nn < FF; nn += NGW) {
            const bf16* wrow = (const bf16*)(ws + WS_WUP) + (size_t)nn * D; float wa[8], wb[8];
            unpack8(*(const u32x4*)(wrow + lane * 8), wa); unpack8(*(const u32x4*)(wrow + 512 + lane * 8), wb);
#pragma unroll 1
            for (int b = 0; b < BATCH; ++b) { const float* sh = MOD + b * NMOD + 3 * D; float sa[8], sb[8]; ld8f(sh + lane * 8, sa); ld8f(sh + 512 + lane * 8, sb); float acc_ = 0.f;
#pragma unroll
                for (int i = 0; i < 8; ++i) acc_ += sa[i] * wa[i] + sb[i] * wb[i];
                acc_ = wave_sum(acc_);
                if (lane == 0) ((float*)(ws + WS_BIAS2))[b * FF + nn] = acc_; }
        }
#endif
    } SEAM(1);
#ifdef DUP2N
    if (IN(2)) {
        pg8::Gemm g{(const bf16*)(ws + WS_XN), (const bf16*)(ws + WS_WIN), M, PT, D}; pg8::StaticOrder S; S.init(M, PT, gridDim.x, blockIdx.x);
        EpiNull E{(float*)(ws + WS_MOD) + 60000};
        pg8::gemm_phase<EpiNull, pg8::StaticOrder, true, true>(lds, g, S, E);
    } GSYNC(2);
#endif
#ifdef DUP2
    if (IN(2)) {
        pg8::Gemm g{(const bf16*)(ws + WS_XN), (const bf16*)(ws + WS_WIN), M, PT, D}; pg8::StaticOrder S; S.init(M, PT, gridDim.x, blockIdx.x);
        stagger_start(250); EpiBf<0, true> E{(bf16*)(ws + WS_P), PT};
        pg8::gemm_phase<EpiBf<0, true>, pg8::StaticOrder, true, true>(lds, g, S, E);
    } GSYNC(2);
#endif
    REP(2) if (IN(2)) {
        pg8::Gemm g{(const bf16*)(ws + WS_XN), (const bf16*)(ws + WS_WIN), M, PT, D}; Order13 S; S.init13(gridDim.x, blockIdx.x);
        EpiBf<0, true> E{(bf16*)(ws + WS_P), PT};
        pg8::gemm_phase<EpiBf<0, true>, Order13, true, true>(lds, g, S, E);
    } SEAM(2);
    REP(3) if (IN(3)) {
        vl_pass(A, gw, NGW, lane);
#if !(SCAN_CHUNKED && CONV_UNDER_S2)
        conv_pass(A, gw, NGW, lane);
#endif
    } SEAM(3);
    REP(4) if (IN(4)) {
        pg8::Gemm g{(const bf16*)(ws + WS_LA), (const bf16*)(ws + WS_LT), M, LN, LK}; pg8::StaticOrder S; S.init(M, LN, gridDim.x, blockIdx.x);
        stagger_start(100); EpiLora E{A.in[7], A.in[9], A.in[13], (const bf16*)(ws + WS_KL), (const bf16*)(ws + WS_KK), (float*)(ws + WS_DEC), (bf16*)(ws + WS_KP), (bf16*)(ws + WS_BV), (bf16*)(ws + WS_G)};
        pg8::gemm_phase<EpiLora, pg8::StaticOrder, true, true>(lds, g, S, E);
    } SEAM(4);
#if SCAN_CHUNKED
    if (IN(5)) {
        for (int ci = gw; ci < 64 * 512; ci += NGW) s1_item(ws, (unsigned char*)A.out, A.in[14], A.in[13], A.in[6], A.in[12], lds + wave * S1_WAVE, ci, lane);
#ifdef DUPS1
        grid.sync();
#pragma unroll 1
        for (int ci = gw; ci < 64 * 512; ci += NGW) s1_item(ws, (unsigned char*)A.out, A.in[14], A.in[13], A.in[6], A.in[12], lds + wave * S1_WAVE, ci, lane);
#endif
        GSYNC(5);
#ifdef DUPS2
        s2_phase(ws, (unsigned char*)A.out, A.in[14], A.in[15], A.in[16], lds, tid, lane, wave);
        GSYNC(5);
#endif
#ifdef DUPCONV
        if (blockIdx.x >= 64) conv_pass(A, (blockIdx.x - 64) * NWAVES + wave, (gridDim.x - 64) * NWAVES, lane);
        GSYNC(5);
#endif
        s2_phase(ws, (unsigned char*)A.out, A.in[14], A.in[15], A.in[16], lds, tid, lane, wave);
#if CONV_UNDER_S2
        if (gridDim.x > 64) { if (blockIdx.x >= 64) { conv_pass(A, (blockIdx.x - 64) * NWAVES + wave, (gridDim.x - 64) * NWAVES, lane); if (SHADOW_EXTRA) shadow_work(A, lds, (blockIdx.x - 64) * NWAVES + wave, (gridDim.x - 64) * NWAVES, lane, wave); } }
        else { conv_pass(A, gw, NGW, lane); if (SHADOW_EXTRA) shadow_work(A, lds, gw, NGW, lane, wave); }
#endif
    } SEAM(5);
#else
    REP(5) if (IN(5)) { scan_phase(ws, lds, tid, lane, wave); } SEAM(5);
#endif
#if !(SCAN_CHUNKED && S2_POST)
    REP(6) if (IN(6)) { int m = gw; for (; m + 3 * NGW < M; m += 4 * NGW) post_rows<4>(A, m, NGW, lane); for (; m < M; m += NGW) post_rows<1>(A, m, NGW, lane); } SEAM(6);
#endif
    REP(7) if (IN(7)) {
        pg8::Gemm g{(const bf16*)(ws + WS_MIX), (const bf16*)(ws + WS_WOUT), M, D, D}; pg8::StaticOrder S; S.init(M, D, gridDim.x, blockIdx.x);
#if FUSED_RES
        EpiRes7 E{A.in[0], (bf16*)(ws + WS_X1B), (bf16*)(ws + WS_XN), MOD, (float*)(ws + WS_RS2)};
        pg8::gemm_phase<EpiRes7, pg8::StaticOrder, true, true>(lds, g, S, E);
#else
        stagger_start(500); EpiRes E{A.in[0], A.out, MOD + 2 * D};
        pg8::gemm_phase<EpiRes, pg8::StaticOrder, true, true>(lds, g, S, E);
#endif
    } SEAM(7);
#if !FUSED_RES
    REP(8) if (IN(8)) {
        int m = gw;
        for (; m + 3 * NGW < M; m += 4 * NGW) norm_mod_rows<4>(A.out, (bf16*)(ws + WS_XN), MOD, 3, m, NGW, lane);
        for (; m < M; m += NGW) norm_mod_rows<1>(A.out, (bf16*)(ws + WS_XN), MOD, 3, m, NGW, lane);
    } SEAM(8);
#endif
#ifdef DUP9H
    if (IN(9)) {
        pg8::Gemm g{(const bf16*)(ws + WS_XN), (const bf16*)(ws + WS_WUP), M, FF / 2, D}; pg8::StaticOrder S; S.init(M, FF / 2, gridDim.x, blockIdx.x);
        EpiNull E{(float*)(ws + WS_MOD) + 60000};
        pg8::gemm_phase<EpiNull, pg8::StaticOrder, true, true>(lds, g, S, E);
    } GSYNC(9);
#endif
#ifdef DUP9N
    if (IN(9)) {
        pg8::Gemm g{(const bf16*)(ws + WS_XN), (const bf16*)(ws + WS_WUP), M, FF, D}; pg8::StaticOrder S; S.init(M, FF, gridDim.x, blockIdx.x);
        EpiNull E{(float*)(ws + WS_MOD) + 60000};
        pg8::gemm_phase<EpiNull, pg8::StaticOrder, true, true>(lds, g, S, E);
    } GSYNC(9);
#endif
#ifdef DUP9
    if (IN(9)) {
        pg8::Gemm g{(const bf16*)(ws + WS_XN), (const bf16*)(ws + WS_WUP), M, FF, D}; pg8::StaticOrder S; S.init(M, FF, gridDim.x, blockIdx.x);
        stagger_start(250); EpiBf<1> E{(bf16*)(ws + WS_H), FF};
        pg8::gemm_phase<EpiBf<1>, pg8::StaticOrder, true, true>(lds, g, S, E);
    } grid.sync();
#endif
    REP(9) if (IN(9)) {
        pg8::Gemm g{(const bf16*)(ws + WS_XN), (const bf16*)(ws + WS_WUP), M, FF, D}; pg8::StaticOrder S; S.init(M, FF, gridDim.x, blockIdx.x);
#if FUSED_RES
        stagger2(275); EpiUp2 E{(bf16*)(ws + WS_H), (const float*)(ws + WS_RS2), (const float*)(ws + WS_BIAS2)};
        pg8::gemm_phase<EpiUp2, pg8::StaticOrder, true, true>(lds, g, S, E);
#else
        stagger_start(250); EpiBf<1> E{(bf16*)(ws + WS_H), FF};
        pg8::gemm_phase<EpiBf<1>, pg8::StaticOrder, true, true>(lds, g, S, E);
#endif
    } SEAM(9);
    if (IN(10)) {
        pg8::Gemm g{(const bf16*)(ws + WS_H), (const bf16*)(ws + WS_WDN), M, D, FF}; pg8::StaticOrder S; S.init(M, D, gridDim.x, blockIdx.x);
#if FUSED_RES && FUSED_FINAL
        EpiDownF E{(const bf16*)(ws + WS_X1B), A.out, MOD, A.in[20], (float*)(ws + WS_RS3), (unsigned*)(ws + WS_CNT)};
        pg8::gemm_phase<EpiDownF, pg8::StaticOrder, true, true>(lds, g, S, E);
#elif FUSED_RES
        EpiDown2 E{(const bf16*)(ws + WS_X1B), (bf16*)(ws + WS_X2B), MOD, (float*)(ws + WS_RS3)};
        pg8::gemm_phase<EpiDown2, pg8::StaticOrder, true, true>(lds, g, S, E);
#else
        stagger_start(600); EpiRes E{A.out, A.out, MOD + 5 * D};
        pg8::gemm_phase<EpiRes, pg8::StaticOrder, true, true>(lds, g, S, E);
#endif
    }
#if FUSED_RES && FUSED_FINAL
#elif FUSED_RES
    SEAM(10);
    if (IN(11)) { int m = gw; for (; m + 3 * NGW < M; m += 4 * NGW) final_rows2<4>((const bf16*)(ws + WS_X2B), (const float*)(ws + WS_RS3), A.out, A.in[20], m, NGW, lane);
        for (; m < M; m += NGW) final_rows2<1>((const bf16*)(ws + WS_X2B), (const float*)(ws + WS_RS3), A.out, A.in[20], m, NGW, lane); }
#else
    if (IN(11)) { int m = gw; for (; m + 3 * NGW < M; m += 4 * NGW) final_rows<4>(A.out, A.in[20], m, NGW, lane); for (; m < M; m += NGW) final_rows<1>(A.out, A.in[20], m, NGW, lane); }
#endif
#undef IN
#undef SEAM
}

extern "C" void kernel_launch(void* const* d_in, const int* in_sizes, int n_in, void* d_out, int out_size, void* d_ws, size_t ws_size, hipStream_t stream) {
    static int grid_blocks = 0;
    if (grid_blocks == 0) {
        if (n_in != 21 || out_size != M * D || ws_size < WS_END) { fprintf(stderr, "kernel_launch: unexpected shapes (n_in %d out %d ws %zu)\n", n_in, out_size, ws_size); grid_blocks = -1; return; }
        int dev = 0, cus = 0, per_cu = 0;
        hipGetDevice(&dev);
        hipDeviceGetAttribute(&cus, hipDeviceAttributeMultiprocessorCount, dev);
        if (hipFuncSetAttribute((const void*)fwd_megakernel, hipFuncAttributeMaxDynamicSharedMemorySize, LDS_BYTES) != hipSuccess) { fprintf(stderr, "kernel_launch: hipFuncSetAttribute failed\n"); grid_blocks = -1; return; }
        if (hipOccupancyMaxActiveBlocksPerMultiprocessor(&per_cu, (const void*)fwd_megakernel, NTHR, LDS_BYTES) != hipSuccess || per_cu < 1) { fprintf(stderr, "kernel_launch: occupancy query failed (%d)\n", per_cu); grid_blocks = -1; return; }
        grid_blocks = cus * per_cu;
    }
    if (grid_blocks < 0) return;
    hipMemsetAsync((char*)d_ws + WS_MOD, 0, CTL_ZERO_BYTES, stream);
    Args a{};
    for (int i = 0; i < 21; ++i) a.in[i] = (const float*)d_in[i];
    a.out = (float*)d_out; a.ws = (unsigned char*)d_ws;
#if MK_SPLIT
    for (int ph = 0; ph < NPHASE; ++ph) {
        a.ph_lo = ph; a.ph_hi = ph + 1;
#else
    {
        a.ph_lo = 0; a.ph_hi = NPHASE;
#endif
        void* args[] = {&a};
        hipError_t e = hipLaunchCooperativeKernel((const void*)fwd_megakernel, dim3(grid_blocks), dim3(NTHR), args, LDS_BYTES, stream);
        if (e != hipSuccess) fprintf(stderr, "kernel_launch: cooperative launch failed: %s (grid %d)\n", hipGetErrorString(e), grid_blocks);
    }
}
```
